# Optimizing an MI355X kernel written in HIP

```python
import jax
import jax.numpy as jnp
from jax import lax
import numpy as np

D_MODEL = 1024
BATCH = 8
SEQ = 4096
DEPTH = 2
DEC_BATCH = 128
DEC_SEQ = 4
PAST_LEN = 16384
PAGE_SIZE = 128

MIX_WIDTH = D_MODEL
GROUP_WIDTH = MIX_WIDTH // 4
HEAD_DIM = 64
A_HEADS = GROUP_WIDTH // HEAD_DIM
A_CONV = 4
A_CHUNK = 64
B_CONV = 3
C_HEADS = GROUP_WIDTH // HEAD_DIM
C_KV_HEADS = 2
WINDOW = 128
ROPE_DIM = HEAD_DIM // 4
ROPE_THETA = 500000.0
D_GROUPS = 4
D_CHUNK = 128
D_FF = 2816
FFN_CONV = 3
EPS = 1e-6
NEG_INF = -1e30
SPLIT_SIZES = (3 * GROUP_WIDTH, GROUP_WIDTH, A_HEADS, A_HEADS, GROUP_WIDTH, GROUP_WIDTH, GROUP_WIDTH, C_HEADS * HEAD_DIM, C_KV_HEADS * HEAD_DIM, C_KV_HEADS * HEAD_DIM, GROUP_WIDTH, GROUP_WIDTH)
P_TOTAL = sum(SPLIT_SIZES)

kernel_name = 'hybrid_parallel_groups_decode_step'


def rmsnorm(x, g):
    xf = x.astype(jnp.float32)
    y = xf * lax.rsqrt(jnp.mean(xf * xf, axis=-1, keepdims=True) + EPS)
    return (y * g.astype(jnp.float32)).astype(x.dtype)


def layernorm(x, g, b):
    xf = x.astype(jnp.float32)
    mu = jnp.mean(xf, axis=-1, keepdims=True)
    xc = xf - mu
    y = xc * lax.rsqrt(jnp.mean(xc * xc, axis=-1, keepdims=True) + EPS)
    return (y * g.astype(jnp.float32) + b.astype(jnp.float32)).astype(x.dtype)


def l2norm(x):
    xf = x.astype(jnp.float32)
    return xf * lax.rsqrt(jnp.sum(xf * xf, axis=-1, keepdims=True) + EPS)


def causal_dwconv(buf, x, w):
    K = w.shape[0]
    t = x.shape[1]
    xp = jnp.concatenate([buf.astype(x.dtype), x], axis=1)
    y = xp[:, 0:t] * w[0]
    for j in range(1, K):
        y = y + xp[:, j:j + t] * w[j]
    return y, xp[:, t:]


def partial_rope(x, pos):
    half = ROPE_DIM // 2
    inv = jnp.power(ROPE_THETA, -jnp.arange(half, dtype=jnp.float32) * (2.0 / ROPE_DIM))
    ang = pos.astype(jnp.float32)[:, None] * inv[None, :]
    cos = jnp.cos(ang)[None, :, None, :]
    sin = jnp.sin(ang)[None, :, None, :]
    xr = x[..., :ROPE_DIM].astype(jnp.float32)
    x1, x2 = xr[..., :half], xr[..., half:]
    rot = jnp.concatenate([x1 * cos - x2 * sin, x2 * cos + x1 * sin], axis=-1).astype(x.dtype)
    return jnp.concatenate([rot, x[..., ROPE_DIM:]], axis=-1)


def sink_softmax(s, sinks):
    sk = jnp.broadcast_to(sinks.astype(jnp.float32)[..., None, None], s.shape[:-1] + (1,))
    return jax.nn.softmax(jnp.concatenate([s, sk], axis=-1), axis=-1)[..., :-1]


def window_attn_banded(q, k, v, sinks):
    bsz, t, hq, hd = q.shape
    hkv = k.shape[2]
    nb = t // WINDOW
    qb = q.reshape(bsz, nb, WINDOW, hkv, hq // hkv, hd)

    def band(a):
        ab = a.reshape(bsz, nb, WINDOW, hkv, hd)
        prev = jnp.concatenate([jnp.zeros_like(ab[:, :1]), ab[:, :-1]], axis=1)
        return jnp.concatenate([prev, ab], axis=2)

    kb, vb = band(k), band(v)
    i = jnp.arange(WINDOW)[:, None]
    j = jnp.arange(2 * WINDOW)[None, :]
    blk = jnp.arange(nb)[:, None, None]
    mask = (j > i) & (j <= i + WINDOW) & (blk * WINDOW + j - WINDOW >= 0)
    s = jnp.einsum('bnqhgd,bnkhd->bnhgqk', qb, kb).astype(jnp.float32) * (hd ** -0.5)
    s = jnp.where(mask[None, :, None, None], s, NEG_INF)
    pr = sink_softmax(s, sinks.reshape(hkv, hq // hkv))
    o = jnp.einsum('bnhgqk,bnkhd->bnqhgd', pr.astype(vb.dtype), vb)
    return o.reshape(bsz, t, hq * hd)


def window_attn_cached(q, k, v, buf_k, buf_v, q_pos, k_pos, sinks):
    bsz, t, hq, hd = q.shape
    hkv = k.shape[2]
    kk = jnp.concatenate([buf_k.astype(k.dtype), k], axis=1)
    vv = jnp.concatenate([buf_v.astype(v.dtype), v], axis=1)
    qg = q.reshape(bsz, t, hkv, hq // hkv, hd)
    s = jnp.einsum('bqhgd,bkhd->bhgqk', qg, kk).astype(jnp.float32) * (hd ** -0.5)
    dpos = q_pos[:, None] - k_pos[None, :]
    s = jnp.where((dpos >= 0) & (dpos < WINDOW), s, NEG_INF)
    pr = sink_softmax(s, sinks.reshape(hkv, hq // hkv))
    o = jnp.einsum('bhgqk,bkhd->bqhgd', pr.astype(vv.dtype), vv).reshape(bsz, t, hq * hd)
    nbuf = buf_k.shape[1]
    return o, kk[:, -nbuf:], vv[:, -nbuf:]


def gated_delta_rule(q, k, v, g, beta, s0):
    f32 = jnp.float32
    bsz, t, h, dk = q.shape
    dv = v.shape[-1]
    c = A_CHUNK if t % A_CHUNK == 0 else t
    n = t // c

    def chunks(a):
        a = a.astype(f32).reshape((bsz, n, c) + a.shape[2:])
        return jnp.moveaxis(jnp.moveaxis(a, 1, 0), 2, 3)

    qc = chunks(q) * (dk ** -0.5)
    kc = chunks(k)
    vc = chunks(v)
    bc = chunks(beta)
    gc = jnp.cumsum(chunks(g), axis=-1)
    causal = jnp.tril(jnp.ones((c, c), bool))
    strict = jnp.tril(jnp.ones((c, c), bool), -1)
    diff = gc[..., :, None] - gc[..., None, :]
    decay = jnp.where(causal, jnp.exp(jnp.where(causal, diff, 0.0)), 0.0)
    kbeta = kc * bc[..., None]
    a_mat = jnp.where(strict, jnp.einsum('nbhcd,nbhsd->nbhcs', kbeta, kc) * decay, 0.0)
    eye = jnp.eye(c, dtype=f32)
    t_inv = lax.linalg.triangular_solve(a_mat + eye, jnp.broadcast_to(eye, a_mat.shape), left_side=True, lower=True)
    u = t_inv @ (vc * bc[..., None])
    w = t_inv @ (kbeta * jnp.exp(gc)[..., None])
    qk = jnp.einsum('nbhcd,nbhsd->nbhcs', qc, kc) * decay
    q_dec = qc * jnp.exp(gc)[..., None]
    g_last = gc[..., -1]
    k_dec = kc * jnp.exp(g_last[..., None] - gc)[..., None]

    def step(s, xs):
        q_i, k_i, u_i, w_i, qk_i, gl_i = xs
        v_new = u_i - w_i @ s
        o_i = q_i @ s + qk_i @ v_new
        s = s * jnp.exp(gl_i)[..., None, None] + jnp.swapaxes(k_i, -1, -2) @ v_new
        return s, o_i

    s_fin, o = lax.scan(step, s0.astype(f32), (q_dec, k_dec, u, w, qk, g_last))
    o = jnp.moveaxis(jnp.moveaxis(o, 3, 2), 0, 1).reshape(bsz, t, h, dv)
    return o.astype(v.dtype), s_fin


def chunk_token_mlp(u, v, ws, bias):
    bsz, t, width = v.shape
    n = min(t, D_CHUNK)
    nc = t // n
    wm = jnp.where(jnp.tril(jnp.ones((n, n), bool)), ws[:, :n, :n], 0.0).astype(v.dtype)
    vc = v.reshape(bsz, nc, n, D_GROUPS, width // D_GROUPS)
    mixed = jnp.einsum('gts,bcsgd->bctgd', wm, vc) + bias[:, :n].T[None, None, :, :, None].astype(v.dtype)
    return u * mixed.reshape(bsz, t, width)


def hybrid_layer(x, pos, k_pos, st, p):
    bsz, t, _ = x.shape
    f32 = jnp.float32
    h = rmsnorm(x, p['norm1_g'])
    proj = h @ p['w_in']
    (a_qkv, a_z, a_b, a_a, b_b, b_c, b_h, c_q, c_k, c_v, d_u, d_v) = jnp.split(proj, [int(s) for s in np.cumsum(SPLIT_SIZES)[:-1]], axis=-1)
    qkv, a_conv_new = causal_dwconv(st['a_conv'], a_qkv, p['a_conv_w'])
    qkv = jax.nn.silu(qkv).reshape(bsz, t, 3, A_HEADS, HEAD_DIM)
    q, k, v = l2norm(qkv[:, :, 0]), l2norm(qkv[:, :, 1]), qkv[:, :, 2]
    beta = jax.nn.sigmoid(a_b.astype(f32))
    g = -jnp.exp(p['a_log'].astype(f32)) * jax.nn.softplus(a_a.astype(f32) + p['a_dt_bias'].astype(f32))
    o, a_state_new = gated_delta_rule(q, k, v, g, beta, st['a_state'])
    o = rmsnorm(o, p['a_norm_g']) * jax.nn.silu(a_z.reshape(bsz, t, A_HEADS, HEAD_DIM))
    out_a = o.reshape(bsz, t, GROUP_WIDTH)
    bx, b_conv_new = causal_dwconv(st['b_conv'], b_c * b_h, p['b_conv_w'])
    out_b = b_b * bx
    cq = partial_rope(c_q.reshape(bsz, t, C_HEADS, HEAD_DIM), pos)
    ck = partial_rope(c_k.reshape(bsz, t, C_KV_HEADS, HEAD_DIM), pos)
    cv = c_v.reshape(bsz, t, C_KV_HEADS, HEAD_DIM)
    if k_pos is None:
        out_c = window_attn_banded(cq, ck, cv, p['c_sinks'])
        c_k_new, c_v_new = ck[:, -WINDOW:], cv[:, -WINDOW:]
    else:
        out_c, c_k_new, c_v_new = window_attn_cached(cq, ck, cv, st['c_k'], st['c_v'], pos, k_pos, p['c_sinks'])
    du = jax.nn.gelu(d_u)
    dvn = layernorm(jax.nn.gelu(d_v), p['d_ln_g'], p['d_ln_b'])
    out_d = chunk_token_mlp(du, dvn, p['d_ws'], p['d_bias'])
    x = x + jnp.concatenate([out_a, out_b, out_c, out_d], axis=-1) @ p['w_out']
    h2 = rmsnorm(x, p['norm2_g'])
    gate, f_conv_new = causal_dwconv(st['f_conv'], h2 @ p['ffn_w_gate'], p['ffn_conv_w'])
    x = x + (jax.nn.silu(gate) * (h2 @ p['ffn_w_up'])) @ p['ffn_w_down']
    new = {'a_state': a_state_new, 'a_conv': a_conv_new, 'b_conv': b_conv_new, 'c_k': c_k_new, 'c_v': c_v_new, 'f_conv': f_conv_new, 'd_v': dvn}
    return x, new


def setup_inputs(seed: int = 0) -> dict:
    key = jax.random.key(seed)
    ks = iter(jax.random.split(key, 40))
    f32 = jnp.float32

    def nrm(shape, scale):
        return jax.random.normal(next(ks), shape, f32) * scale

    win_buf = min(WINDOW, PAST_LEN)
    a_log = jnp.log(jax.random.uniform(next(ks), (DEPTH, A_HEADS), f32, minval=1.0, maxval=16.0))
    dt = jnp.exp(jax.random.uniform(next(ks), (DEPTH, A_HEADS), f32, minval=float(np.log(1e-3)), maxval=float(np.log(1e-1))))
    a_dt_bias = dt + jnp.log(-jnp.expm1(-dt))
    return {
        'x_prompt': nrm((BATCH, SEQ, D_MODEL), 1.0),
        'x_sample': nrm((DEC_BATCH, DEC_SEQ, D_MODEL), 1.0),
        'state_delta': nrm((DEPTH, DEC_BATCH, A_HEADS, HEAD_DIM, HEAD_DIM), 0.3),
        'state_delta_conv': nrm((DEPTH, DEC_BATCH, A_CONV - 1, 3 * GROUP_WIDTH), 1.0),
        'state_shortconv': nrm((DEPTH, DEC_BATCH, B_CONV - 1, GROUP_WIDTH), 1.0),
        'cache_win_k': nrm((DEPTH, DEC_BATCH, win_buf, C_KV_HEADS, HEAD_DIM), 1.0),
        'cache_win_v': nrm((DEPTH, DEC_BATCH, win_buf, C_KV_HEADS, HEAD_DIM), 1.0),
        'state_ffn_conv': nrm((DEPTH, DEC_BATCH, FFN_CONV - 1, D_FF), 1.0),
        'norm1_g': 1.0 + nrm((DEPTH, D_MODEL), 0.1),
        'w_in': nrm((DEPTH, D_MODEL, P_TOTAL), D_MODEL ** -0.5),
        'a_conv_w': nrm((DEPTH, A_CONV, 3 * GROUP_WIDTH), A_CONV ** -0.5),
        'a_log': a_log,
        'a_dt_bias': a_dt_bias,
        'a_norm_g': 1.0 + nrm((DEPTH, HEAD_DIM), 0.1),
        'b_conv_w': nrm((DEPTH, B_CONV, GROUP_WIDTH), B_CONV ** -0.5),
        'c_sinks': nrm((DEPTH, C_HEADS), 1.0),
        'd_ln_g': 1.0 + nrm((DEPTH, GROUP_WIDTH), 0.1),
        'd_ln_b': nrm((DEPTH, GROUP_WIDTH), 0.1),
        'd_ws': nrm((DEPTH, D_GROUPS, D_CHUNK, D_CHUNK), D_CHUNK ** -0.5),
        'd_bias': 1.0 + nrm((DEPTH, D_GROUPS, D_CHUNK), 0.1),
        'w_out': nrm((DEPTH, MIX_WIDTH, D_MODEL), MIX_WIDTH ** -0.5),
        'norm2_g': 1.0 + nrm((DEPTH, D_MODEL), 0.1),
        'ffn_w_gate': nrm((DEPTH, D_MODEL, D_FF), D_MODEL ** -0.5),
        'ffn_w_up': nrm((DEPTH, D_MODEL, D_FF), D_MODEL ** -0.5),
        'ffn_conv_w': nrm((DEPTH, FFN_CONV, D_FF), FFN_CONV ** -0.5),
        'ffn_w_down': nrm((DEPTH, D_FF, D_MODEL), D_FF ** -0.5),
        'final_norm_g': 1.0 + nrm((D_MODEL,), 0.1),
    }


def reference(x_prompt, x_sample, state_delta, state_delta_conv, state_shortconv, cache_win_k, cache_win_v, state_ffn_conv, norm1_g, w_in, a_conv_w, a_log, a_dt_bias, a_norm_g, b_conv_w, c_sinks, d_ln_g, d_ln_b, d_ws, d_bias, w_out, norm2_g, ffn_w_gate, ffn_w_up, ffn_conv_w, ffn_w_down, final_norm_g):
    bp, tp, _ = x_prompt.shape
    bs, ts, _ = x_sample.shape
    dt = x_prompt.dtype
    win_buf = cache_win_k.shape[2]
    pos_p = jnp.arange(tp, dtype=jnp.int32)
    pos_s = PAST_LEN + jnp.arange(ts, dtype=jnp.int32)
    k_pos_s = PAST_LEN - win_buf + jnp.arange(win_buf + ts, dtype=jnp.int32)
    names = ('a_state', 'a_conv', 'b_conv', 'c_k', 'c_v', 'f_conv')
    new_p = {n: [] for n in names}
    new_s = {n: [] for n in names}
    chunk_v_rows = []
    hp, hs = x_prompt, x_sample
    for l in range(DEPTH):
        p = {'norm1_g': norm1_g[l], 'w_in': w_in[l], 'a_conv_w': a_conv_w[l], 'a_log': a_log[l], 'a_dt_bias': a_dt_bias[l], 'a_norm_g': a_norm_g[l], 'b_conv_w': b_conv_w[l], 'c_sinks': c_sinks[l], 'd_ln_g': d_ln_g[l], 'd_ln_b': d_ln_b[l], 'd_ws': d_ws[l], 'd_bias': d_bias[l], 'w_out': w_out[l], 'norm2_g': norm2_g[l], 'ffn_w_gate': ffn_w_gate[l], 'ffn_w_up': ffn_w_up[l], 'ffn_conv_w': ffn_conv_w[l], 'ffn_w_down': ffn_w_down[l]}
        st_p = {'a_state': jnp.zeros((bp, A_HEADS, HEAD_DIM, HEAD_DIM), jnp.float32), 'a_conv': jnp.zeros((bp, A_CONV - 1, 3 * GROUP_WIDTH), dt), 'b_conv': jnp.zeros((bp, B_CONV - 1, GROUP_WIDTH), dt), 'f_conv': jnp.zeros((bp, FFN_CONV - 1, D_FF), dt)}
        hp, np_ = hybrid_layer(hp, pos_p, None, st_p, p)
        st_s = {'a_state': state_delta[l], 'a_conv': state_delta_conv[l], 'b_conv': state_shortconv[l], 'c_k': cache_win_k[l], 'c_v': cache_win_v[l], 'f_conv': state_ffn_conv[l]}
        hs, ns_ = hybrid_layer(hs, pos_s, k_pos_s, st_s, p)
        for n in names:
            new_p[n].append(np_[n])
            new_s[n].append(ns_[n])
        chunk_v_rows.append(ns_['d_v'])
    y_prompt = rmsnorm(hp, final_norm_g)
    y_sample = rmsnorm(hs, final_norm_g)
    sp = {n: jnp.stack(new_p[n]) for n in names}
    ss = {n: jnp.stack(new_s[n]) for n in names}
    chunk_v_s = jnp.stack(chunk_v_rows)
    return (y_prompt, y_sample, sp['a_state'], ss['a_state'], sp['a_conv'], ss['a_conv'], sp['b_conv'], ss['b_conv'], sp['c_k'], ss['c_k'], sp['c_v'], ss['c_v'], sp['f_conv'], ss['f_conv'], chunk_v_s)
```

```cpp
#include <hip/hip_runtime.h>
#include <hip/hip_cooperative_groups.h>
#include <cstdio>
namespace cg = cooperative_groups;

#define DEVI __device__ __forceinline__
#define LAS __attribute__((address_space(3)))
typedef unsigned short bf16_t;
typedef short bf16x8 __attribute__((ext_vector_type(8)));
typedef short bf16x4 __attribute__((ext_vector_type(4)));
typedef float f32x4 __attribute__((ext_vector_type(4)));

#ifndef ONE_LAUNCH
#define ONE_LAUNCH 0
#endif

constexpr int MP = 32768, MS = 512, M = MP + MS, DM = 1024, FF = 2816, PS = 2824  , NPAD = 3072;
constexpr int C_AQ = 0, C_AZ = 768, C_BB = 1024, C_BC = 1280, C_BH = 1536, C_CQ = 1792, C_CK = 2048, C_DU = 2304, C_DV = 2560, C_AB = 2816, C_AA = 2820;
constexpr float EPS = 1e-6f;

constexpr size_t O_YP = 0, O_YS = O_YP + (size_t)MP * DM, O_SDP = O_YS + (size_t)MS * DM, O_SDS = O_SDP + 2 * 8 * 4 * 4096, O_SCP = O_SDS + 2 * 128 * 4 * 4096,
                 O_SCS = O_SCP + 2 * 8 * 3 * 768, O_SSP = O_SCS + 2 * 128 * 3 * 768, O_SSS = O_SSP + 2 * 8 * 2 * 256, O_CKP = O_SSS + 2 * 128 * 2 * 256,
                 O_CKS = O_CKP + 2 * 8 * 128 * 128, O_CVP = O_CKS + 2 * 128 * 128 * 128, O_CVS = O_CVP + 2 * 8 * 128 * 128, O_SFP = O_CVS + 2 * 128 * 128 * 128,
                 O_SFS = O_SFP + 2 * 8 * 2 * 2816, O_CHV = O_SFS + 2 * 128 * 2 * 2816, O_END = O_CHV + 2 * 128 * 4 * 256;
static_assert(O_END == 50008064, "output size");

constexpr size_t WS_WIN = 0, WS_WOUT = WS_WIN + (size_t)2 * NPAD * 1024 * 2, WS_WGU = WS_WOUT + (size_t)2 * 1024 * 1024 * 2, WS_WDN = WS_WGU + (size_t)2 * 5632 * 1024 * 2,
                 WS_XB = WS_WDN + (size_t)2 * 1024 * 2816 * 2,
                 WS_PROJ = WS_XB + (size_t)M * 1024 * 2,
                 WS_MIX = WS_PROJ + (size_t)M * PS * 2,
                 WS_SSQA = WS_MIX + (size_t)M * 1024 * 2, WS_SSQB = WS_SSQA + (size_t)M * 16 * 4, WS_BG = WS_SSQB + (size_t)M * 16 * 4,
                 WS_GLS = WS_BG + (size_t)M * 8 * 4,
                 WS_QR = WS_GLS + 2048 * 4,
                 WS_KVR = WS_QR + (size_t)M * 256 * 2, WS_DVN = WS_KVR + (size_t)M * 256 * 2, WS_ORAW = WS_QR,
                 WS_A2 = WS_DVN + (size_t)M * 256 * 2,
                 WS_SG = WS_A2, WS_SU = WS_SG + (size_t)512 * 4 * 2816 * 4,
                 WS_END = WS_A2 + (size_t)2048 * 49152;
static_assert(WS_END <= (size_t)536870912, "workspace too large");
static_assert(WS_SU + (size_t)512 * 2 * 2816 * 4 <= WS_END, "side buffers");
static_assert((size_t)M * 256 * 4 <= (size_t)3 * M * 256 * 2, "oraw alias");

struct Args { const float* in[27]; float* out; unsigned char* ws; int coop; int ph_lo; int ph_hi; int pad; };

DEVI int tidx() { int t = threadIdx.x; asm volatile("" : "+v"(t)); return t; }
DEVI int bidx() { int t = blockIdx.x; asm volatile("" : "+s"(t)); return t; }
DEVI int gdim() { int t = gridDim.x; asm volatile("" : "+s"(t)); return t; }
DEVI float bf2f(bf16_t v) { return __uint_as_float(((unsigned)v) << 16); }
DEVI bf16_t f2bf(float f) { unsigned u = __float_as_uint(f); u += 0x7FFFu + ((u >> 16) & 1u); return (bf16_t)(u >> 16); }
DEVI unsigned pk2(float lo, float hi) { unsigned r; asm("v_cvt_pk_bf16_f32 %0, %1, %2" : "=v"(r) : "v"(lo), "v"(hi)); return r; }
DEVI f32x4 ld4bf(const bf16_t* p) { const uint2 u = *(const uint2*)p; f32x4 o; o[0] = __uint_as_float(u.x << 16); o[1] = __uint_as_float(u.x & 0xffff0000u); o[2] = __uint_as_float(u.y << 16); o[3] = __uint_as_float(u.y & 0xffff0000u); return o; }
DEVI void st4bf(bf16_t* p, f32x4 v) { uint2 u; u.x = pk2(v[0], v[1]); u.y = pk2(v[2], v[3]); *(uint2*)p = u; }
DEVI bf16x8 pack8(f32x4 a, f32x4 b) { union { uint4 u; bf16x8 v; } x; x.u.x = pk2(a[0], a[1]); x.u.y = pk2(a[2], a[3]); x.u.z = pk2(b[0], b[1]); x.u.w = pk2(b[2], b[3]); return x.v; }
DEVI uint4 pack8u(f32x4 a, f32x4 b) { uint4 u; u.x = pk2(a[0], a[1]); u.y = pk2(a[2], a[3]); u.z = pk2(b[0], b[1]); u.w = pk2(b[2], b[3]); return u; }
DEVI float wave_sum(float v) { for (int d = 1; d < 64; d <<= 1) v += __shfl_xor(v, d); return v; }
DEVI float red16(float v) { v += __shfl_xor(v, 1); v += __shfl_xor(v, 2); v += __shfl_xor(v, 4); v += __shfl_xor(v, 8); return v; }
DEVI float silu_f(float y) { return y / (1.f + __expf(-y)); }
DEVI float gelu_f(float x) { const float z = 0.7978845608028654f * (x + 0.044715f * x * x * x); return x / (1.f + __expf(-2.f * z)); }
DEVI f32x4 silu4(f32x4 v) { f32x4 o; for (int i = 0; i < 4; ++i) o[i] = silu_f(v[i]); return o; }
DEVI f32x4 gelu4(f32x4 v) { f32x4 o; for (int i = 0; i < 4; ++i) o[i] = gelu_f(v[i]); return o; }
DEVI float rdlane(float v, int l) { return __builtin_bit_cast(float, __builtin_amdgcn_readlane(__builtin_bit_cast(int, v), l)); }
DEVI void wave_lds_fence() { asm volatile("s_waitcnt lgkmcnt(0)" ::: "memory"); }
template <int CTRL> DEVI float dppf(float x) { return __builtin_bit_cast(float, __builtin_amdgcn_update_dpp(0, __builtin_bit_cast(int, x), CTRL, 0xf, 0xf, true)); }
DEVI float rowscale(const float* ssq, int r) { const f32x4* p = (const f32x4*)(ssq + (size_t)r * 16); const f32x4 a = p[0], b = p[1], c = p[2], d = p[3];
    const float s = (a[0] + a[1] + a[2] + a[3]) + (b[0] + b[1] + b[2] + b[3]) + (c[0] + c[1] + c[2] + c[3]) + (d[0] + d[1] + d[2] + d[3]); return rsqrtf(s * (1.f / 1024.f) + EPS); }
DEVI unsigned char* wsp(const Args& a) { unsigned char* p = a.ws; asm volatile("" : "+s"(p)); return p; }
DEVI float* outp(const Args& a) { float* p = a.out; asm volatile("" : "+s"(p)); return p; }
DEVI const float* inp(const Args& a, int k) { const float* p = a.in[k]; asm volatile("" : "+s"(p)); return p; }
#define MFMA16(a, b, c) __builtin_amdgcn_mfma_f32_16x16x32_bf16((a), (b), (c), 0, 0, 0)

namespace pg8 {
constexpr int BM = 256, BK = 64, HALF = 128, HTB = HALF * BK * 2, STAGE_BYTES = 8 * HTB, NXCD = 8, WGM = 8;
DEVI int lds_byte(int r, int c) { const int st = (r >> 4) * 2 + (c >> 5), rr = r & 15, cc = c & 31, ob = rr * 64 + cc * 2; return st * 1024 + (ob ^ (((ob >> 9) & 1) << 5)); }
DEVI void stage_rc(int b, int& R, int& C) { const int st = b / 1024, sb = b % 1024, swz = sb ^ (((sb >> 9) & 1) << 5); R = (st >> 1) * 16 + swz / 64; C = (st & 1) * 32 + (swz % 64) / 2; }
DEVI int perm32(int rho) { const int n = rho >> 4, i = rho & 15; return 8 * (i >> 2) + 4 * n + (i & 3); }
struct Unit { int pm, pn; };
struct Gemm { const bf16_t* A; const bf16_t* Bt; int M, N, K; };
struct StaticOrder {
    int nM, nN, nwg, G, c;
    DEVI void init(int M_, int N_, int G_, int c_) { nM = M_ / BM; nN = N_ / BM; nwg = nM * nN; G = G_; c = c_; }
    DEVI bool next(int i, Unit& u) const {
        const long L = (long)i * G + c; if (L >= nwg) return false;
        int wgid = (int)L; { const int q = nwg / NXCD, r = nwg % NXCD, xcd = wgid % NXCD, off = wgid / NXCD; wgid = (xcd < r ? xcd * (q + 1) : r * (q + 1) + (xcd - r) * q) + off; }
        const int nig = WGM * nN, gid = wgid / nig, fm = gid * WGM, gsz = (nM - fm) < WGM ? (nM - fm) : WGM;
        u.pm = fm + ((wgid % nig) % gsz); u.pn = (wgid % nig) / gsz; return true;
    }
    DEVI void a_ready(const Unit&) const {}
    DEVI void done(const Unit&) const {}
};
template <class Epi, class Sched>
DEVI void gemm_phase(LAS unsigned char* lds, const Gemm g, const Sched& S, const Epi& E) {
    const int tid = tidx(), wid = __builtin_amdgcn_readfirstlane(tid >> 6), lane = tid & 63, wr = wid >> 2, wc = wid & 3, fr = lane & 15, fq = lane >> 4;
    const int K = g.K, nt = K / BK;
    unsigned voffA[2], voffB[2];
#pragma unroll
    for (int i = 0; i < 2; ++i) { int R, C; stage_rc(tid * 16 + i * 8192, R, C); const int Rb = Epi::PERM ? ((R & ~31) + perm32(R & 31)) : R;
        voffA[i] = (unsigned)(R * K + C) * 2u; voffB[i] = (unsigned)(Rb * K + C) * 2u; }
    const size_t kstep = (size_t)(BK * 2);
    const size_t hstep = (size_t)HALF * K * 2;
    const size_t tstep = 2 * hstep;
    const unsigned ldsw = (unsigned)wid * 1024u;
    const int aoff = lds_byte(wr * 64 + fr, fq * 8), boff = lds_byte(wc * 32 + fr, fq * 8);
#define PG8_SA(b, h) (((b) * 2 + (h)) * HTB)
#define PG8_SB(b, h) ((4 + (b) * 2 + (h)) * HTB)
#define PG8_STAGE(bufoff, gbase, voff) do { _Pragma("unroll") for (int _i = 0; _i < 2; ++_i) \
        __builtin_amdgcn_global_load_lds((const unsigned*)((const char*)(gbase) + (voff)[_i]), (LAS unsigned*)(lds + (bufoff) + ldsw + _i * 8192), 16, 0, 0); } while (0)
#define PG8_LDA(dst, b, h) do { _Pragma("unroll") for (int m = 0; m < 4; ++m) _Pragma("unroll") for (int k = 0; k < 2; ++k) dst[m][k] = *(const LAS bf16x8*)(lds + PG8_SA(b, h) + aoff + m * 2048 + k * 1024); } while (0)
#define PG8_LDB(dst, b, h) do { _Pragma("unroll") for (int n = 0; n < 2; ++n) _Pragma("unroll") for (int k = 0; k < 2; ++k) dst[n][k] = *(const LAS bf16x8*)(lds + PG8_SB(b, h) + boff + n * 2048 + k * 1024); } while (0)
#define PG8_MMA(ai, bj, At, Bt) do { __builtin_amdgcn_s_setprio(1); _Pragma("unroll") for (int m = 0; m < 4; ++m) _Pragma("unroll") for (int n = 0; n < 2; ++n) _Pragma("unroll") for (int k = 0; k < 2; ++k) \
        acc[ai][bj][m][n] = __builtin_amdgcn_mfma_f32_16x16x32_bf16(Bt[n][k], At[m][k], acc[ai][bj][m][n], 0, 0, 0); __builtin_amdgcn_s_setprio(0); } while (0)
#define PG8_WAIT_V(n) asm volatile("s_waitcnt vmcnt(" #n ")" ::: "memory")
#define PG8_WAIT_L(n) asm volatile("s_waitcnt lgkmcnt(" #n ")" ::: "memory")
#define PG8_BAR __builtin_amdgcn_s_barrier()
#define PG8_SCHED __builtin_amdgcn_sched_barrier(0)
    Unit cur, nxt; int ui = 0;
    if (!S.next(0, cur)) return;
    f32x4 acc[2][2][4][2];
#pragma unroll
    for (int a = 0; a < 2; ++a)
#pragma unroll
        for (int b = 0; b < 2; ++b)
#pragma unroll
            for (int m = 0; m < 4; ++m)
#pragma unroll
                for (int n = 0; n < 2; ++n) acc[a][b][m][n] = (f32x4){0.f, 0.f, 0.f, 0.f};
    bf16x8 At[4][2], B0[2][2], B1[2][2];
    const char* cA = (const char*)g.A + (size_t)cur.pm * tstep; const char* cB = (const char*)g.Bt + (size_t)cur.pn * tstep;
    S.a_ready(cur);
    PG8_STAGE(PG8_SB(0, 0), cB, voffB); PG8_STAGE(PG8_SA(0, 0), cA, voffA); PG8_STAGE(PG8_SB(0, 1), cB + hstep, voffB); PG8_STAGE(PG8_SA(0, 1), cA + hstep, voffA);
    if (wr == 1) PG8_BAR;
    PG8_WAIT_V(4); PG8_BAR;
    PG8_STAGE(PG8_SB(1, 0), cB + kstep, voffB); PG8_STAGE(PG8_SA(1, 0), cA + kstep, voffA); PG8_STAGE(PG8_SB(1, 1), cB + hstep + kstep, voffB);
    PG8_WAIT_V(6); PG8_BAR;
    for (;;) {
        const bool has_next = S.next(ui + 1, nxt);
        const char* nA = has_next ? (const char*)g.A + (size_t)nxt.pm * tstep : cA; const char* nB = has_next ? (const char*)g.Bt + (size_t)nxt.pn * tstep : cB;
        for (int t = 0; t < nt; t += 2) {
            const bool last = (t == nt - 2);
            const char* a1 = cA + (size_t)(t + 1) * kstep;
            const char* a2 = last ? nA : cA + (size_t)(t + 2) * kstep; const char* b2 = last ? nB : cB + (size_t)(t + 2) * kstep;
            const char* a3 = a2 + kstep; const char* b3 = b2 + kstep;
            if (last && has_next) S.a_ready(nxt);
            PG8_LDB(B0, 0, 0); PG8_SCHED; PG8_LDA(At, 0, 0); PG8_STAGE(PG8_SA(1, 1), a1 + hstep, voffA);
            PG8_WAIT_L(8); PG8_BAR; PG8_WAIT_L(0); PG8_MMA(0, 0, At, B0); PG8_BAR; PG8_SCHED;
            PG8_LDB(B1, 0, 1); PG8_STAGE(PG8_SB(0, 0), b2, voffB);
            PG8_BAR; PG8_WAIT_L(0); PG8_MMA(0, 1, At, B1); PG8_BAR;
            PG8_LDA(At, 0, 1); PG8_STAGE(PG8_SA(0, 0), a2, voffA);
            PG8_BAR; PG8_WAIT_L(0); PG8_MMA(1, 0, At, B0); PG8_BAR; PG8_SCHED;
            PG8_STAGE(PG8_SB(0, 1), b2 + hstep, voffB);
            PG8_WAIT_V(6); PG8_BAR; PG8_MMA(1, 1, At, B1); PG8_BAR;
            PG8_LDB(B0, 1, 0); PG8_SCHED; PG8_LDA(At, 1, 0); PG8_STAGE(PG8_SA(0, 1), a2 + hstep, voffA);
            PG8_WAIT_L(8); PG8_BAR; PG8_WAIT_L(0); PG8_MMA(0, 0, At, B0); PG8_BAR; PG8_SCHED;
            PG8_LDB(B1, 1, 1); PG8_STAGE(PG8_SB(1, 0), b3, voffB);
            PG8_BAR; PG8_WAIT_L(0); PG8_MMA(0, 1, At, B1); PG8_BAR;
            PG8_LDA(At, 1, 1); PG8_STAGE(PG8_SA(1, 0), a3, voffA);
            PG8_BAR; PG8_WAIT_L(0); PG8_MMA(1, 0, At, B0); PG8_BAR; PG8_SCHED;
            PG8_STAGE(PG8_SB(1, 1), b3 + hstep, voffB);
            PG8_WAIT_V(6); PG8_BAR; PG8_MMA(1, 1, At, B1); PG8_BAR;
        }
        E(acc, cur, wr, wc, fr, fq); S.done(cur);
        if (!has_next) break;
#pragma unroll
        for (int a = 0; a < 2; ++a)
#pragma unroll
            for (int b = 0; b < 2; ++b)
#pragma unroll
                for (int m = 0; m < 4; ++m)
#pragma unroll
                    for (int n = 0; n < 2; ++n) acc[a][b][m][n] = (f32x4){0.f, 0.f, 0.f, 0.f};
        cur = nxt; cA = nA; cB = nB; ++ui;
    }
    PG8_WAIT_V(0);
    if (wr == 0) PG8_BAR;
    PG8_BAR;
#undef PG8_SA
#undef PG8_SB
#undef PG8_STAGE
#undef PG8_LDA
#undef PG8_LDB
#undef PG8_MMA
#undef PG8_WAIT_V
#undef PG8_WAIT_L
#undef PG8_BAR
#undef PG8_SCHED
}
}
using pg8::Unit;

struct EpiProj {
    static constexpr bool PERM = true;
    bf16_t* P; const float* ssq;
    DEVI void operator()(const f32x4 (&acc)[2][2][4][2], const Unit& u, int wr, int wc, int fr, int fq) const {
        const int row0 = u.pm * 256 + wr * 64 + fr, colb = u.pn * 256 + wc * 32 + 8 * fq;
#pragma unroll
        for (int ai = 0; ai < 2; ++ai)
#pragma unroll
            for (int m = 0; m < 4; ++m) { const int r = row0 + ai * 128 + m * 16; const float sc = rowscale(ssq, r);
#pragma unroll
                for (int bj = 0; bj < 2; ++bj) { const int c = colb + bj * 128;
                    if (c < PS) *(uint4*)(P + (size_t)r * PS + c) = pack8u(acc[ai][bj][m][0] * sc, acc[ai][bj][m][1] * sc); } }
    }
};
struct EpiRes {
    static constexpr bool PERM = true;
    const float* res_p; const float* res_s; float* xf; bf16_t* xb; float* ssq;
    DEVI void operator()(const f32x4 (&acc)[2][2][4][2], const Unit& u, int wr, int wc, int fr, int fq) const {
        const int row0 = u.pm * 256 + wr * 64 + fr, colb = u.pn * 256 + wc * 32 + 8 * fq;
#pragma unroll
        for (int ai = 0; ai < 2; ++ai)
#pragma unroll
            for (int m = 0; m < 4; ++m) { const int r = row0 + ai * 128 + m * 16;
                const float* rp = (r < MP) ? res_p + (size_t)r * DM : res_s + (size_t)(r - MP) * DM; float part = 0.f;
#pragma unroll
                for (int bj = 0; bj < 2; ++bj) { const int c = colb + bj * 128;
                    const f32x4 v0 = acc[ai][bj][m][0] + *(const f32x4*)(rp + c), v1 = acc[ai][bj][m][1] + *(const f32x4*)(rp + c + 4);
                    *(f32x4*)(xf + (size_t)r * DM + c) = v0; *(f32x4*)(xf + (size_t)r * DM + c + 4) = v1;
                    *(uint4*)(xb + (size_t)r * DM + c) = pack8u(v0, v1);
                    part += v0[0] * v0[0] + v0[1] * v0[1] + v0[2] * v0[2] + v0[3] * v0[3] + v1[0] * v1[0] + v1[1] * v1[1] + v1[2] * v1[2] + v1[3] * v1[3]; }
                part += __shfl_xor(part, 16); part += __shfl_xor(part, 32);
                if (fq == 0) ssq[(size_t)r * 16 + u.pn * 4 + wc] = part; }
    }
};
struct EpiGU {
    static constexpr bool PERM = true;
    bf16_t* act; const float* ssq; const float* cw; const float* st; float* sg; float* su; float* osfp; float* osfs;
    DEVI void operator()(const f32x4 (&acc)[2][2][4][2], const Unit& u, int wr, int wc, int fr, int fq) const {
        const int f0 = u.pn * 128 + wc * 32 + 8 * fq;
        const f32x4 w0a = *(const f32x4*)(cw + f0), w0b = *(const f32x4*)(cw + f0 + 4), w1a = *(const f32x4*)(cw + FF + f0), w1b = *(const f32x4*)(cw + FF + f0 + 4),
                    w2a = *(const f32x4*)(cw + 2 * FF + f0), w2b = *(const f32x4*)(cw + 2 * FF + f0 + 4);
        const bool smp = u.pm >= 128;
#pragma unroll
        for (int ai = 0; ai < 2; ++ai) {
            const int rb = u.pm * 256 + ai * 128 + wr * 64;
            f32x4 gpa[4], gpb[4]; float scs[4];
#pragma unroll
            for (int m = 0; m < 4; ++m) { scs[m] = rowscale(ssq, rb + 16 * m + fr); gpa[m] = acc[ai][0][m][0] * scs[m]; gpb[m] = acc[ai][0][m][1] * scs[m]; }
#pragma unroll
            for (int m = 0; m < 4; ++m) {
                const int r = rb + 16 * m + fr;
                const f32x4 ua = acc[ai][1][m][0] * scs[m], ub = acc[ai][1][m][1] * scs[m];
                f32x4 p1a, p1b, p2a, p2b;
#pragma unroll
                for (int jj = 0; jj < 4; ++jj) {
                    const float ca = gpa[m][jj], cb = gpb[m][jj], pa = m > 0 ? gpa[m > 0 ? m - 1 : 0][jj] : 0.f, pb = m > 0 ? gpb[m > 0 ? m - 1 : 0][jj] : 0.f;
                    const float a1 = dppf<0x111>(ca), a2 = dppf<0x112>(ca), b1 = dppf<0x10F>(pa), b2 = dppf<0x10E>(pa);
                    p1a[jj] = fr >= 1 ? a1 : b1; p2a[jj] = fr >= 2 ? a2 : b2;
                    const float c1 = dppf<0x111>(cb), c2 = dppf<0x112>(cb), d1 = dppf<0x10F>(pb), d2 = dppf<0x10E>(pb);
                    p1b[jj] = fr >= 1 ? c1 : d1; p2b[jj] = fr >= 2 ? c2 : d2;
                }
                if (smp) {
                    const int t = fr & 3, bb = (r - MP) >> 2; const float* sp = st + (size_t)bb * 2 * FF + f0;
                    if (t == 0) { p2a = *(const f32x4*)sp; p2b = *(const f32x4*)(sp + 4); p1a = *(const f32x4*)(sp + FF); p1b = *(const f32x4*)(sp + FF + 4); }
                    else if (t == 1) { p2a = *(const f32x4*)(sp + FF); p2b = *(const f32x4*)(sp + FF + 4); }
                    if (t >= 2) { float* o = osfs + ((size_t)bb * 2 + (t - 2)) * FF + f0; *(f32x4*)o = gpa[m]; *(f32x4*)(o + 4) = gpb[m]; }
                }
                const bool head = !smp && m == 0 && fr < 2;
                if (!head) {
                    const f32x4 ga = w0a * p2a + w1a * p1a + w2a * gpa[m], gb = w0b * p2b + w1b * p1b + w2b * gpb[m];
                    *(uint4*)(act + (size_t)r * FF + f0) = pack8u(silu4(ga) * ua, silu4(gb) * ub);
                }
                if (!smp) {
                    const int blk = rb >> 6;
                    if (m == 0 && fr < 2) { float* o = sg + ((size_t)blk * 4 + fr) * FF + f0; *(f32x4*)o = gpa[m]; *(f32x4*)(o + 4) = gpb[m];
                        float* o2 = su + ((size_t)blk * 2 + fr) * FF + f0; *(f32x4*)o2 = ua; *(f32x4*)(o2 + 4) = ub; }
                    if (m == 3 && fr >= 14) { float* o = sg + ((size_t)blk * 4 + 2 + (fr - 14)) * FF + f0; *(f32x4*)o = gpa[m]; *(f32x4*)(o + 4) = gpb[m];
                        const int t = r & 4095; if (t >= 4094) { float* o3 = osfp + ((size_t)(r >> 12) * 2 + (t - 4094)) * FF + f0; *(f32x4*)o3 = gpa[m]; *(f32x4*)(o3 + 4) = gpb[m]; } }
                }
            }
        }
    }
};

__device__ void phase_prep(const Args& a, unsigned char* smem) {
    float* tile = (float*)smem;
    const int tid = tidx(), tx = tid & 63, ty = tid >> 6, lane = tid & 63, wid = tid >> 6;
    constexpr int T_IN = 48 * 16, T_OUT = 16 * 16, T_GU = 88 * 16, T_DN = 16 * 44, T_L = T_IN + T_OUT + T_GU + T_DN;
    for (int it = bidx(); it < 2 * T_L; it += gdim()) {
        const int l = it / T_L; int r = it % T_L;
        const float* src; int ld, col, kt, nt, Kd; const float* gk = nullptr; bf16_t* dst;
        if (r < T_IN) { nt = r / 16; kt = r % 16; Kd = 1024; ld = PS; src = inp(a, 9) + (size_t)l * 1024 * PS; gk = inp(a, 8) + l * 1024; dst = (bf16_t*)(wsp(a) + WS_WIN) + (size_t)l * NPAD * 1024;
            const int n = nt * 64 + tx; col = n < 1024 ? n : (n < 2816 ? n + 8 : (n < 2824 ? 1024 + (n - 2816) : -1)); }
        else if ((r -= T_IN) < T_OUT) { nt = r / 16; kt = r % 16; Kd = 1024; ld = 1024; src = inp(a, 20) + (size_t)l * 1024 * 1024; dst = (bf16_t*)(wsp(a) + WS_WOUT) + (size_t)l * 1024 * 1024; col = nt * 64 + tx; }
        else if ((r -= T_OUT) < T_GU) { nt = r / 16; kt = r % 16; Kd = 1024; ld = FF; gk = inp(a, 21) + l * 1024; dst = (bf16_t*)(wsp(a) + WS_WGU) + (size_t)l * 5632 * 1024;
            const int n = nt * 64, pn = n >> 8, cc = n & 255; src = (cc < 128 ? inp(a, 22) : inp(a, 23)) + (size_t)l * 1024 * FF; col = pn * 128 + (cc & 127) + tx; }
        else { r -= T_GU; nt = r / 44; kt = r % 44; Kd = FF; ld = 1024; src = inp(a, 25) + (size_t)l * FF * 1024; dst = (bf16_t*)(wsp(a) + WS_WDN) + (size_t)l * 1024 * FF; col = nt * 64 + tx; }
        for (int i = ty; i < 64; i += 8) { const int k = kt * 64 + i; float v = 0.f; if (col >= 0) { v = src[(size_t)k * ld + col]; if (gk) v *= gk[k]; } tile[i * 65 + tx] = v; }
        __syncthreads();
        for (int i = ty; i < 64; i += 8) dst[(size_t)(nt * 64 + i) * Kd + kt * 64 + tx] = f2bf(tile[tx * 65 + i]);
        __syncthreads();
    }
    bf16_t* xb = (bf16_t*)(wsp(a) + WS_XB); float* ssq = (float*)(wsp(a) + WS_SSQA);
    for (int r = bidx() * 8 + wid; r < M; r += gdim() * 8) {
        const float* xr = (r < MP) ? inp(a, 0) + (size_t)r * DM : inp(a, 1) + (size_t)(r - MP) * DM; float ss = 0.f;
#pragma unroll
        for (int q = 0; q < 4; ++q) { const f32x4 v = *(const f32x4*)(xr + q * 256 + lane * 4); ss += v[0] * v[0] + v[1] * v[1] + v[2] * v[2] + v[3] * v[3]; st4bf(xb + (size_t)r * DM + q * 256 + lane * 4, v); }
        ss = wave_sum(ss);
        if (lane < 16) ssq[(size_t)r * 16 + lane] = lane == 0 ? ss : 0.f;
    }
}

__device__ void phase_tok(const Args& a, const int l) {
    const int lane = tidx() & 63, wid = tidx() >> 6, c4 = lane * 4;
    const bf16_t* proj = (const bf16_t*)(wsp(a) + WS_PROJ);
    bf16_t* qkvn = (bf16_t*)(wsp(a) + WS_XB); bf16_t* mix = (bf16_t*)(wsp(a) + WS_MIX); float* bg = (float*)(wsp(a) + WS_BG);
    bf16_t* qr = (bf16_t*)(wsp(a) + WS_QR); bf16_t* kvr = (bf16_t*)(wsp(a) + WS_KVR); bf16_t* dvn = (bf16_t*)(wsp(a) + WS_DVN);
    float* out = outp(a);
    const float* cwp = inp(a, 10) + (size_t)l * 4 * 768 + c4;
    f32x4 bw[3];
#pragma unroll
    for (int j = 0; j < 3; ++j) bw[j] = *(const f32x4*)(inp(a, 14) + (size_t)l * 3 * 256 + j * 256 + c4);
    const f32x4 lng = *(const f32x4*)(inp(a, 16) + l * 256 + c4), lnb = *(const f32x4*)(inp(a, 17) + l * 256 + c4);
    float inv[4];
#pragma unroll
    for (int e = 0; e < 4; ++e) inv[e] = powf(500000.f, -(float)(4 * (lane & 1) + e) * 0.125f);
    const int j16 = lane & 15, gD = lane >> 4;
    const float* Wd = inp(a, 18) + ((size_t)(l * 4 + gD) * 128) * 128; const float* biasd = inp(a, 19) + (size_t)(l * 4 + gD) * 128;
    for (int run = bidx() * 8 + wid; run < 2048 + 128; run += gdim() * 8) {
        const bool smp = run >= 2048;
        int b, t0, ntok, pos0; size_t r0;
        if (!smp) { b = run >> 8; t0 = (run & 255) * 16; ntok = 16; r0 = (size_t)b * 4096 + t0; pos0 = t0; }
        else { b = run - 2048; t0 = 0; ntok = 4; r0 = (size_t)MP + 4 * b; pos0 = 16384; }
        f32x4 ha[3][3], hb[2];
        const f32x4 z4 = {0.f, 0.f, 0.f, 0.f};
        if (smp) {
            const float* st = inp(a, 3) + ((size_t)(l * 128 + b) * 3) * 768;
#pragma unroll
            for (int p = 0; p < 3; ++p)
#pragma unroll
                for (int j = 0; j < 3; ++j) ha[p][j] = *(const f32x4*)(st + j * 768 + p * 256 + c4);
            const float* sb = inp(a, 4) + ((size_t)(l * 128 + b) * 2) * 256; hb[0] = *(const f32x4*)(sb + c4); hb[1] = *(const f32x4*)(sb + 256 + c4);
            const float* ck = inp(a, 5) + (size_t)(l * 128 + b) * 16384; const float* cv = inp(a, 6) + (size_t)(l * 128 + b) * 16384;
            float* ok = out + O_CKS + (size_t)(l * 128 + b) * 16384; float* ov = out + O_CVS + (size_t)(l * 128 + b) * 16384;
            for (int i = lane; i < 3968; i += 64) { *(f32x4*)(ok + i * 4) = *(const f32x4*)(ck + 512 + i * 4); *(f32x4*)(ov + i * 4) = *(const f32x4*)(cv + 512 + i * 4); }
        } else if (t0 == 0) {
#pragma unroll
            for (int p = 0; p < 3; ++p)
#pragma unroll
                for (int j = 0; j < 3; ++j) ha[p][j] = z4;
            hb[0] = z4; hb[1] = z4;
        } else {
#pragma unroll
            for (int p = 0; p < 3; ++p)
#pragma unroll
                for (int j = 0; j < 3; ++j) ha[p][j] = ld4bf(proj + (r0 - 3 + j) * PS + C_AQ + p * 256 + c4);
#pragma unroll
            for (int j = 0; j < 2; ++j) hb[j] = ld4bf(proj + (r0 - 2 + j) * PS + C_BC + c4) * ld4bf(proj + (r0 - 2 + j) * PS + C_BH + c4);
        }
        f32x4 h0 = z4, h1 = z4, h2 = z4, h3 = z4;
#pragma unroll 1
        for (int i = 0; i < ntok; ++i) {
            const size_t r = r0 + i; const bf16_t* pr = proj + r * PS; const int t = t0 + i;
#pragma unroll
            for (int p = 0; p < 3; ++p) {
                const f32x4 cur = ld4bf(pr + C_AQ + p * 256 + c4);
                f32x4 s = silu4(*(const f32x4*)(cwp + p * 256) * ha[p][0] + *(const f32x4*)(cwp + 768 + p * 256) * ha[p][1] + *(const f32x4*)(cwp + 1536 + p * 256) * ha[p][2] + *(const f32x4*)(cwp + 2304 + p * 256) * cur);
                ha[p][0] = ha[p][1]; ha[p][1] = ha[p][2]; ha[p][2] = cur;
                if (p < 2) { float ss = red16(s[0] * s[0] + s[1] * s[1] + s[2] * s[2] + s[3] * s[3]); const float sc = rsqrtf(ss + EPS) * (p == 0 ? 0.125f : 1.f); s = s * sc; }
                st4bf(qkvn + r * 768 + p * 256 + c4, s);
                if (!smp) { if (t >= 4093) *(f32x4*)(out + O_SCP + ((size_t)(l * 8 + b) * 3 + (t - 4093)) * 768 + p * 256 + c4) = cur; }
                else if (i >= 1) *(f32x4*)(out + O_SCS + ((size_t)(l * 128 + b) * 3 + (i - 1)) * 768 + p * 256 + c4) = cur;
            }
            if (lane < 4) {
                const float ab = bf2f(pr[C_AB + lane]), aa = bf2f(pr[C_AA + lane]);
                const float beta = 1.f / (1.f + __expf(-ab)); const float x = aa + inp(a, 12)[l * 4 + lane]; const float sp = x > 20.f ? x : log1pf(__expf(x));
                bg[r * 8 + lane] = beta; bg[r * 8 + 4 + lane] = -__expf(inp(a, 11)[l * 4 + lane]) * sp;
            }
            {
                const f32x4 s = ld4bf(pr + C_BC + c4) * ld4bf(pr + C_BH + c4), bb = ld4bf(pr + C_BB + c4);
                const f32x4 bx = bw[0] * hb[0] + bw[1] * hb[1] + bw[2] * s;
                st4bf(mix + r * DM + 256 + c4, bb * bx); hb[0] = hb[1]; hb[1] = s;
                if (!smp) { if (t >= 4094) *(f32x4*)(out + O_SSP + ((size_t)(l * 8 + b) * 2 + (t - 4094)) * 256 + c4) = s; }
                else if (i >= 2) *(f32x4*)(out + O_SSS + ((size_t)(l * 128 + b) * 2 + (i - 2)) * 256 + c4) = s;
            }
            {
                f32x4 q = ld4bf(pr + C_CQ + c4), kv = ld4bf(pr + C_CK + c4), qo, ko;
#pragma unroll
                for (int e = 0; e < 4; ++e) { qo[e] = __shfl_xor(q[e], 2); ko[e] = __shfl_xor(kv[e], 2); }
                const float posf = (float)(pos0 + i);
                if (j16 < 4) {
                    const float sgn = j16 < 2 ? -1.f : 1.f;
#pragma unroll
                    for (int e = 0; e < 4; ++e) {
                        const float ang = posf * inv[e]; const double rd = (double)ang * 0.15915494309189535; const float rr = (float)((rd - floor(rd)) * 6.283185307179586);
                        const float cs = __cosf(rr), sn = __sinf(rr);
                        q[e] = q[e] * cs + sgn * qo[e] * sn;
                        if (lane < 32) kv[e] = kv[e] * cs + sgn * ko[e] * sn;
                    }
                }
                st4bf(qr + r * 256 + c4, q); st4bf(kvr + r * 256 + c4, kv);
                if (!smp) { if (t >= 3968) { float* o = (lane < 32 ? out + O_CKP : out + O_CVP) + ((size_t)(l * 8 + b) * 128 + (t - 3968)) * 128 + (c4 & 127); *(f32x4*)o = kv; } }
                else { float* o = (lane < 32 ? out + O_CKS : out + O_CVS) + ((size_t)(l * 128 + b) * 128 + 124 + i) * 128 + (c4 & 127); *(f32x4*)o = kv; }
            }
            {
                const f32x4 x = gelu4(ld4bf(pr + C_DV + c4));
                const float mean = wave_sum(x[0] + x[1] + x[2] + x[3]) * (1.f / 256.f);
                const f32x4 xc = x - mean;
                const float var = wave_sum(xc[0] * xc[0] + xc[1] * xc[1] + xc[2] * xc[2] + xc[3] * xc[3]) * (1.f / 256.f);
                const f32x4 y = xc * rsqrtf(var + EPS) * lng + lnb;
                st4bf(dvn + r * 256 + c4, y);
                if (smp) {
                    *(f32x4*)(out + O_CHV + ((size_t)(l * 128 + b) * 4 + i) * 256 + c4) = y;
                    if (i == 0) h0 = y; else if (i == 1) h1 = y; else if (i == 2) h2 = y; else h3 = y;
                    f32x4 mx = Wd[i * 128 + 0] * h0 + biasd[i];
                    if (i >= 1) mx = mx + Wd[i * 128 + 1] * h1;
                    if (i >= 2) mx = mx + Wd[i * 128 + 2] * h2;
                    if (i >= 3) mx = mx + Wd[i * 128 + 3] * h3;
                    st4bf(mix + r * DM + 768 + c4, gelu4(ld4bf(pr + C_DU + c4)) * mx);
                }
            }
        }
    }
}

constexpr int A2_LDS = 64 * 68 * 4 + 512;
DEVI int fragidx(int row, int col) { return (((row >> 4) * 2 + (col >> 5)) * 64 + ((col >> 2) & 3) * 16 + (row & 15)) * 8 + 4 * ((col >> 4) & 1) + (col & 3); }
__device__ void a2_item(const Args& a, const int it, unsigned char* wl) {
    const int lane = tidx() & 63, fr = lane & 15, fq = lane >> 4;
    float* Aw = (float*)wl; float* gcs = Aw + 64 * 68; float* bts = gcs + 64;
    const int h = it & 3, n = (it >> 2) & 63, b = it >> 8;
    const size_t t0 = (size_t)b * 4096 + n * 64;
    const float* bg = (const float*)(wsp(a) + WS_BG); const bf16_t* qkvn = (const bf16_t*)(wsp(a) + WS_XB);
    float gcv = bg[(t0 + lane) * 8 + 4 + h]; const float bt = bg[(t0 + lane) * 8 + h];
    for (int d = 1; d < 64; d <<= 1) { const float o = __shfl_up(gcv, d); if (lane >= d) gcv += o; }
    const float gl = __shfl(gcv, 63);
    gcs[lane] = gcv; bts[lane] = bt;
    const bf16_t* qb = qkvn + t0 * 768 + h * 64; const bf16_t* kb = qb + 256; const bf16_t* vb = qb + 512;
    bf16x8 kf[4][2], qf[4][2];
#pragma unroll
    for (int m = 0; m < 4; ++m)
#pragma unroll
        for (int kk = 0; kk < 2; ++kk) { kf[m][kk] = *(const bf16x8*)(kb + (size_t)(16 * m + fr) * 768 + 32 * kk + 8 * fq); qf[m][kk] = *(const bf16x8*)(qb + (size_t)(16 * m + fr) * 768 + 32 * kk + 8 * fq); }
    wave_lds_fence();
    unsigned char* cbase = wsp(a) + WS_A2 + (size_t)it * 49152;
    if (lane == 0) ((float*)(wsp(a) + WS_GLS))[it] = gl;
#pragma unroll
    for (int m = 0; m < 4; ++m) {
        const int i = 16 * m + fr; const float gi = gcs[i], bi = bts[i];
#pragma unroll
        for (int k2 = 0; k2 < 2; ++k2) {
            f32x4 ak[2], aq[2];
#pragma unroll
            for (int hh = 0; hh < 2; ++hh) {
                const int nn = 2 * k2 + hh;
                ak[hh] = (f32x4){0.f, 0.f, 0.f, 0.f}; aq[hh] = (f32x4){0.f, 0.f, 0.f, 0.f};
                if (nn <= m) {
#pragma unroll
                    for (int kk = 0; kk < 2; ++kk) { ak[hh] = MFMA16(kf[nn][kk], kf[m][kk], ak[hh]); aq[hh] = MFMA16(kf[nn][kk], qf[m][kk], aq[hh]); }
                    const f32x4 gj = *(const f32x4*)(gcs + 16 * nn + 4 * fq);
#pragma unroll
                    for (int jj = 0; jj < 4; ++jj) { const int j = 16 * nn + 4 * fq + jj; const float e = __expf(fminf(gi - gj[jj], 0.f));
                        ak[hh][jj] = (j < i) ? bi * ak[hh][jj] * e : 0.f; aq[hh][jj] = (j <= i) ? aq[hh][jj] * e : 0.f; }
                }
                *(f32x4*)(Aw + i * 68 + 16 * nn + 4 * fq) = ak[hh];
            }
            *(uint4*)(cbase + ((m * 2 + k2) * 64 + lane) * 16) = pack8u(aq[0], aq[1]);
        }
    }
#pragma unroll
    for (int m = 0; m < 4; ++m)
#pragma unroll
        for (int kk = 0; kk < 2; ++kk) { const int i = 16 * m + fr; const float e = __expf(gcs[i]);
            const f32x4 lo = ld4bf(qb + (size_t)i * 768 + 32 * kk + 4 * fq) * e, hi = ld4bf(qb + (size_t)i * 768 + 32 * kk + 16 + 4 * fq) * e;
            *(uint4*)(cbase + 16384 + ((m * 2 + kk) * 64 + lane) * 16) = pack8u(lo, hi); }
    wave_lds_fence();
    const int c = lane;
    bf16_t* wF = (bf16_t*)(cbase + 8192); bf16_t* kdF = (bf16_t*)(cbase + 24576); float* uS = (float*)(cbase + 32768);
    {
        float U[64];
#pragma unroll
        for (int i = 0; i < 64; ++i) {
            const float vi = bf2f(vb[(size_t)i * 768 + c]);
            float su = bts[i] * vi;
#pragma unroll
            for (int j0 = 0; j0 < i; j0 += 4) { const f32x4 a4 = *(const f32x4*)(Aw + i * 68 + j0);
#pragma unroll
                for (int jj = 0; jj < 4; ++jj) if (j0 + jj < i) su -= a4[jj] * U[j0 + jj]; }
            U[i] = su;
            uS[(((c >> 4) * 4 + (i >> 4)) * 64 + ((i >> 2) & 3) * 16 + (c & 15)) * 4 + (i & 3)] = su;
            asm volatile("" ::: "memory");
        }
    }
    {
        float W[64];
#pragma unroll
        for (int i = 0; i < 64; ++i) {
            const float ki = bf2f(kb[(size_t)i * 768 + c]);
            const float bi = bts[i], gi = gcs[i];
            float sw = bi * __expf(gi) * ki;
#pragma unroll
            for (int j0 = 0; j0 < i; j0 += 4) { const f32x4 a4 = *(const f32x4*)(Aw + i * 68 + j0);
#pragma unroll
                for (int jj = 0; jj < 4; ++jj) if (j0 + jj < i) sw -= a4[jj] * W[j0 + jj]; }
            W[i] = sw;
            kdF[fragidx(c, i)] = f2bf(ki * __expf(gl - gi));
            wF[fragidx(i, c)] = f2bf(sw);
            asm volatile("" ::: "memory");
        }
    }
}

__device__ void sdelta_item(const Args& a, const int l, const int it) {
    const int lane = tidx() & 63, h = it & 3, b = it >> 2;
    const float* S0 = inp(a, 2) + ((size_t)(l * 128 + b) * 4 + h) * 4096;
    const float* bg = (const float*)(wsp(a) + WS_BG); const bf16_t* qkvn = (const bf16_t*)(wsp(a) + WS_XB); float* oraw = (float*)(wsp(a) + WS_ORAW);
    float S[64];
#pragma unroll
    for (int i = 0; i < 64; ++i) S[i] = S0[i * 64 + lane];
    for (int t = 0; t < 4; ++t) {
        const size_t r = (size_t)MP + 4 * b + t; const bf16_t* p = qkvn + r * 768 + h * 64 + lane;
        const float qv = bf2f(p[0]), kv = bf2f(p[256]), vv = bf2f(p[512]); const float beta = bg[r * 8 + h], eg = __expf(bg[r * 8 + 4 + h]);
        float rr = 0.f;
#pragma unroll
        for (int i = 0; i < 64; ++i) { S[i] *= eg; rr += rdlane(kv, i) * S[i]; }
        const float cc = beta * (vv - rr); float oo = 0.f;
#pragma unroll
        for (int i = 0; i < 64; ++i) { S[i] += rdlane(kv, i) * cc; oo += rdlane(qv, i) * S[i]; }
        oraw[r * 256 + h * 64 + lane] = oo;
    }
    float* So = outp(a) + O_SDS + ((size_t)(l * 128 + b) * 4 + h) * 4096;
#pragma unroll
    for (int i = 0; i < 64; ++i) So[i * 64 + lane] = S[i];
}

__device__ void sattn_item(const Args& a, const int l, const int it) {
    const int lane = tidx() & 63, hq = it & 3, b = it >> 2, kvh = hq >> 1;
    const float* ck = inp(a, 5) + (size_t)(l * 128 + b) * 16384 + kvh * 64; const float* cv = inp(a, 6) + (size_t)(l * 128 + b) * 16384 + kvh * 64;
    const bf16_t* qr = (const bf16_t*)(wsp(a) + WS_QR); const bf16_t* kvr = (const bf16_t*)(wsp(a) + WS_KVR); bf16_t* mix = (bf16_t*)(wsp(a) + WS_MIX);
    const size_t r0 = (size_t)MP + 4 * b;
    float qv[4];
#pragma unroll
    for (int i = 0; i < 4; ++i) qv[i] = bf2f(qr[(r0 + i) * 256 + hq * 64 + lane]);
    float s[3][4];
#pragma unroll
    for (int sl = 0; sl < 3; ++sl) {
        float acc0 = 0.f, acc1 = 0.f, acc2 = 0.f, acc3 = 0.f;
        if (sl < 2) { const float* kp = ck + (size_t)(sl * 64 + lane) * 128;
#pragma unroll
            for (int d4 = 0; d4 < 16; ++d4) { const f32x4 kx = *(const f32x4*)(kp + d4 * 4);
#pragma unroll
                for (int e = 0; e < 4; ++e) { const int d = d4 * 4 + e; acc0 += rdlane(qv[0], d) * kx[e]; acc1 += rdlane(qv[1], d) * kx[e]; acc2 += rdlane(qv[2], d) * kx[e]; acc3 += rdlane(qv[3], d) * kx[e]; } }
        } else { const bf16_t* kp = kvr + (r0 + (lane & 3)) * 256 + kvh * 64;
#pragma unroll
            for (int d4 = 0; d4 < 16; ++d4) { const f32x4 kx = ld4bf(kp + d4 * 4);
#pragma unroll
                for (int e = 0; e < 4; ++e) { const int d = d4 * 4 + e; acc0 += rdlane(qv[0], d) * kx[e]; acc1 += rdlane(qv[1], d) * kx[e]; acc2 += rdlane(qv[2], d) * kx[e]; acc3 += rdlane(qv[3], d) * kx[e]; } }
        }
        s[sl][0] = acc0; s[sl][1] = acc1; s[sl][2] = acc2; s[sl][3] = acc3;
    }
    const float sink = inp(a, 15)[l * 4 + hq];
    float inv[4];
#pragma unroll
    for (int i = 0; i < 4; ++i) {
        const bool v0 = lane > i, v1 = true, v2 = lane <= i && lane < 4;
        const float x0 = v0 ? s[0][i] * 0.125f : -1e30f, x1 = v1 ? s[1][i] * 0.125f : -1e30f, x2 = v2 ? s[2][i] * 0.125f : -1e30f;
        float mx = fmaxf(fmaxf(x0, x1), x2);
        for (int d = 1; d < 64; d <<= 1) mx = fmaxf(mx, __shfl_xor(mx, d));
        mx = fmaxf(mx, sink);
        const float p0 = v0 ? __expf(x0 - mx) : 0.f, p1 = __expf(x1 - mx), p2 = v2 ? __expf(x2 - mx) : 0.f;
        const float sum = wave_sum(p0 + p1 + p2) + __expf(sink - mx);
        s[0][i] = p0; s[1][i] = p1; s[2][i] = p2; inv[i] = 1.f / sum;
    }
    float o[4] = {0.f, 0.f, 0.f, 0.f};
#pragma unroll
    for (int sl = 0; sl < 2; ++sl)
        for (int jj = 0; jj < 64; ++jj) { const float vv = cv[(size_t)(sl * 64 + jj) * 128 + lane];
#pragma unroll
            for (int i = 0; i < 4; ++i) o[i] += rdlane(s[sl][i], jj) * vv; }
#pragma unroll
    for (int jj = 0; jj < 4; ++jj) { const float vv = bf2f(kvr[(r0 + jj) * 256 + 128 + kvh * 64 + lane]);
#pragma unroll
        for (int i = 0; i < 4; ++i) o[i] += rdlane(s[2][i], jj) * vv; }
#pragma unroll
    for (int i = 0; i < 4; ++i) mix[(r0 + i) * DM + 512 + hq * 64 + lane] = f2bf(o[i] * inv[i]);
}

__device__ void c_item(const Args& a, const int l, const int it, unsigned char* smem) {
    const int tid = tidx(), lane = tid & 63, w = tid >> 6, fr = lane & 15, fq = lane >> 4;
    const int qb = it & 63, kvh = (it >> 6) & 1, b = it >> 7;
    bf16_t* Ks = (bf16_t*)smem; bf16_t* Vt = Ks + 192 * 72;
    const bf16_t* kvr = (const bf16_t*)(wsp(a) + WS_KVR); const bf16_t* qr = (const bf16_t*)(wsp(a) + WS_QR); bf16_t* mix = (bf16_t*)(wsp(a) + WS_MIX);
    const int kp0 = 64 * qb - 128;
    for (int id = tid; id < 1536; id += 512) { const int row = id >> 3, c8 = id & 7, kp = kp0 + row; uint4 kq = {0u, 0u, 0u, 0u}, vq = {0u, 0u, 0u, 0u};
        if (kp >= 0) { const bf16_t* src = kvr + ((size_t)b * 4096 + kp) * 256 + kvh * 64 + c8 * 8; kq = *(const uint4*)src; vq = *(const uint4*)(src + 128); }
        *(uint4*)(Ks + row * 72 + c8 * 8) = kq; bf16_t* vd = Vt + (c8 * 8) * 200 + row;
        vd[0] = (bf16_t)(vq.x & 0xffffu); vd[200] = (bf16_t)(vq.x >> 16); vd[400] = (bf16_t)(vq.y & 0xffffu); vd[600] = (bf16_t)(vq.y >> 16);
        vd[800] = (bf16_t)(vq.z & 0xffffu); vd[1000] = (bf16_t)(vq.z >> 16); vd[1200] = (bf16_t)(vq.w & 0xffffu); vd[1400] = (bf16_t)(vq.w >> 16); }
    __syncthreads();
    const int hq = 2 * kvh + (w >> 2), wq = w & 3, qrow0 = 64 * qb + 16 * wq, kb = 16 * wq;
    const bf16_t* qp = qr + ((size_t)b * 4096 + qrow0 + fr) * 256 + hq * 64 + 8 * fq;
    const bf16x8 qf0 = *(const bf16x8*)qp, qf1 = *(const bf16x8*)(qp + 32);
    f32x4 s[9];
#pragma unroll
    for (int nn = 0; nn < 9; ++nn) { const bf16_t* kr = Ks + (kb + 16 * nn + fr) * 72 + 8 * fq; s[nn] = (f32x4){0.f, 0.f, 0.f, 0.f};
        s[nn] = MFMA16(*(const bf16x8*)kr, qf0, s[nn]); s[nn] = MFMA16(*(const bf16x8*)(kr + 32), qf1, s[nn]); }
    const int tq = qrow0 + fr; const float sink = inp(a, 15)[l * 4 + hq];
    float mx = sink;
#pragma unroll
    for (int nn = 0; nn < 9; ++nn)
#pragma unroll
        for (int jj = 0; jj < 4; ++jj) { const int tk = kp0 + kb + 16 * nn + 4 * fq + jj; const bool ok = tk >= 0 && tk <= tq && tk > tq - 128;
            const float v = ok ? s[nn][jj] * 0.125f : -1e30f; s[nn][jj] = v; mx = fmaxf(mx, v); }
    mx = fmaxf(mx, __shfl_xor(mx, 16)); mx = fmaxf(mx, __shfl_xor(mx, 32));
    float sum = 0.f;
#pragma unroll
    for (int nn = 0; nn < 9; ++nn)
#pragma unroll
        for (int jj = 0; jj < 4; ++jj) { const float p = s[nn][jj] > -1e29f ? __expf(s[nn][jj] - mx) : 0.f; s[nn][jj] = p; sum += p; }
    sum += __shfl_xor(sum, 16); sum += __shfl_xor(sum, 32); sum += __expf(sink - mx);
    bf16x8 pb[5];
#pragma unroll
    for (int kk = 0; kk < 4; ++kk) pb[kk] = pack8(s[2 * kk], s[2 * kk + 1]);
    pb[4] = pack8(s[8], (f32x4){0.f, 0.f, 0.f, 0.f});
    const float inv = 1.f / sum;
#pragma unroll
    for (int m = 0; m < 4; ++m) { f32x4 o = {0.f, 0.f, 0.f, 0.f};
#pragma unroll
        for (int kk = 0; kk < 5; ++kk) { const bf16_t* vp = Vt + (16 * m + fr) * 200 + kb + 32 * kk + 4 * fq;
            const bf16x4 lo = *(const bf16x4*)vp; bf16x4 hi = {0, 0, 0, 0}; if (kk < 4) hi = *(const bf16x4*)(vp + 16);
            const bf16x8 af = {lo[0], lo[1], lo[2], lo[3], hi[0], hi[1], hi[2], hi[3]};
            o = MFMA16(af, pb[kk], o); }
        st4bf(mix + ((size_t)b * 4096 + tq) * DM + 512 + hq * 64 + 16 * m + 4 * fq, o * inv); }
    __syncthreads();
}

__device__ void d_item(const Args& a, const int l, const int it, unsigned char* smem) {
    const int tid = tidx(), lane = tid & 63, w = tid >> 6, fr = lane & 15, fq = lane >> 4;
    const int g = it & 3, ch = (it >> 2) & 31, b = it >> 7;
    bf16_t* vT = (bf16_t*)smem;
    const bf16_t* dvn = (const bf16_t*)(wsp(a) + WS_DVN); const bf16_t* proj = (const bf16_t*)(wsp(a) + WS_PROJ); bf16_t* mix = (bf16_t*)(wsp(a) + WS_MIX);
    const size_t r0 = (size_t)b * 4096 + 128 * ch;
    for (int id = tid; id < 1024; id += 512) { const int row = id >> 3, c8 = id & 7; const uint4 vq = *(const uint4*)(dvn + (r0 + row) * 256 + g * 64 + c8 * 8); bf16_t* vd = vT + (c8 * 8) * 136 + row;
        vd[0] = (bf16_t)(vq.x & 0xffffu); vd[136] = (bf16_t)(vq.x >> 16); vd[272] = (bf16_t)(vq.y & 0xffffu); vd[408] = (bf16_t)(vq.y >> 16);
        vd[544] = (bf16_t)(vq.z & 0xffffu); vd[680] = (bf16_t)(vq.z >> 16); vd[816] = (bf16_t)(vq.w & 0xffffu); vd[952] = (bf16_t)(vq.w >> 16); }
    __syncthreads();
    const float* Wg = inp(a, 18) + ((size_t)(l * 4 + g) * 128) * 128;
    const int t = 16 * w + fr;
    f32x4 acc[4];
#pragma unroll
    for (int n = 0; n < 4; ++n) acc[n] = (f32x4){0.f, 0.f, 0.f, 0.f};
#pragma unroll
    for (int kk = 0; kk < 4; ++kk) if (kk <= (w >> 1)) {
        const float* wp = Wg + (size_t)t * 128 + 32 * kk + 8 * fq; f32x4 w0 = *(const f32x4*)wp, w1 = *(const f32x4*)(wp + 4);
#pragma unroll
        for (int e = 0; e < 4; ++e) { if (32 * kk + 8 * fq + e > t) w0[e] = 0.f; if (32 * kk + 8 * fq + 4 + e > t) w1[e] = 0.f; }
        const bf16x8 bfr = pack8(w0, w1);
#pragma unroll
        for (int n = 0; n < 4; ++n) acc[n] = MFMA16(*(const bf16x8*)(vT + (16 * n + fr) * 136 + 32 * kk + 8 * fq), bfr, acc[n]);
    }
    const float bias = inp(a, 19)[(size_t)(l * 4 + g) * 128 + t];
    const size_t r = r0 + t;
#pragma unroll
    for (int n = 0; n < 4; ++n) { const f32x4 du = gelu4(ld4bf(proj + r * PS + C_DU + g * 64 + 16 * n + 4 * fq)); st4bf(mix + r * DM + 768 + g * 64 + 16 * n + 4 * fq, du * (acc[n] + bias)); }
    __syncthreads();
}

__device__ void phase_chunk(const Args& a, const int l, unsigned char* smem) {
    const int wid = tidx() >> 6, gw = bidx() * 8 + wid, nw = gdim() * 8;
#ifndef CHMASK
#define CHMASK 15
#endif
    if (CHMASK & 1) for (int it = gw; it < 2048; it += nw) a2_item(a, it, smem + wid * A2_LDS);
    if (CHMASK & 2) for (int it = gw; it < 512; it += nw) sattn_item(a, l, it);
    __syncthreads();
    if (CHMASK & 4) for (int it = bidx(); it < 1024; it += gdim()) c_item(a, l, it, smem);
    if (CHMASK & 8) for (int it = bidx(); it < 1024; it += gdim()) d_item(a, l, it, smem);
}

__device__ void phase_scan(const Args& a, const int l) {
    const int lane = tidx() & 63, wid = tidx() >> 6, fr = lane & 15, fq = lane >> 4;
    float* oraw = (float*)(wsp(a) + WS_ORAW);
    if (bidx() >= 32 || gdim() < 64) {
        const int nb = gdim() < 64 ? gdim() : gdim() - 32, bi = gdim() < 64 ? bidx() : bidx() - 32;
        for (int it = bi * 8 + wid; it < 512; it += nb * 8) sdelta_item(a, l, it);
        if (gdim() >= 64) return;
    }
    if (wid >= 4) return;
    for (int bh = bidx(); bh < 32; bh += gdim()) {
        const int b = bh >> 2, h = bh & 3, sl = wid;
        f32x4 S[4];
#pragma unroll
        for (int m = 0; m < 4; ++m) S[m] = (f32x4){0.f, 0.f, 0.f, 0.f};
        for (int n = 0; n < 64; ++n) {
            const int it = ((b * 64 + n) * 4 + h);
            const unsigned char* cbase = wsp(a) + WS_A2 + (size_t)it * 49152;
            bf16x8 wf[4][2], qd[4][2], qk[4][2], kd[4][2]; f32x4 u[4];
#pragma unroll
            for (int m = 0; m < 4; ++m) {
#pragma unroll
                for (int kk = 0; kk < 2; ++kk) { const size_t o = (size_t)((m * 2 + kk) * 64 + lane) * 16;
                    wf[m][kk] = *(const bf16x8*)(cbase + 8192 + o); qk[m][kk] = *(const bf16x8*)(cbase + o); qd[m][kk] = *(const bf16x8*)(cbase + 16384 + o); kd[m][kk] = *(const bf16x8*)(cbase + 24576 + o); }
                u[m] = *(const f32x4*)(cbase + 32768 + (size_t)((sl * 4 + m) * 64 + lane) * 16);
            }
            const float egl = __expf(((const float*)(wsp(a) + WS_GLS))[it]);
            bf16x8 Sb[2], Vb[2];
            Sb[0] = pack8(S[0], S[1]); Sb[1] = pack8(S[2], S[3]);
            f32x4 vn[4], O[4];
#pragma unroll
            for (int m = 0; m < 4; ++m) { f32x4 T = {0.f, 0.f, 0.f, 0.f}; T = MFMA16(wf[m][0], Sb[0], T); T = MFMA16(wf[m][1], Sb[1], T); vn[m] = u[m] - T; }
            Vb[0] = pack8(vn[0], vn[1]); Vb[1] = pack8(vn[2], vn[3]);
#pragma unroll
            for (int m = 0; m < 4; ++m) { f32x4 o = {0.f, 0.f, 0.f, 0.f}; o = MFMA16(qd[m][0], Sb[0], o); o = MFMA16(qd[m][1], Sb[1], o); o = MFMA16(qk[m][0], Vb[0], o); o = MFMA16(qk[m][1], Vb[1], o); O[m] = o; }
#pragma unroll
            for (int m = 0; m < 4; ++m) { f32x4 s2 = S[m] * egl; s2 = MFMA16(kd[m][0], Vb[0], s2); s2 = MFMA16(kd[m][1], Vb[1], s2); S[m] = s2; }
            const size_t t0 = (size_t)b * 4096 + n * 64;
#pragma unroll
            for (int m = 0; m < 4; ++m)
#pragma unroll
                for (int jj = 0; jj < 4; ++jj) oraw[(t0 + 16 * m + 4 * fq + jj) * 256 + h * 64 + 16 * sl + fr] = O[m][jj];
        }
        float* So = outp(a) + O_SDP + ((size_t)(l * 8 + b) * 4 + h) * 4096;
#pragma unroll
        for (int m = 0; m < 4; ++m)
#pragma unroll
            for (int jj = 0; jj < 4; ++jj) So[(16 * m + 4 * fq + jj) * 64 + 16 * sl + fr] = S[m][jj];
    }
}

__device__ void phase_aout(const Args& a, const int l) {
    const int lane = tidx() & 63, wid = tidx() >> 6, c4 = lane * 4;
    const float* oraw = (const float*)(wsp(a) + WS_ORAW); const bf16_t* proj = (const bf16_t*)(wsp(a) + WS_PROJ); bf16_t* mix = (bf16_t*)(wsp(a) + WS_MIX);
    const f32x4 g = *(const f32x4*)(inp(a, 13) + l * 64 + (c4 & 63));
    for (int r = bidx() * 8 + wid; r < M; r += gdim() * 8) {
        const f32x4 o = *(const f32x4*)(oraw + (size_t)r * 256 + c4);
        const float ss = red16(o[0] * o[0] + o[1] * o[1] + o[2] * o[2] + o[3] * o[3]);
        const f32x4 y = o * rsqrtf(ss * (1.f / 64.f) + EPS) * g;
        st4bf(mix + (size_t)r * DM + c4, y * silu4(ld4bf(proj + (size_t)r * PS + C_AZ + c4)));
    }
}

__device__ void phase_fix(const Args& a, const int l) {
    const float* sg = (const float*)(wsp(a) + WS_SG); const float* su = (const float*)(wsp(a) + WS_SU); bf16_t* act = (bf16_t*)(wsp(a) + WS_PROJ);
    const float* cw = inp(a, 24) + (size_t)l * 3 * FF;
    for (int idx = bidx() * 512 + tidx(); idx < 512 * 2 * 704; idx += gdim() * 512) {
        const int f = (idx % 704) * 4, q = (idx / 704) & 1, blk = idx / 1408; const bool prev = (blk & 63) != 0;
        const f32x4 z4 = {0.f, 0.f, 0.f, 0.f};
        const f32x4 g0 = *(const f32x4*)(sg + ((size_t)blk * 4 + q) * FF + f), up = *(const f32x4*)(su + ((size_t)blk * 2 + q) * FF + f);
        f32x4 gm2, gm1;
        if (q == 0) { gm2 = prev ? *(const f32x4*)(sg + ((size_t)(blk - 1) * 4 + 2) * FF + f) : z4; gm1 = prev ? *(const f32x4*)(sg + ((size_t)(blk - 1) * 4 + 3) * FF + f) : z4; }
        else { gm2 = prev ? *(const f32x4*)(sg + ((size_t)(blk - 1) * 4 + 3) * FF + f) : z4; gm1 = *(const f32x4*)(sg + ((size_t)blk * 4 + 0) * FF + f); }
        const f32x4 gc = *(const f32x4*)(cw + f) * gm2 + *(const f32x4*)(cw + FF + f) * gm1 + *(const f32x4*)(cw + 2 * FF + f) * g0;
        st4bf(act + ((size_t)blk * 64 + q) * FF + f, silu4(gc) * up);
    }
}

__device__ void phase_final(const Args& a) {
    const int lane = tidx() & 63, wid = tidx() >> 6;
    const float* ssq = (const float*)(wsp(a) + WS_SSQA); const float* g = inp(a, 26);
    for (int r = bidx() * 8 + wid; r < M; r += gdim() * 8) {
        const float sc = rowscale(ssq, r); float* xr = outp(a) + (size_t)r * DM;
#pragma unroll
        for (int q = 0; q < 4; ++q) { const int c = q * 256 + lane * 4; *(f32x4*)(xr + c) = *(const f32x4*)(xr + c) * sc * *(const f32x4*)(g + c); }
    }
}

constexpr int NPH = 20, LDS_BYTES = 147456;
__global__ void __launch_bounds__(512) fwd_kernel(Args a0) {
    extern __shared__ __attribute__((aligned(16))) unsigned char smem[];
    LAS unsigned char* lds = (LAS unsigned char*)smem;
#pragma unroll 1
    for (int ph = a0.ph_lo; ph < a0.ph_hi; ++ph) {
        if (ph > a0.ph_lo && a0.coop) cg::this_grid().sync();
        const Args& a = a0;
#ifndef PHMASK
#define PHMASK 0xFFFFF
#endif
        if (ph == 0) { if (PHMASK & 1) phase_prep(a, smem); continue; }
        if (ph == NPH - 1) { if (PHMASK & 2) phase_final(a); continue; }
        const int l = (ph - 1) / 9, sp = (ph - 1) % 9;
        pg8::StaticOrder S;
        if (!((PHMASK >> (2 + sp)) & 1)) continue;
        switch (sp) {
        case 0: { pg8::Gemm g{(const bf16_t*)(wsp(a) + WS_XB), (const bf16_t*)(wsp(a) + WS_WIN) + (size_t)l * NPAD * 1024, M, NPAD, 1024}; S.init(M, NPAD, gdim(), bidx());
            EpiProj E{(bf16_t*)(wsp(a) + WS_PROJ), (const float*)(wsp(a) + WS_SSQA)}; pg8::gemm_phase(lds, g, S, E); } break;
        case 1: phase_tok(a, l); break;
        case 2: phase_chunk(a, l, smem); break;
        case 3: phase_scan(a, l); break;
        case 4: phase_aout(a, l); break;
        case 5: { pg8::Gemm g{(const bf16_t*)(wsp(a) + WS_MIX), (const bf16_t*)(wsp(a) + WS_WOUT) + (size_t)l * 1024 * 1024, M, 1024, 1024}; S.init(M, 1024, gdim(), bidx());
            EpiRes E{l == 0 ? inp(a, 0) : outp(a), l == 0 ? inp(a, 1) : outp(a) + O_YS, outp(a), (bf16_t*)(wsp(a) + WS_XB), (float*)(wsp(a) + WS_SSQB)}; pg8::gemm_phase(lds, g, S, E); } break;
        case 6: { pg8::Gemm g{(const bf16_t*)(wsp(a) + WS_XB), (const bf16_t*)(wsp(a) + WS_WGU) + (size_t)l * 5632 * 1024, M, 5632, 1024}; S.init(M, 5632, gdim(), bidx());
            EpiGU E{(bf16_t*)(wsp(a) + WS_PROJ), (const float*)(wsp(a) + WS_SSQB), inp(a, 24) + (size_t)l * 3 * FF, inp(a, 7) + (size_t)l * 128 * 2 * FF, (float*)(wsp(a) + WS_SG), (float*)(wsp(a) + WS_SU),
                    outp(a) + O_SFP + (size_t)l * 8 * 2 * FF, outp(a) + O_SFS + (size_t)l * 128 * 2 * FF}; pg8::gemm_phase(lds, g, S, E); } break;
        case 7: phase_fix(a, l); break;
        default: { pg8::Gemm g{(const bf16_t*)(wsp(a) + WS_PROJ), (const bf16_t*)(wsp(a) + WS_WDN) + (size_t)l * 1024 * FF, M, 1024, FF}; S.init(M, 1024, gdim(), bidx());
            EpiRes E{outp(a), outp(a) + O_YS, outp(a), (bf16_t*)(wsp(a) + WS_XB), (float*)(wsp(a) + WS_SSQA)}; pg8::gemm_phase(lds, g, S, E); } break;
        }
    }
}

extern "C" void kernel_launch(void* const* d_in, const int* in_sizes, int n_in, void* d_out, int out_size, void* d_ws, size_t ws_size, hipStream_t stream) {
    static int grid = 0;
    if (grid == 0) {
        if (n_in != 27 || (size_t)out_size != O_END || ws_size < WS_END) { fprintf(stderr, "kernel_launch: unexpected sizes n_in %d out %d ws %zu (need %zu)\n", n_in, out_size, ws_size, (size_t)WS_END); grid = -1; return; }
        int dev = 0, cus = 0, per_cu = 0;
        hipGetDevice(&dev); hipDeviceGetAttribute(&cus, hipDeviceAttributeMultiprocessorCount, dev);
        if (hipFuncSetAttribute((const void*)fwd_kernel, hipFuncAttributeMaxDynamicSharedMemorySize, LDS_BYTES) != hipSuccess) { fprintf(stderr, "kernel_launch: hipFuncSetAttribute failed\n"); grid = -1; return; }
        hipOccupancyMaxActiveBlocksPerMultiprocessor(&per_cu, (const void*)fwd_kernel, 512, LDS_BYTES);
        (void)hipGetLastError();
        if (per_cu < 1) per_cu = 1;
        grid = cus * 1;
        if (grid <= 0) grid = 256;
    }
    if (grid < 0) return;
    Args a{};
    for (int i = 0; i < 27; ++i) a.in[i] = (const float*)d_in[i];
    a.out = (float*)d_out; a.ws = (unsigned char*)d_ws;
#if ONE_LAUNCH
    a.coop = 1; a.ph_lo = 0; a.ph_hi = NPH;
    void* args[] = {&a};
    hipError_t e = hipLaunchCooperativeKernel((const void*)fwd_kernel, dim3(grid), dim3(512), args, LDS_BYTES, stream);
    if (e != hipSuccess) fprintf(stderr, "cooperative launch failed: %s (grid %d)\n", hipGetErrorString(e), grid);
#else
    a.coop = 0;
    for (int ph = 0; ph < NPH; ++ph) { a.ph_lo = ph; a.ph_hi = ph + 1; hipLaunchKernelGGL(fwd_kernel, dim3(grid), dim3(512), LDS_BYTES, stream, a); }
#endif
}
```

```cpp
#include <hip/hip_runtime.h>
#include <hip/hip_cooperative_groups.h>
#include <cstdio>
namespace cg = cooperative_groups;

#define DEVI __device__ __forceinline__
#define LAS __attribute__((address_space(3)))
typedef unsigned short bf16_t;
typedef short bf16x8 __attribute__((ext_vector_type(8)));
typedef short bf16x4 __attribute__((ext_vector_type(4)));
typedef float f32x4 __attribute__((ext_vector_type(4)));

#ifndef ONE_LAUNCH
#define ONE_LAUNCH 1
#endif

constexpr int MP = 32768, MS = 512, M = MP + MS, DM = 1024, FF = 2816, PS = 2824  , NPAD = 3072;
constexpr int C_AQ = 0, C_AZ = 768, C_BB = 1024, C_BC = 1280, C_BH = 1536, C_CQ = 1792, C_CK = 2048, C_DU = 2304, C_DV = 2560, C_AB = 2816, C_AA = 2820;
constexpr float EPS = 1e-6f;

constexpr size_t O_YP = 0, O_YS = O_YP + (size_t)MP * DM, O_SDP = O_YS + (size_t)MS * DM, O_SDS = O_SDP + 2 * 8 * 4 * 4096, O_SCP = O_SDS + 2 * 128 * 4 * 4096,
                 O_SCS = O_SCP + 2 * 8 * 3 * 768, O_SSP = O_SCS + 2 * 128 * 3 * 768, O_SSS = O_SSP + 2 * 8 * 2 * 256, O_CKP = O_SSS + 2 * 128 * 2 * 256,
                 O_CKS = O_CKP + 2 * 8 * 128 * 128, O_CVP = O_CKS + 2 * 128 * 128 * 128, O_CVS = O_CVP + 2 * 8 * 128 * 128, O_SFP = O_CVS + 2 * 128 * 128 * 128,
                 O_SFS = O_SFP + 2 * 8 * 2 * 2816, O_CHV = O_SFS + 2 * 128 * 2 * 2816, O_END = O_CHV + 2 * 128 * 4 * 256;
static_assert(O_END == 50008064, "output size");

constexpr size_t WS_WIN = 0, WS_WOUT = WS_WIN + (size_t)2 * NPAD * 1024 * 2, WS_WGU = WS_WOUT + (size_t)2 * 1024 * 1024 * 2, WS_WDN = WS_WGU + (size_t)2 * 5632 * 1024 * 2,
                 WS_XB = WS_WDN + (size_t)2 * 1024 * 2816 * 2,
                 WS_PROJ = WS_XB + (size_t)M * 1024 * 2,
                 WS_MIX = WS_PROJ + (size_t)M * PS * 2,
                 WS_SSQA = WS_MIX + (size_t)M * 1024 * 2, WS_SSQB = WS_SSQA + (size_t)M * 16 * 4, WS_BG = WS_SSQB + (size_t)M * 16 * 4,
                 WS_GLS = WS_BG + (size_t)M * 8 * 4,
                 WS_QR = WS_GLS + 2048 * 4,
                 WS_KVR = WS_QR + (size_t)M * 256 * 2, WS_DVN = WS_KVR + (size_t)M * 256 * 2, WS_ORAW = WS_QR,
                 WS_A2 = WS_DVN + (size_t)M * 256 * 2,
                 WS_SG = WS_A2, WS_SU = WS_SG + (size_t)512 * 4 * 2816 * 4,
                 WS_END = WS_A2 + (size_t)2048 * 49152;
static_assert(WS_END <= (size_t)536870912, "workspace too large");
static_assert(WS_SU + (size_t)512 * 2 * 2816 * 4 <= WS_END, "side buffers");
static_assert((size_t)M * 256 * 4 <= (size_t)3 * M * 256 * 2, "oraw alias");

struct Args { const float* in[27]; float* out; unsigned char* ws; int coop; int ph_lo; int ph_hi; int pad; };

DEVI int tidx() { int t = threadIdx.x; asm volatile("" : "+v"(t)); return t; }
DEVI int bidx() { int t = blockIdx.x; asm volatile("" : "+s"(t)); return t; }
DEVI int gdim() { int t = gridDim.x; asm volatile("" : "+s"(t)); return t; }
DEVI float bf2f(bf16_t v) { return __uint_as_float(((unsigned)v) << 16); }
DEVI bf16_t f2bf(float f) { unsigned u = __float_as_uint(f); u += 0x7FFFu + ((u >> 16) & 1u); return (bf16_t)(u >> 16); }
DEVI unsigned pk2(float lo, float hi) { unsigned r; asm("v_cvt_pk_bf16_f32 %0, %1, %2" : "=v"(r) : "v"(lo), "v"(hi)); return r; }
DEVI f32x4 ld4bf(const bf16_t* p) { const uint2 u = *(const uint2*)p; f32x4 o; o[0] = __uint_as_float(u.x << 16); o[1] = __uint_as_float(u.x & 0xffff0000u); o[2] = __uint_as_float(u.y << 16); o[3] = __uint_as_float(u.y & 0xffff0000u); return o; }
DEVI void st4bf(bf16_t* p, f32x4 v) { uint2 u; u.x = pk2(v[0], v[1]); u.y = pk2(v[2], v[3]); *(uint2*)p = u; }
DEVI bf16x8 pack8(f32x4 a, f32x4 b) { union { uint4 u; bf16x8 v; } x; x.u.x = pk2(a[0], a[1]); x.u.y = pk2(a[2], a[3]); x.u.z = pk2(b[0], b[1]); x.u.w = pk2(b[2], b[3]); return x.v; }
DEVI uint4 pack8u(f32x4 a, f32x4 b) { uint4 u; u.x = pk2(a[0], a[1]); u.y = pk2(a[2], a[3]); u.z = pk2(b[0], b[1]); u.w = pk2(b[2], b[3]); return u; }
DEVI float wave_sum(float v) { for (int d = 1; d < 64; d <<= 1) v += __shfl_xor(v, d); return v; }
DEVI float red16(float v) { v += __shfl_xor(v, 1); v += __shfl_xor(v, 2); v += __shfl_xor(v, 4); v += __shfl_xor(v, 8); return v; }
DEVI float silu_f(float y) { return y / (1.f + __expf(-y)); }
DEVI float gelu_f(float x) { const float z = 0.7978845608028654f * (x + 0.044715f * x * x * x); return x / (1.f + __expf(-2.f * z)); }
DEVI f32x4 silu4(f32x4 v) { f32x4 o; for (int i = 0; i < 4; ++i) o[i] = silu_f(v[i]); return o; }
DEVI f32x4 gelu4(f32x4 v) { f32x4 o; for (int i = 0; i < 4; ++i) o[i] = gelu_f(v[i]); return o; }
DEVI float rdlane(float v, int l) { return __builtin_bit_cast(float, __builtin_amdgcn_readlane(__builtin_bit_cast(int, v), l)); }
DEVI void wave_lds_fence() { asm volatile("s_waitcnt lgkmcnt(0)" ::: "memory"); }
template <int CTRL> DEVI float dppf(float x) { return __builtin_bit_cast(float, __builtin_amdgcn_update_dpp(0, __builtin_bit_cast(int, x), CTRL, 0xf, 0xf, true)); }
DEVI float rowscale(const float* ssq, int r) { const f32x4* p = (const f32x4*)(ssq + (size_t)r * 16); const f32x4 a = p[0], b = p[1], c = p[2], d = p[3];
    const float s = (a[0] + a[1] + a[2] + a[3]) + (b[0] + b[1] + b[2] + b[3]) + (c[0] + c[1] + c[2] + c[3]) + (d[0] + d[1] + d[2] + d[3]); return rsqrtf(s * (1.f / 1024.f) + EPS); }
DEVI unsigned char* wsp(const Args& a) { unsigned char* p = a.ws; asm volatile("" : "+s"(p)); return p; }
DEVI float* outp(const Args& a) { float* p = a.out; asm volatile("" : "+s"(p)); return p; }
DEVI const float* inp(const Args& a, int k) { const float* p = a.in[k]; asm volatile("" : "+s"(p)); return p; }
#define MFMA16(a, b, c) __builtin_amdgcn_mfma_f32_16x16x32_bf16((a), (b), (c), 0, 0, 0)

namespace pg8 {
constexpr int BM = 256, BK = 64, HALF = 128, HTB = HALF * BK * 2, STAGE_BYTES = 8 * HTB, NXCD = 8, WGM = 8;
DEVI int lds_byte(int r, int c) { const int st = (r >> 4) * 2 + (c >> 5), rr = r & 15, cc = c & 31, ob = rr * 64 + cc * 2; return st * 1024 + (ob ^ (((ob >> 9) & 1) << 5)); }
DEVI void stage_rc(int b, int& R, int& C) { const int st = b / 1024, sb = b % 1024, swz = sb ^ (((sb >> 9) & 1) << 5); R = (st >> 1) * 16 + swz / 64; C = (st & 1) * 32 + (swz % 64) / 2; }
DEVI int perm32(int rho) { const int n = rho >> 4, i = rho & 15; return 8 * (i >> 2) + 4 * n + (i & 3); }
struct Unit { int pm, pn; };
struct Gemm { const bf16_t* A; const bf16_t* Bt; int M, N, K; };
struct StaticOrder {
    int nM, nN, nwg, G, c;
    DEVI void init(int M_, int N_, int G_, int c_) { nM = M_ / BM; nN = N_ / BM; nwg = nM * nN; G = G_; c = c_; }
    DEVI bool next(int i, Unit& u) const {
        const long L = (long)i * G + c; if (L >= nwg) return false;
        int wgid = (int)L; { const int q = nwg / NXCD, r = nwg % NXCD, xcd = wgid % NXCD, off = wgid / NXCD; wgid = (xcd < r ? xcd * (q + 1) : r * (q + 1) + (xcd - r) * q) + off; }
        const int nig = WGM * nN, gid = wgid / nig, fm = gid * WGM, gsz = (nM - fm) < WGM ? (nM - fm) : WGM;
        u.pm = fm + ((wgid % nig) % gsz); u.pn = (wgid % nig) / gsz; return true;
    }
    DEVI void a_ready(const Unit&) const {}
    DEVI void done(const Unit&) const {}
};
template <class Epi, class Sched>
DEVI void gemm_phase(LAS unsigned char* lds, const Gemm g, const Sched& S, const Epi& E) {
    const int tid = tidx(), wid = __builtin_amdgcn_readfirstlane(tid >> 6), lane = tid & 63, wr = wid >> 2, wc = wid & 3, fr = lane & 15, fq = lane >> 4;
    const int K = g.K, nt = K / BK;
    unsigned voffA[2], voffB[2];
#pragma unroll
    for (int i = 0; i < 2; ++i) { int R, C; stage_rc(tid * 16 + i * 8192, R, C); const int Rb = Epi::PERM ? ((R & ~31) + perm32(R & 31)) : R;
        voffA[i] = (unsigned)(R * K + C) * 2u; voffB[i] = (unsigned)(Rb * K + C) * 2u; }
    const size_t kstep = (size_t)(BK * 2);
    const size_t hstep = (size_t)HALF * K * 2;
    const size_t tstep = 2 * hstep;
    const unsigned ldsw = (unsigned)wid * 1024u;
    const int aoff = lds_byte(wr * 64 + fr, fq * 8), boff = lds_byte(wc * 32 + fr, fq * 8);
#define PG8_SA(b, h) (((b) * 2 + (h)) * HTB)
#define PG8_SB(b, h) ((4 + (b) * 2 + (h)) * HTB)
#define PG8_STAGE(bufoff, gbase, voff) do { _Pragma("unroll") for (int _i = 0; _i < 2; ++_i) \
        __builtin_amdgcn_global_load_lds((const unsigned*)((const char*)(gbase) + (voff)[_i]), (LAS unsigned*)(lds + (bufoff) + ldsw + _i * 8192), 16, 0, 0); } while (0)
#define PG8_LDA(dst, b, h) do { _Pragma("unroll") for (int m = 0; m < 4; ++m) _Pragma("unroll") for (int k = 0; k < 2; ++k) dst[m][k] = *(const LAS bf16x8*)(lds + PG8_SA(b, h) + aoff + m * 2048 + k * 1024); } while (0)
#define PG8_LDB(dst, b, h) do { _Pragma("unroll") for (int n = 0; n < 2; ++n) _Pragma("unroll") for (int k = 0; k < 2; ++k) dst[n][k] = *(const LAS bf16x8*)(lds + PG8_SB(b, h) + boff + n * 2048 + k * 1024); } while (0)
#define PG8_MMA(ai, bj, At, Bt) do { __builtin_amdgcn_s_setprio(1); _Pragma("unroll") for (int m = 0; m < 4; ++m) _Pragma("unroll") for (int n = 0; n < 2; ++n) _Pragma("unroll") for (int k = 0; k < 2; ++k) \
        acc[ai][bj][m][n] = __builtin_amdgcn_mfma_f32_16x16x32_bf16(Bt[n][k], At[m][k], acc[ai][bj][m][n], 0, 0, 0); __builtin_amdgcn_s_setprio(0); } while (0)
#define PG8_WAIT_V(n) asm volatile("s_waitcnt vmcnt(" #n ")" ::: "memory")
#define PG8_WAIT_L(n) asm volatile("s_waitcnt lgkmcnt(" #n ")" ::: "memory")
#define PG8_BAR __builtin_amdgcn_s_barrier()
#define PG8_SCHED __builtin_amdgcn_sched_barrier(0)
    Unit cur, nxt; int ui = 0;
    if (!S.next(0, cur)) return;
    f32x4 acc[2][2][4][2];
#pragma unroll
    for (int a = 0; a < 2; ++a)
#pragma unroll
        for (int b = 0; b < 2; ++b)
#pragma unroll
            for (int m = 0; m < 4; ++m)
#pragma unroll
                for (int n = 0; n < 2; ++n) acc[a][b][m][n] = (f32x4){0.f, 0.f, 0.f, 0.f};
    bf16x8 At[4][2], B0[2][2], B1[2][2];
    const char* cA = (const char*)g.A + (size_t)cur.pm * tstep; const char* cB = (const char*)g.Bt + (size_t)cur.pn * tstep;
    S.a_ready(cur);
    PG8_STAGE(PG8_SB(0, 0), cB, voffB); PG8_STAGE(PG8_SA(0, 0), cA, voffA); PG8_STAGE(PG8_SB(0, 1), cB + hstep, voffB); PG8_STAGE(PG8_SA(0, 1), cA + hstep, voffA);
    if (wr == 1) PG8_BAR;
    PG8_WAIT_V(4); PG8_BAR;
    PG8_STAGE(PG8_SB(1, 0), cB + kstep, voffB); PG8_STAGE(PG8_SA(1, 0), cA + kstep, voffA); PG8_STAGE(PG8_SB(1, 1), cB + hstep + kstep, voffB);
    PG8_WAIT_V(6); PG8_BAR;
    for (;;) {
        const bool has_next = S.next(ui + 1, nxt);
        const char* nA = has_next ? (const char*)g.A + (size_t)nxt.pm * tstep : cA; const char* nB = has_next ? (const char*)g.Bt + (size_t)nxt.pn * tstep : cB;
        for (int t = 0; t < nt; t += 2) {
            const bool last = (t == nt - 2);
            const char* a1 = cA + (size_t)(t + 1) * kstep;
            const char* a2 = last ? nA : cA + (size_t)(t + 2) * kstep; const char* b2 = last ? nB : cB + (size_t)(t + 2) * kstep;
            const char* a3 = a2 + kstep; const char* b3 = b2 + kstep;
            if (last && has_next) S.a_ready(nxt);
            PG8_LDB(B0, 0, 0); PG8_SCHED; PG8_LDA(At, 0, 0); PG8_STAGE(PG8_SA(1, 1), a1 + hstep, voffA);
            PG8_WAIT_L(8); PG8_BAR; PG8_WAIT_L(0); PG8_MMA(0, 0, At, B0); PG8_BAR; PG8_SCHED;
            PG8_LDB(B1, 0, 1); PG8_STAGE(PG8_SB(0, 0), b2, voffB);
            PG8_BAR; PG8_WAIT_L(0); PG8_MMA(0, 1, At, B1); PG8_BAR;
            PG8_LDA(At, 0, 1); PG8_STAGE(PG8_SA(0, 0), a2, voffA);
            PG8_BAR; PG8_WAIT_L(0); PG8_MMA(1, 0, At, B0); PG8_BAR; PG8_SCHED;
            PG8_STAGE(PG8_SB(0, 1), b2 + hstep, voffB);
            PG8_WAIT_V(6); PG8_BAR; PG8_MMA(1, 1, At, B1); PG8_BAR;
            PG8_LDB(B0, 1, 0); PG8_SCHED; PG8_LDA(At, 1, 0); PG8_STAGE(PG8_SA(0, 1), a2 + hstep, voffA);
            PG8_WAIT_L(8); PG8_BAR; PG8_WAIT_L(0); PG8_MMA(0, 0, At, B0); PG8_BAR; PG8_SCHED;
            PG8_LDB(B1, 1, 1); PG8_STAGE(PG8_SB(1, 0), b3, voffB);
            PG8_BAR; PG8_WAIT_L(0); PG8_MMA(0, 1, At, B1); PG8_BAR;
            PG8_LDA(At, 1, 1); PG8_STAGE(PG8_SA(1, 0), a3, voffA);
            PG8_BAR; PG8_WAIT_L(0); PG8_MMA(1, 0, At, B0); PG8_BAR; PG8_SCHED;
            PG8_STAGE(PG8_SB(1, 1), b3 + hstep, voffB);
            PG8_WAIT_V(6); PG8_BAR; PG8_MMA(1, 1, At, B1); PG8_BAR;
        }
        E(acc, cur, wr, wc, fr, fq); S.done(cur);
        if (!has_next) break;
#pragma unroll
        for (int a = 0; a < 2; ++a)
#pragma unroll
            for (int b = 0; b < 2; ++b)
#pragma unroll
                for (int m = 0; m < 4; ++m)
#pragma unroll
                    for (int n = 0; n < 2; ++n) acc[a][b][m][n] = (f32x4){0.f, 0.f, 0.f, 0.f};
        cur = nxt; cA = nA; cB = nB; ++ui;
    }
    PG8_WAIT_V(0);
    if (wr == 0) PG8_BAR;
    PG8_BAR;
#undef PG8_SA
#undef PG8_SB
#undef PG8_STAGE
#undef PG8_LDA
#undef PG8_LDB
#undef PG8_MMA
#undef PG8_WAIT_V
#undef PG8_WAIT_L
#undef PG8_BAR
#undef PG8_SCHED
}
}
using pg8::Unit;

struct EpiProj {
    static constexpr bool PERM = true;
    bf16_t* P; const float* ssq;
    DEVI void operator()(const f32x4 (&acc)[2][2][4][2], const Unit& u, int wr, int wc, int fr, int fq) const {
        const int row0 = u.pm * 256 + wr * 64 + fr, colb = u.pn * 256 + wc * 32 + 8 * fq;
#pragma unroll
        for (int ai = 0; ai < 2; ++ai)
#pragma unroll
            for (int m = 0; m < 4; ++m) { const int r = row0 + ai * 128 + m * 16; const float sc = rowscale(ssq, r);
#pragma unroll
                for (int bj = 0; bj < 2; ++bj) { const int c = colb + bj * 128;
                    if (c < PS) *(uint4*)(P + (size_t)r * PS + c) = pack8u(acc[ai][bj][m][0] * sc, acc[ai][bj][m][1] * sc); } }
    }
};
struct EpiRes {
    static constexpr bool PERM = true;
    const float* res_p; const float* res_s; float* xf; bf16_t* xb; float* ssq;
    DEVI void operator()(const f32x4 (&acc)[2][2][4][2], const Unit& u, int wr, int wc, int fr, int fq) const {
        const int row0 = u.pm * 256 + wr * 64 + fr, colb = u.pn * 256 + wc * 32 + 8 * fq;
#pragma unroll
        for (int ai = 0; ai < 2; ++ai)
#pragma unroll
            for (int m = 0; m < 4; ++m) { const int r = row0 + ai * 128 + m * 16;
                const float* rp = (r < MP) ? res_p + (size_t)r * DM : res_s + (size_t)(r - MP) * DM; float part = 0.f;
#pragma unroll
                for (int bj = 0; bj < 2; ++bj) { const int c = colb + bj * 128;
                    const f32x4 v0 = acc[ai][bj][m][0] + *(const f32x4*)(rp + c), v1 = acc[ai][bj][m][1] + *(const f32x4*)(rp + c + 4);
                    *(f32x4*)(xf + (size_t)r * DM + c) = v0; *(f32x4*)(xf + (size_t)r * DM + c + 4) = v1;
                    *(uint4*)(xb + (size_t)r * DM + c) = pack8u(v0, v1);
                    part += v0[0] * v0[0] + v0[1] * v0[1] + v0[2] * v0[2] + v0[3] * v0[3] + v1[0] * v1[0] + v1[1] * v1[1] + v1[2] * v1[2] + v1[3] * v1[3]; }
                part += __shfl_xor(part, 16); part += __shfl_xor(part, 32);
                if (fq == 0) ssq[(size_t)r * 16 + u.pn * 4 + wc] = part; }
    }
};
struct EpiGU {
    static constexpr bool PERM = true;
    bf16_t* act; const float* ssq; const float* cw; const float* st; float* sg; float* su; float* osfp; float* osfs;
    DEVI void operator()(const f32x4 (&acc)[2][2][4][2], const Unit& u, int wr, int wc, int fr, int fq) const {
        const int f0 = u.pn * 128 + wc * 32 + 8 * fq;
        const f32x4 w0a = *(const f32x4*)(cw + f0), w0b = *(const f32x4*)(cw + f0 + 4), w1a = *(const f32x4*)(cw + FF + f0), w1b = *(const f32x4*)(cw + FF + f0 + 4),
                    w2a = *(const f32x4*)(cw + 2 * FF + f0), w2b = *(const f32x4*)(cw + 2 * FF + f0 + 4);
        const bool smp = u.pm >= 128;
#pragma unroll
        for (int ai = 0; ai < 2; ++ai) {
            const int rb = u.pm * 256 + ai * 128 + wr * 64;
            f32x4 gpa[4], gpb[4]; float scs[4];
#pragma unroll
            for (int m = 0; m < 4; ++m) { scs[m] = rowscale(ssq, rb + 16 * m + fr); gpa[m] = acc[ai][0][m][0] * scs[m]; gpb[m] = acc[ai][0][m][1] * scs[m]; }
#pragma unroll
            for (int m = 0; m < 4; ++m) {
                const int r = rb + 16 * m + fr;
                const f32x4 ua = acc[ai][1][m][0] * scs[m], ub = acc[ai][1][m][1] * scs[m];
                f32x4 p1a, p1b, p2a, p2b;
#pragma unroll
                for (int jj = 0; jj < 4; ++jj) {
                    const float ca = gpa[m][jj], cb = gpb[m][jj], pa = m > 0 ? gpa[m > 0 ? m - 1 : 0][jj] : 0.f, pb = m > 0 ? gpb[m > 0 ? m - 1 : 0][jj] : 0.f;
                    const float a1 = dppf<0x111>(ca), a2 = dppf<0x112>(ca), b1 = dppf<0x10F>(pa), b2 = dppf<0x10E>(pa);
                    p1a[jj] = fr >= 1 ? a1 : b1; p2a[jj] = fr >= 2 ? a2 : b2;
                    const float c1 = dppf<0x111>(cb), c2 = dppf<0x112>(cb), d1 = dppf<0x10F>(pb), d2 = dppf<0x10E>(pb);
                    p1b[jj] = fr >= 1 ? c1 : d1; p2b[jj] = fr >= 2 ? c2 : d2;
                }
                if (smp) {
                    const int t = fr & 3, bb = (r - MP) >> 2; const float* sp = st + (size_t)bb * 2 * FF + f0;
                    if (t == 0) { p2a = *(const f32x4*)sp; p2b = *(const f32x4*)(sp + 4); p1a = *(const f32x4*)(sp + FF); p1b = *(const f32x4*)(sp + FF + 4); }
                    else if (t == 1) { p2a = *(const f32x4*)(sp + FF); p2b = *(const f32x4*)(sp + FF + 4); }
                    if (t >= 2) { float* o = osfs + ((size_t)bb * 2 + (t - 2)) * FF + f0; *(f32x4*)o = gpa[m]; *(f32x4*)(o + 4) = gpb[m]; }
                }
                const bool head = !smp && m == 0 && fr < 2;
                if (!head) {
                    const f32x4 ga = w0a * p2a + w1a * p1a + w2a * gpa[m], gb = w0b * p2b + w1b * p1b + w2b * gpb[m];
                    *(uint4*)(act + (size_t)r * FF + f0) = pack8u(silu4(ga) * ua, silu4(gb) * ub);
                }
                if (!smp) {
                    const int blk = rb >> 6;
                    if (m == 0 && fr < 2) { float* o = sg + ((size_t)blk * 4 + fr) * FF + f0; *(f32x4*)o = gpa[m]; *(f32x4*)(o + 4) = gpb[m];
                        float* o2 = su + ((size_t)blk * 2 + fr) * FF + f0; *(f32x4*)o2 = ua; *(f32x4*)(o2 + 4) = ub; }
                    if (m == 3 && fr >= 14) { float* o = sg + ((size_t)blk * 4 + 2 + (fr - 14)) * FF + f0; *(f32x4*)o = gpa[m]; *(f32x4*)(o + 4) = gpb[m];
                        const int t = r & 4095; if (t >= 4094) { float* o3 = osfp + ((size_t)(r >> 12) * 2 + (t - 4094)) * FF + f0; *(f32x4*)o3 = gpa[m]; *(f32x4*)(o3 + 4) = gpb[m]; } }
                }
            }
        }
    }
};

__device__ void phase_prep(const Args& a, unsigned char* smem) {
    float* tile = (float*)smem;
    const int tid = tidx(), tx = tid & 63, ty = tid >> 6, lane = tid & 63, wid = tid >> 6;
    constexpr int T_IN = 48 * 16, T_OUT = 16 * 16, T_GU = 88 * 16, T_DN = 16 * 44, T_L = T_IN + T_OUT + T_GU + T_DN;
    for (int it = bidx(); it < 2 * T_L; it += gdim()) {
        const int l = it / T_L; int r = it % T_L;
        const float* src; int ld, col, kt, nt, Kd; const float* gk = nullptr; bf16_t* dst;
        if (r < T_IN) { nt = r / 16; kt = r % 16; Kd = 1024; ld = PS; src = inp(a, 9) + (size_t)l * 1024 * PS; gk = inp(a, 8) + l * 1024; dst = (bf16_t*)(wsp(a) + WS_WIN) + (size_t)l * NPAD * 1024;
            const int n = nt * 64 + tx; col = n < 1024 ? n : (n < 2816 ? n + 8 : (n < 2824 ? 1024 + (n - 2816) : -1)); }
        else if ((r -= T_IN) < T_OUT) { nt = r / 16; kt = r % 16; Kd = 1024; ld = 1024; src = inp(a, 20) + (size_t)l * 1024 * 1024; dst = (bf16_t*)(wsp(a) + WS_WOUT) + (size_t)l * 1024 * 1024; col = nt * 64 + tx; }
        else if ((r -= T_OUT) < T_GU) { nt = r / 16; kt = r % 16; Kd = 1024; ld = FF; gk = inp(a, 21) + l * 1024; dst = (bf16_t*)(wsp(a) + WS_WGU) + (size_t)l * 5632 * 1024;
            const int n = nt * 64, pn = n >> 8, cc = n & 255; src = (cc < 128 ? inp(a, 22) : inp(a, 23)) + (size_t)l * 1024 * FF; col = pn * 128 + (cc & 127) + tx; }
        else { r -= T_GU; nt = r / 44; kt = r % 44; Kd = FF; ld = 1024; src = inp(a, 25) + (size_t)l * FF * 1024; dst = (bf16_t*)(wsp(a) + WS_WDN) + (size_t)l * 1024 * FF; col = nt * 64 + tx; }
        for (int i = ty; i < 64; i += 8) { const int k = kt * 64 + i; float v = 0.f; if (col >= 0) { v = src[(size_t)k * ld + col]; if (gk) v *= gk[k]; } tile[i * 65 + tx] = v; }
        __syncthreads();
        for (int i = ty; i < 64; i += 8) dst[(size_t)(nt * 64 + i) * Kd + kt * 64 + tx] = f2bf(tile[tx * 65 + i]);
        __syncthreads();
    }
    bf16_t* xb = (bf16_t*)(wsp(a) + WS_XB); float* ssq = (float*)(wsp(a) + WS_SSQA);
    for (int r = bidx() * 8 + wid; r < M; r += gdim() * 8) {
        const float* xr = (r < MP) ? inp(a, 0) + (size_t)r * DM : inp(a, 1) + (size_t)(r - MP) * DM; float ss = 0.f;
#pragma unroll
        for (int q = 0; q < 4; ++q) { const f32x4 v = *(const f32x4*)(xr + q * 256 + lane * 4); ss += v[0] * v[0] + v[1] * v[1] + v[2] * v[2] + v[3] * v[3]; st4bf(xb + (size_t)r * DM + q * 256 + lane * 4, v); }
        ss = wave_sum(ss);
        if (lane < 16) ssq[(size_t)r * 16 + lane] = lane == 0 ? ss : 0.f;
    }
}

__device__ void phase_tok(const Args& a, const int l) {
    const int lane = tidx() & 63, wid = tidx() >> 6, c4 = lane * 4;
    const bf16_t* proj = (const bf16_t*)(wsp(a) + WS_PROJ);
    bf16_t* qkvn = (bf16_t*)(wsp(a) + WS_XB); bf16_t* mix = (bf16_t*)(wsp(a) + WS_MIX); float* bg = (float*)(wsp(a) + WS_BG);
    bf16_t* qr = (bf16_t*)(wsp(a) + WS_QR); bf16_t* kvr = (bf16_t*)(wsp(a) + WS_KVR); bf16_t* dvn = (bf16_t*)(wsp(a) + WS_DVN);
    float* out = outp(a);
    const float* cwp = inp(a, 10) + (size_t)l * 4 * 768 + c4;
    f32x4 bw[3];
#pragma unroll
    for (int j = 0; j < 3; ++j) bw[j] = *(const f32x4*)(inp(a, 14) + (size_t)l * 3 * 256 + j * 256 + c4);
    const f32x4 lng = *(const f32x4*)(inp(a, 16) + l * 256 + c4), lnb = *(const f32x4*)(inp(a, 17) + l * 256 + c4);
    float inv[4];
#pragma unroll
    for (int e = 0; e < 4; ++e) inv[e] = powf(500000.f, -(float)(4 * (lane & 1) + e) * 0.125f);
    const int j16 = lane & 15, gD = lane >> 4;
    const float* Wd = inp(a, 18) + ((size_t)(l * 4 + gD) * 128) * 128; const float* biasd = inp(a, 19) + (size_t)(l * 4 + gD) * 128;
    for (int run = bidx() * 8 + wid; run < 2048 + 128; run += gdim() * 8) {
        const bool smp = run >= 2048;
        int b, t0, ntok, pos0; size_t r0;
        if (!smp) { b = run >> 8; t0 = (run & 255) * 16; ntok = 16; r0 = (size_t)b * 4096 + t0; pos0 = t0; }
        else { b = run - 2048; t0 = 0; ntok = 4; r0 = (size_t)MP + 4 * b; pos0 = 16384; }
        f32x4 ha[3][3], hb[2];
        const f32x4 z4 = {0.f, 0.f, 0.f, 0.f};
        if (smp) {
            const float* st = inp(a, 3) + ((size_t)(l * 128 + b) * 3) * 768;
#pragma unroll
            for (int p = 0; p < 3; ++p)
#pragma unroll
                for (int j = 0; j < 3; ++j) ha[p][j] = *(const f32x4*)(st + j * 768 + p * 256 + c4);
            const float* sb = inp(a, 4) + ((size_t)(l * 128 + b) * 2) * 256; hb[0] = *(const f32x4*)(sb + c4); hb[1] = *(const f32x4*)(sb + 256 + c4);
            const float* ck = inp(a, 5) + (size_t)(l * 128 + b) * 16384; const float* cv = inp(a, 6) + (size_t)(l * 128 + b) * 16384;
            float* ok = out + O_CKS + (size_t)(l * 128 + b) * 16384; float* ov = out + O_CVS + (size_t)(l * 128 + b) * 16384;
            for (int i = lane; i < 3968; i += 64) { *(f32x4*)(ok + i * 4) = *(const f32x4*)(ck + 512 + i * 4); *(f32x4*)(ov + i * 4) = *(const f32x4*)(cv + 512 + i * 4); }
        } else if (t0 == 0) {
#pragma unroll
            for (int p = 0; p < 3; ++p)
#pragma unroll
                for (int j = 0; j < 3; ++j) ha[p][j] = z4;
            hb[0] = z4; hb[1] = z4;
        } else {
#pragma unroll
            for (int p = 0; p < 3; ++p)
#pragma unroll
                for (int j = 0; j < 3; ++j) ha[p][j] = ld4bf(proj + (r0 - 3 + j) * PS + C_AQ + p * 256 + c4);
#pragma unroll
            for (int j = 0; j < 2; ++j) hb[j] = ld4bf(proj + (r0 - 2 + j) * PS + C_BC + c4) * ld4bf(proj + (r0 - 2 + j) * PS + C_BH + c4);
        }
        f32x4 h0 = z4, h1 = z4, h2 = z4, h3 = z4;
#pragma unroll 1
        for (int i = 0; i < ntok; ++i) {
            const size_t r = r0 + i; const bf16_t* pr = proj + r * PS; const int t = t0 + i;
#pragma unroll
            for (int p = 0; p < 3; ++p) {
                const f32x4 cur = ld4bf(pr + C_AQ + p * 256 + c4);
                f32x4 s = silu4(*(const f32x4*)(cwp + p * 256) * ha[p][0] + *(const f32x4*)(cwp + 768 + p * 256) * ha[p][1] + *(const f32x4*)(cwp + 1536 + p * 256) * ha[p][2] + *(const f32x4*)(cwp + 2304 + p * 256) * cur);
                ha[p][0] = ha[p][1]; ha[p][1] = ha[p][2]; ha[p][2] = cur;
                if (p < 2) { float ss = red16(s[0] * s[0] + s[1] * s[1] + s[2] * s[2] + s[3] * s[3]); const float sc = rsqrtf(ss + EPS) * (p == 0 ? 0.125f : 1.f); s = s * sc; }
                st4bf(qkvn + r * 768 + p * 256 + c4, s);
                if (!smp) { if (t >= 4093) *(f32x4*)(out + O_SCP + ((size_t)(l * 8 + b) * 3 + (t - 4093)) * 768 + p * 256 + c4) = cur; }
                else if (i >= 1) *(f32x4*)(out + O_SCS + ((size_t)(l * 128 + b) * 3 + (i - 1)) * 768 + p * 256 + c4) = cur;
            }
            if (lane < 4) {
                const float ab = bf2f(pr[C_AB + lane]), aa = bf2f(pr[C_AA + lane]);
                const float beta = 1.f / (1.f + __expf(-ab)); const float x = aa + inp(a, 12)[l * 4 + lane]; const float sp = x > 20.f ? x : log1pf(__expf(x));
                bg[r * 8 + lane] = beta; bg[r * 8 + 4 + lane] = -__expf(inp(a, 11)[l * 4 + lane]) * sp;
            }
            {
                const f32x4 s = ld4bf(pr + C_BC + c4) * ld4bf(pr + C_BH + c4), bb = ld4bf(pr + C_BB + c4);
                const f32x4 bx = bw[0] * hb[0] + bw[1] * hb[1] + bw[2] * s;
                st4bf(mix + r * DM + 256 + c4, bb * bx); hb[0] = hb[1]; hb[1] = s;
                if (!smp) { if (t >= 4094) *(f32x4*)(out + O_SSP + ((size_t)(l * 8 + b) * 2 + (t - 4094)) * 256 + c4) = s; }
                else if (i >= 2) *(f32x4*)(out + O_SSS + ((size_t)(l * 128 + b) * 2 + (i - 2)) * 256 + c4) = s;
            }
            {
                f32x4 q = ld4bf(pr + C_CQ + c4), kv = ld4bf(pr + C_CK + c4), qo, ko;
#pragma unroll
                for (int e = 0; e < 4; ++e) { qo[e] = __shfl_xor(q[e], 2); ko[e] = __shfl_xor(kv[e], 2); }
                const float posf = (float)(pos0 + i);
                if (j16 < 4) {
                    const float sgn = j16 < 2 ? -1.f : 1.f;
#pragma unroll
                    for (int e = 0; e < 4; ++e) {
                        const float ang = posf * inv[e]; const double rd = (double)ang * 0.15915494309189535; const float rr = (float)((rd - floor(rd)) * 6.283185307179586);
                        const float cs = __cosf(rr), sn = __sinf(rr);
                        q[e] = q[e] * cs + sgn * qo[e] * sn;
                        if (lane < 32) kv[e] = kv[e] * cs + sgn * ko[e] * sn;
                    }
                }
                st4bf(qr + r * 256 + c4, q); st4bf(kvr + r * 256 + c4, kv);
                if (!smp) { if (t >= 3968) { float* o = (lane < 32 ? out + O_CKP : out + O_CVP) + ((size_t)(l * 8 + b) * 128 + (t - 3968)) * 128 + (c4 & 127); *(f32x4*)o = kv; } }
                else { float* o = (lane < 32 ? out + O_CKS : out + O_CVS) + ((size_t)(l * 128 + b) * 128 + 124 + i) * 128 + (c4 & 127); *(f32x4*)o = kv; }
            }
            {
                const f32x4 x = gelu4(ld4bf(pr + C_DV + c4));
                const float mean = wave_sum(x[0] + x[1] + x[2] + x[3]) * (1.f / 256.f);
                const f32x4 xc = x - mean;
                const float var = wave_sum(xc[0] * xc[0] + xc[1] * xc[1] + xc[2] * xc[2] + xc[3] * xc[3]) * (1.f / 256.f);
                const f32x4 y = xc * rsqrtf(var + EPS) * lng + lnb;
                st4bf(dvn + r * 256 + c4, y);
                if (smp) {
                    *(f32x4*)(out + O_CHV + ((size_t)(l * 128 + b) * 4 + i) * 256 + c4) = y;
                    if (i == 0) h0 = y; else if (i == 1) h1 = y; else if (i == 2) h2 = y; else h3 = y;
                    f32x4 mx = Wd[i * 128 + 0] * h0 + biasd[i];
                    if (i >= 1) mx = mx + Wd[i * 128 + 1] * h1;
                    if (i >= 2) mx = mx + Wd[i * 128 + 2] * h2;
                    if (i >= 3) mx = mx + Wd[i * 128 + 3] * h3;
                    st4bf(mix + r * DM + 768 + c4, gelu4(ld4bf(pr + C_DU + c4)) * mx);
                }
            }
        }
    }
}

constexpr int A2_LDS = 64 * 68 * 4 + 512;
DEVI int fragidx(int row, int col) { return (((row >> 4) * 2 + (col >> 5)) * 64 + ((col >> 2) & 3) * 16 + (row & 15)) * 8 + 4 * ((col >> 4) & 1) + (col & 3); }
__device__ void a2_item(const Args& a, const int it, unsigned char* wl) {
    const int lane = tidx() & 63, fr = lane & 15, fq = lane >> 4;
    float* Aw = (float*)wl; float* gcs = Aw + 64 * 68; float* bts = gcs + 64;
    const int h = it & 3, n = (it >> 2) & 63, b = it >> 8;
    const size_t t0 = (size_t)b * 4096 + n * 64;
    const float* bg = (const float*)(wsp(a) + WS_BG); const bf16_t* qkvn = (const bf16_t*)(wsp(a) + WS_XB);
    float gcv = bg[(t0 + lane) * 8 + 4 + h]; const float bt = bg[(t0 + lane) * 8 + h];
    for (int d = 1; d < 64; d <<= 1) { const float o = __shfl_up(gcv, d); if (lane >= d) gcv += o; }
    const float gl = __shfl(gcv, 63);
    gcs[lane] = gcv; bts[lane] = bt;
    const bf16_t* qb = qkvn + t0 * 768 + h * 64; const bf16_t* kb = qb + 256; const bf16_t* vb = qb + 512;
    bf16x8 kf[4][2], qf[4][2];
#pragma unroll
    for (int m = 0; m < 4; ++m)
#pragma unroll
        for (int kk = 0; kk < 2; ++kk) { kf[m][kk] = *(const bf16x8*)(kb + (size_t)(16 * m + fr) * 768 + 32 * kk + 8 * fq); qf[m][kk] = *(const bf16x8*)(qb + (size_t)(16 * m + fr) * 768 + 32 * kk + 8 * fq); }
    wave_lds_fence();
    unsigned char* cbase = wsp(a) + WS_A2 + (size_t)it * 49152;
    if (lane == 0) ((float*)(wsp(a) + WS_GLS))[it] = gl;
#pragma unroll
    for (int m = 0; m < 4; ++m) {
        const int i = 16 * m + fr; const float gi = gcs[i], bi = bts[i];
#pragma unroll
        for (int k2 = 0; k2 < 2; ++k2) {
            f32x4 ak[2], aq[2];
#pragma unroll
            for (int hh = 0; hh < 2; ++hh) {
                const int nn = 2 * k2 + hh;
                ak[hh] = (f32x4){0.f, 0.f, 0.f, 0.f}; aq[hh] = (f32x4){0.f, 0.f, 0.f, 0.f};
                if (nn <= m) {
#pragma unroll
                    for (int kk = 0; kk < 2; ++kk) { ak[hh] = MFMA16(kf[nn][kk], kf[m][kk], ak[hh]); aq[hh] = MFMA16(kf[nn][kk], qf[m][kk], aq[hh]); }
                    const f32x4 gj = *(const f32x4*)(gcs + 16 * nn + 4 * fq);
#pragma unroll
                    for (int jj = 0; jj < 4; ++jj) { const int j = 16 * nn + 4 * fq + jj; const float e = __expf(fminf(gi - gj[jj], 0.f));
                        ak[hh][jj] = (j < i) ? bi * ak[hh][jj] * e : 0.f; aq[hh][jj] = (j <= i) ? aq[hh][jj] * e : 0.f; }
                }
                *(f32x4*)(Aw + i * 68 + 16 * nn + 4 * fq) = ak[hh];
            }
            *(uint4*)(cbase + ((m * 2 + k2) * 64 + lane) * 16) = pack8u(aq[0], aq[1]);
        }
    }
#pragma unroll
    for (int m = 0; m < 4; ++m)
#pragma unroll
        for (int kk = 0; kk < 2; ++kk) { const int i = 16 * m + fr; const float e = __expf(gcs[i]);
            const f32x4 lo = ld4bf(qb + (size_t)i * 768 + 32 * kk + 4 * fq) * e, hi = ld4bf(qb + (size_t)i * 768 + 32 * kk + 16 + 4 * fq) * e;
            *(uint4*)(cbase + 16384 + ((m * 2 + kk) * 64 + lane) * 16) = pack8u(lo, hi); }
    wave_lds_fence();
    const int c = lane;
    bf16_t* wF = (bf16_t*)(cbase + 8192); bf16_t* kdF = (bf16_t*)(cbase + 24576); float* uS = (float*)(cbase + 32768);
    {
        float U[64];
#pragma unroll
        for (int i = 0; i < 64; ++i) {
            const float vi = bf2f(vb[(size_t)i * 768 + c]);
            float su = bts[i] * vi;
#pragma unroll
            for (int j0 = 0; j0 < i; j0 += 4) { const f32x4 a4 = *(const f32x4*)(Aw + i * 68 + j0);
#pragma unroll
                for (int jj = 0; jj < 4; ++jj) if (j0 + jj < i) su -= a4[jj] * U[j0 + jj]; }
            U[i] = su;
            uS[(((c >> 4) * 4 + (i >> 4)) * 64 + ((i >> 2) & 3) * 16 + (c & 15)) * 4 + (i & 3)] = su;
            asm volatile("" ::: "memory");
        }
    }
    {
        float W[64];
#pragma unroll
        for (int i = 0; i < 64; ++i) {
            const float ki = bf2f(kb[(size_t)i * 768 + c]);
            const float bi = bts[i], gi = gcs[i];
            float sw = bi * __expf(gi) * ki;
#pragma unroll
            for (int j0 = 0; j0 < i; j0 += 4) { const f32x4 a4 = *(const f32x4*)(Aw + i * 68 + j0);
#pragma unroll
                for (int jj = 0; jj < 4; ++jj) if (j0 + jj < i) sw -= a4[jj] * W[j0 + jj]; }
            W[i] = sw;
            kdF[fragidx(c, i)] = f2bf(ki * __expf(gl - gi));
            wF[fragidx(i, c)] = f2bf(sw);
            asm volatile("" ::: "memory");
        }
    }
}

__device__ void sdelta_item(const Args& a, const int l, const int it) {
    const int lane = tidx() & 63, h = it & 3, b = it >> 2;
    const float* S0 = inp(a, 2) + ((size_t)(l * 128 + b) * 4 + h) * 4096;
    const float* bg = (const float*)(wsp(a) + WS_BG); const bf16_t* qkvn = (const bf16_t*)(wsp(a) + WS_XB); float* oraw = (float*)(wsp(a) + WS_ORAW);
    float S[64];
#pragma unroll
    for (int i = 0; i < 64; ++i) S[i] = S0[i * 64 + lane];
    for (int t = 0; t < 4; ++t) {
        const size_t r = (size_t)MP + 4 * b + t; const bf16_t* p = qkvn + r * 768 + h * 64 + lane;
        const float qv = bf2f(p[0]), kv = bf2f(p[256]), vv = bf2f(p[512]); const float beta = bg[r * 8 + h], eg = __expf(bg[r * 8 + 4 + h]);
        float rr = 0.f;
#pragma unroll
        for (int i = 0; i < 64; ++i) { S[i] *= eg; rr += rdlane(kv, i) * S[i]; }
        const float cc = beta * (vv - rr); float oo = 0.f;
#pragma unroll
        for (int i = 0; i < 64; ++i) { S[i] += rdlane(kv, i) * cc; oo += rdlane(qv, i) * S[i]; }
        oraw[r * 256 + h * 64 + lane] = oo;
    }
    float* So = outp(a) + O_SDS + ((size_t)(l * 128 + b) * 4 + h) * 4096;
#pragma unroll
    for (int i = 0; i < 64; ++i) So[i * 64 + lane] = S[i];
}

__device__ void sattn_item(const Args& a, const int l, const int it) {
    const int lane = tidx() & 63, hq = it & 3, b = it >> 2, kvh = hq >> 1;
    const float* ck = inp(a, 5) + (size_t)(l * 128 + b) * 16384 + kvh * 64; const float* cv = inp(a, 6) + (size_t)(l * 128 + b) * 16384 + kvh * 64;
    const bf16_t* qr = (const bf16_t*)(wsp(a) + WS_QR); const bf16_t* kvr = (const bf16_t*)(wsp(a) + WS_KVR); bf16_t* mix = (bf16_t*)(wsp(a) + WS_MIX);
    const size_t r0 = (size_t)MP + 4 * b;
    float qv[4];
#pragma unroll
    for (int i = 0; i < 4; ++i) qv[i] = bf2f(qr[(r0 + i) * 256 + hq * 64 + lane]);
    float s[3][4];
#pragma unroll
    for (int sl = 0; sl < 3; ++sl) {
        float acc0 = 0.f, acc1 = 0.f, acc2 = 0.f, acc3 = 0.f;
        if (sl < 2) { const float* kp = ck + (size_t)(sl * 64 + lane) * 128;
#pragma unroll
            for (int d4 = 0; d4 < 16; ++d4) { const f32x4 kx = *(const f32x4*)(kp + d4 * 4);
#pragma unroll
                for (int e = 0; e < 4; ++e) { const int d = d4 * 4 + e; acc0 += rdlane(qv[0], d) * kx[e]; acc1 += rdlane(qv[1], d) * kx[e]; acc2 += rdlane(qv[2], d) * kx[e]; acc3 += rdlane(qv[3], d) * kx[e]; } }
        } else { const bf16_t* kp = kvr + (r0 + (lane & 3)) * 256 + kvh * 64;
#pragma unroll
            for (int d4 = 0; d4 < 16; ++d4) { const f32x4 kx = ld4bf(kp + d4 * 4);
#pragma unroll
                for (int e = 0; e < 4; ++e) { const int d = d4 * 4 + e; acc0 += rdlane(qv[0], d) * kx[e]; acc1 += rdlane(qv[1], d) * kx[e]; acc2 += rdlane(qv[2], d) * kx[e]; acc3 += rdlane(qv[3], d) * kx[e]; } }
        }
        s[sl][0] = acc0; s[sl][1] = acc1; s[sl][2] = acc2; s[sl][3] = acc3;
    }
    const float sink = inp(a, 15)[l * 4 + hq];
    float inv[4];
#pragma unroll
    for (int i = 0; i < 4; ++i) {
        const bool v0 = lane > i, v1 = true, v2 = lane <= i && lane < 4;
        const float x0 = v0 ? s[0][i] * 0.125f : -1e30f, x1 = v1 ? s[1][i] * 0.125f : -1e30f, x2 = v2 ? s[2][i] * 0.125f : -1e30f;
        float mx = fmaxf(fmaxf(x0, x1), x2);
        for (int d = 1; d < 64; d <<= 1) mx = fmaxf(mx, __shfl_xor(mx, d));
        mx = fmaxf(mx, sink);
        const float p0 = v0 ? __expf(x0 - mx) : 0.f, p1 = __expf(x1 - mx), p2 = v2 ? __expf(x2 - mx) : 0.f;
        const float sum = wave_sum(p0 + p1 + p2) + __expf(sink - mx);
        s[0][i] = p0; s[1][i] = p1; s[2][i] = p2; inv[i] = 1.f / sum;
    }
    float o[4] = {0.f, 0.f, 0.f, 0.f};
#pragma unroll
    for (int sl = 0; sl < 2; ++sl)
        for (int jj = 0; jj < 64; ++jj) { const float vv = cv[(size_t)(sl * 64 + jj) * 128 + lane];
#pragma unroll
            for (int i = 0; i < 4; ++i) o[i] += rdlane(s[sl][i], jj) * vv; }
#pragma unroll
    for (int jj = 0; jj < 4; ++jj) { const float vv = bf2f(kvr[(r0 + jj) * 256 + 128 + kvh * 64 + lane]);
#pragma unroll
        for (int i = 0; i < 4; ++i) o[i] += rdlane(s[2][i], jj) * vv; }
#pragma unroll
    for (int i = 0; i < 4; ++i) mix[(r0 + i) * DM + 512 + hq * 64 + lane] = f2bf(o[i] * inv[i]);
}

__device__ void c_item(const Args& a, const int l, const int it, unsigned char* smem) {
    const int tid = tidx(), lane = tid & 63, w = tid >> 6, fr = lane & 15, fq = lane >> 4;
    const int qb = it & 63, kvh = (it >> 6) & 1, b = it >> 7;
    bf16_t* Ks = (bf16_t*)smem; bf16_t* Vt = Ks + 192 * 72;
    const bf16_t* kvr = (const bf16_t*)(wsp(a) + WS_KVR); const bf16_t* qr = (const bf16_t*)(wsp(a) + WS_QR); bf16_t* mix = (bf16_t*)(wsp(a) + WS_MIX);
    const int kp0 = 64 * qb - 128;
    for (int id = tid; id < 1536; id += 512) { const int row = id >> 3, c8 = id & 7, kp = kp0 + row; uint4 kq = {0u, 0u, 0u, 0u}, vq = {0u, 0u, 0u, 0u};
        if (kp >= 0) { const bf16_t* src = kvr + ((size_t)b * 4096 + kp) * 256 + kvh * 64 + c8 * 8; kq = *(const uint4*)src; vq = *(const uint4*)(src + 128); }
        *(uint4*)(Ks + row * 72 + c8 * 8) = kq; bf16_t* vd = Vt + (c8 * 8) * 200 + row;
        vd[0] = (bf16_t)(vq.x & 0xffffu); vd[200] = (bf16_t)(vq.x >> 16); vd[400] = (bf16_t)(vq.y & 0xffffu); vd[600] = (bf16_t)(vq.y >> 16);
        vd[800] = (bf16_t)(vq.z & 0xffffu); vd[1000] = (bf16_t)(vq.z >> 16); vd[1200] = (bf16_t)(vq.w & 0xffffu); vd[1400] = (bf16_t)(vq.w >> 16); }
    __syncthreads();
    const int hq = 2 * kvh + (w >> 2), wq = w & 3, qrow0 = 64 * qb + 16 * wq, kb = 16 * wq;
    const bf16_t* qp = qr + ((size_t)b * 4096 + qrow0 + fr) * 256 + hq * 64 + 8 * fq;
    const bf16x8 qf0 = *(const bf16x8*)qp, qf1 = *(const bf16x8*)(qp + 32);
    f32x4 s[9];
#pragma unroll
    for (int nn = 0; nn < 9; ++nn) { const bf16_t* kr = Ks + (kb + 16 * nn + fr) * 72 + 8 * fq; s[nn] = (f32x4){0.f, 0.f, 0.f, 0.f};
        s[nn] = MFMA16(*(const bf16x8*)kr, qf0, s[nn]); s[nn] = MFMA16(*(const bf16x8*)(kr + 32), qf1, s[nn]); }
    const int tq = qrow0 + fr; const float sink = inp(a, 15)[l * 4 + hq];
    float mx = sink;
#pragma unroll
    for (int nn = 0; nn < 9; ++nn)
#pragma unroll
        for (int jj = 0; jj < 4; ++jj) { const int tk = kp0 + kb + 16 * nn + 4 * fq + jj; const bool ok = tk >= 0 && tk <= tq && tk > tq - 128;
            const float v = ok ? s[nn][jj] * 0.125f : -1e30f; s[nn][jj] = v; mx = fmaxf(mx, v); }
    mx = fmaxf(mx, __shfl_xor(mx, 16)); mx = fmaxf(mx, __shfl_xor(mx, 32));
    float sum = 0.f;
#pragma unroll
    for (int nn = 0; nn < 9; ++nn)
#pragma unroll
        for (int jj = 0; jj < 4; ++jj) { const float p = s[nn][jj] > -1e29f ? __expf(s[nn][jj] - mx) : 0.f; s[nn][jj] = p; sum += p; }
    sum += __shfl_xor(sum, 16); sum += __shfl_xor(sum, 32); sum += __expf(sink - mx);
    bf16x8 pb[5];
#pragma unroll
    for (int kk = 0; kk < 4; ++kk) pb[kk] = pack8(s[2 * kk], s[2 * kk + 1]);
    pb[4] = pack8(s[8], (f32x4){0.f, 0.f, 0.f, 0.f});
    const float inv = 1.f / sum;
#pragma unroll
    for (int m = 0; m < 4; ++m) { f32x4 o = {0.f, 0.f, 0.f, 0.f};
#pragma unroll
        for (int kk = 0; kk < 5; ++kk) { const bf16_t* vp = Vt + (16 * m + fr) * 200 + kb + 32 * kk + 4 * fq;
            const bf16x4 lo = *(const bf16x4*)vp; bf16x4 hi = {0, 0, 0, 0}; if (kk < 4) hi = *(const bf16x4*)(vp + 16);
            const bf16x8 af = {lo[0], lo[1], lo[2], lo[3], hi[0], hi[1], hi[2], hi[3]};
            o = MFMA16(af, pb[kk], o); }
        st4bf(mix + ((size_t)b * 4096 + tq) * DM + 512 + hq * 64 + 16 * m + 4 * fq, o * inv); }
    __syncthreads();
}

__device__ void d_item(const Args& a, const int l, const int it, unsigned char* smem) {
    const int tid = tidx(), lane = tid & 63, w = tid >> 6, fr = lane & 15, fq = lane >> 4;
    const int g = it & 3, ch = (it >> 2) & 31, b = it >> 7;
    bf16_t* vT = (bf16_t*)smem;
    const bf16_t* dvn = (const bf16_t*)(wsp(a) + WS_DVN); const bf16_t* proj = (const bf16_t*)(wsp(a) + WS_PROJ); bf16_t* mix = (bf16_t*)(wsp(a) + WS_MIX);
    const size_t r0 = (size_t)b * 4096 + 128 * ch;
    for (int id = tid; id < 1024; id += 512) { const int row = id >> 3, c8 = id & 7; const uint4 vq = *(const uint4*)(dvn + (r0 + row) * 256 + g * 64 + c8 * 8); bf16_t* vd = vT + (c8 * 8) * 136 + row;
        vd[0] = (bf16_t)(vq.x & 0xffffu); vd[136] = (bf16_t)(vq.x >> 16); vd[272] = (bf16_t)(vq.y & 0xffffu); vd[408] = (bf16_t)(vq.y >> 16);
        vd[544] = (bf16_t)(vq.z & 0xffffu); vd[680] = (bf16_t)(vq.z >> 16); vd[816] = (bf16_t)(vq.w & 0xffffu); vd[952] = (bf16_t)(vq.w >> 16); }
    __syncthreads();
    const float* Wg = inp(a, 18) + ((size_t)(l * 4 + g) * 128) * 128;
    const int t = 16 * w + fr;
    f32x4 acc[4];
#pragma unroll
    for (int n = 0; n < 4; ++n) acc[n] = (f32x4){0.f, 0.f, 0.f, 0.f};
#pragma unroll
    for (int kk = 0; kk < 4; ++kk) if (kk <= (w >> 1)) {
        const float* wp = Wg + (size_t)t * 128 + 32 * kk + 8 * fq; f32x4 w0 = *(const f32x4*)wp, w1 = *(const f32x4*)(wp + 4);
#pragma unroll
        for (int e = 0; e < 4; ++e) { if (32 * kk + 8 * fq + e > t) w0[e] = 0.f; if (32 * kk + 8 * fq + 4 + e > t) w1[e] = 0.f; }
        const bf16x8 bfr = pack8(w0, w1);
#pragma unroll
        for (int n = 0; n < 4; ++n) acc[n] = MFMA16(*(const bf16x8*)(vT + (16 * n + fr) * 136 + 32 * kk + 8 * fq), bfr, acc[n]);
    }
    const float bias = inp(a, 19)[(size_t)(l * 4 + g) * 128 + t];
    const size_t r = r0 + t;
#pragma unroll
    for (int n = 0; n < 4; ++n) { const f32x4 du = gelu4(ld4bf(proj + r * PS + C_DU + g * 64 + 16 * n + 4 * fq)); st4bf(mix + r * DM + 768 + g * 64 + 16 * n + 4 * fq, du * (acc[n] + bias)); }
    __syncthreads();
}

__device__ void phase_chunk(const Args& a, const int l, unsigned char* smem) {
    const int wid = tidx() >> 6, gw = bidx() * 8 + wid, nw = gdim() * 8;
#ifndef CHMASK
#define CHMASK 15
#endif
    if (CHMASK & 1) for (int it = gw; it < 2048; it += nw) a2_item(a, it, smem + wid * A2_LDS);
    if (CHMASK & 2) for (int it = gw; it < 512; it += nw) sattn_item(a, l, it);
    __syncthreads();
    if (CHMASK & 4) for (int it = bidx(); it < 1024; it += gdim()) c_item(a, l, it, smem);
    if (CHMASK & 8) for (int it = bidx(); it < 1024; it += gdim()) d_item(a, l, it, smem);
}

__device__ void phase_scan(const Args& a, const int l) {
    const int lane = tidx() & 63, wid = tidx() >> 6, fr = lane & 15, fq = lane >> 4;
    float* oraw = (float*)(wsp(a) + WS_ORAW);
    if (bidx() >= 32 || gdim() < 64) {
        const int nb = gdim() < 64 ? gdim() : gdim() - 32, bi = gdim() < 64 ? bidx() : bidx() - 32;
        for (int it = bi * 8 + wid; it < 512; it += nb * 8) sdelta_item(a, l, it);
        if (gdim() >= 64) return;
    }
    if (wid >= 4) return;
    for (int bh = bidx(); bh < 32; bh += gdim()) {
        const int b = bh >> 2, h = bh & 3, sl = wid;
        f32x4 S[4];
#pragma unroll
        for (int m = 0; m < 4; ++m) S[m] = (f32x4){0.f, 0.f, 0.f, 0.f};
        for (int n = 0; n < 64; ++n) {
            const int it = ((b * 64 + n) * 4 + h);
            const unsigned char* cbase = wsp(a) + WS_A2 + (size_t)it * 49152;
            bf16x8 wf[4][2], qd[4][2], qk[4][2], kd[4][2]; f32x4 u[4];
#pragma unroll
            for (int m = 0; m < 4; ++m) {
#pragma unroll
                for (int kk = 0; kk < 2; ++kk) { const size_t o = (size_t)((m * 2 + kk) * 64 + lane) * 16;
                    wf[m][kk] = *(const bf16x8*)(cbase + 8192 + o); qk[m][kk] = *(const bf16x8*)(cbase + o); qd[m][kk] = *(const bf16x8*)(cbase + 16384 + o); kd[m][kk] = *(const bf16x8*)(cbase + 24576 + o); }
                u[m] = *(const f32x4*)(cbase + 32768 + (size_t)((sl * 4 + m) * 64 + lane) * 16);
            }
            const float egl = __expf(((const float*)(wsp(a) + WS_GLS))[it]);
            bf16x8 Sb[2], Vb[2];
            Sb[0] = pack8(S[0], S[1]); Sb[1] = pack8(S[2], S[3]);
            f32x4 vn[4], O[4];
#pragma unroll
            for (int m = 0; m < 4; ++m) { f32x4 T = {0.f, 0.f, 0.f, 0.f}; T = MFMA16(wf[m][0], Sb[0], T); T = MFMA16(wf[m][1], Sb[1], T); vn[m] = u[m] - T; }
            Vb[0] = pack8(vn[0], vn[1]); Vb[1] = pack8(vn[2], vn[3]);
#pragma unroll
            for (int m = 0; m < 4; ++m) { f32x4 o = {0.f, 0.f, 0.f, 0.f}; o = MFMA16(qd[m][0], Sb[0], o); o = MFMA16(qd[m][1], Sb[1], o); o = MFMA16(qk[m][0], Vb[0], o); o = MFMA16(qk[m][1], Vb[1], o); O[m] = o; }
#pragma unroll
            for (int m = 0; m < 4; ++m) { f32x4 s2 = S[m] * egl; s2 = MFMA16(kd[m][0], Vb[0], s2); s2 = MFMA16(kd[m][1], Vb[1], s2); S[m] = s2; }
            const size_t t0 = (size_t)b * 4096 + n * 64;
#pragma unroll
            for (int m = 0; m < 4; ++m)
#pragma unroll
                for (int jj = 0; jj < 4; ++jj) oraw[(t0 + 16 * m + 4 * fq + jj) * 256 + h * 64 + 16 * sl + fr] = O[m][jj];
        }
        float* So = outp(a) + O_SDP + ((size_t)(l * 8 + b) * 4 + h) * 4096;
#pragma unroll
        for (int m = 0; m < 4; ++m)
#pragma unroll
            for (int jj = 0; jj < 4; ++jj) So[(16 * m + 4 * fq + jj) * 64 + 16 * sl + fr] = S[m][jj];
    }
}

__device__ void phase_aout(const Args& a, const int l) {
    const int lane = tidx() & 63, wid = tidx() >> 6, c4 = lane * 4;
    const float* oraw = (const float*)(wsp(a) + WS_ORAW); const bf16_t* proj = (const bf16_t*)(wsp(a) + WS_PROJ); bf16_t* mix = (bf16_t*)(wsp(a) + WS_MIX);
    const f32x4 g = *(const f32x4*)(inp(a, 13) + l * 64 + (c4 & 63));
    for (int r = bidx() * 8 + wid; r < M; r += gdim() * 8) {
        const f32x4 o = *(const f32x4*)(oraw + (size_t)r * 256 + c4);
        const float ss = red16(o[0] * o[0] + o[1] * o[1] + o[2] * o[2] + o[3] * o[3]);
        const f32x4 y = o * rsqrtf(ss * (1.f / 64.f) + EPS) * g;
        st4bf(mix + (size_t)r * DM + c4, y * silu4(ld4bf(proj + (size_t)r * PS + C_AZ + c4)));
    }
}

__device__ void phase_fix(const Args& a, const int l) {
    const float* sg = (const float*)(wsp(a) + WS_SG); const float* su = (const float*)(wsp(a) + WS_SU); bf16_t* act = (bf16_t*)(wsp(a) + WS_PROJ);
    const float* cw = inp(a, 24) + (size_t)l * 3 * FF;
    for (int idx = bidx() * 512 + tidx(); idx < 512 * 2 * 704; idx += gdim() * 512) {
        const int f = (idx % 704) * 4, q = (idx / 704) & 1, blk = idx / 1408; const bool prev = (blk & 63) != 0;
        const f32x4 z4 = {0.f, 0.f, 0.f, 0.f};
        const f32x4 g0 = *(const f32x4*)(sg + ((size_t)blk * 4 + q) * FF + f), up = *(const f32x4*)(su + ((size_t)blk * 2 + q) * FF + f);
        f32x4 gm2, gm1;
        if (q == 0) { gm2 = prev ? *(const f32x4*)(sg + ((size_t)(blk - 1) * 4 + 2) * FF + f) : z4; gm1 = prev ? *(const f32x4*)(sg + ((size_t)(blk - 1) * 4 + 3) * FF + f) : z4; }
        else { gm2 = prev ? *(const f32x4*)(sg + ((size_t)(blk - 1) * 4 + 3) * FF + f) : z4; gm1 = *(const f32x4*)(sg + ((size_t)blk * 4 + 0) * FF + f); }
        const f32x4 gc = *(const f32x4*)(cw + f) * gm2 + *(const f32x4*)(cw + FF + f) * gm1 + *(const f32x4*)(cw + 2 * FF + f) * g0;
        st4bf(act + ((size_t)blk * 64 + q) * FF + f, silu4(gc) * up);
    }
}

__device__ void phase_final(const Args& a) {
    const int lane = tidx() & 63, wid = tidx() >> 6;
    const float* ssq = (const float*)(wsp(a) + WS_SSQA); const float* g = inp(a, 26);
    for (int r = bidx() * 8 + wid; r < M; r += gdim() * 8) {
        const float sc = rowscale(ssq, r); float* xr = outp(a) + (size_t)r * DM;
#pragma unroll
        for (int q = 0; q < 4; ++q) { const int c = q * 256 + lane * 4; *(f32x4*)(xr + c) = *(const f32x4*)(xr + c) * sc * *(const f32x4*)(g + c); }
    }
}

constexpr int NPH = 20, LDS_BYTES = 147456;
__global__ void __launch_bounds__(512) fwd_kernel(Args a0) {
    extern __shared__ __attribute__((aligned(16))) unsigned char smem[];
    LAS unsigned char* lds = (LAS unsigned char*)smem;
#pragma unroll 1
    for (int ph = a0.ph_lo; ph < a0.ph_hi; ++ph) {
        if (ph > a0.ph_lo && a0.coop) cg::this_grid().sync();
        const Args& a = a0;
#ifndef PHMASK
#define PHMASK 0xFFFFF
#endif
        if (ph == 0) { if (PHMASK & 1) phase_prep(a, smem); continue; }
        if (ph == NPH - 1) { if (PHMASK & 2) phase_final(a); continue; }
        const int l = (ph - 1) / 9, sp = (ph - 1) % 9;
        pg8::StaticOrder S;
        if (!((PHMASK >> (2 + sp)) & 1)) continue;
        switch (sp) {
        case 0: { pg8::Gemm g{(const bf16_t*)(wsp(a) + WS_XB), (const bf16_t*)(wsp(a) + WS_WIN) + (size_t)l * NPAD * 1024, M, NPAD, 1024}; S.init(M, NPAD, gdim(), bidx());
            EpiProj E{(bf16_t*)(wsp(a) + WS_PROJ), (const float*)(wsp(a) + WS_SSQA)}; pg8::gemm_phase(lds, g, S, E); } break;
        case 1: phase_tok(a, l); break;
        case 2: phase_chunk(a, l, smem); break;
        case 3: phase_scan(a, l); break;
        case 4: phase_aout(a, l); break;
        case 5: { pg8::Gemm g{(const bf16_t*)(wsp(a) + WS_MIX), (const bf16_t*)(wsp(a) + WS_WOUT) + (size_t)l * 1024 * 1024, M, 1024, 1024}; S.init(M, 1024, gdim(), bidx());
            EpiRes E{l == 0 ? inp(a, 0) : outp(a), l == 0 ? inp(a, 1) : outp(a) + O_YS, outp(a), (bf16_t*)(wsp(a) + WS_XB), (float*)(wsp(a) + WS_SSQB)}; pg8::gemm_phase(lds, g, S, E); } break;
        case 6: { pg8::Gemm g{(const bf16_t*)(wsp(a) + WS_XB), (const bf16_t*)(wsp(a) + WS_WGU) + (size_t)l * 5632 * 1024, M, 5632, 1024}; S.init(M, 5632, gdim(), bidx());
            EpiGU E{(bf16_t*)(wsp(a) + WS_PROJ), (const float*)(wsp(a) + WS_SSQB), inp(a, 24) + (size_t)l * 3 * FF, inp(a, 7) + (size_t)l * 128 * 2 * FF, (float*)(wsp(a) + WS_SG), (float*)(wsp(a) + WS_SU),
                    outp(a) + O_SFP + (size_t)l * 8 * 2 * FF, outp(a) + O_SFS + (size_t)l * 128 * 2 * FF}; pg8::gemm_phase(lds, g, S, E); } break;
        case 7: phase_fix(a, l); break;
        default: { pg8::Gemm g{(const bf16_t*)(wsp(a) + WS_PROJ), (const bf16_t*)(wsp(a) + WS_WDN) + (size_t)l * 1024 * FF, M, 1024, FF}; S.init(M, 1024, gdim(), bidx());
            EpiRes E{outp(a), outp(a) + O_YS, outp(a), (bf16_t*)(wsp(a) + WS_XB), (float*)(wsp(a) + WS_SSQA)}; pg8::gemm_phase(lds, g, S, E); } break;
        }
    }
}

extern "C" void kernel_launch(void* const* d_in, const int* in_sizes, int n_in, void* d_out, int out_size, void* d_ws, size_t ws_size, hipStream_t stream) {
    static int grid = 0;
    if (grid == 0) {
        if (n_in != 27 || (size_t)out_size != O_END || ws_size < WS_END) { fprintf(stderr, "kernel_launch: unexpected sizes n_in %d out %d ws %zu (need %zu)\n", n_in, out_size, ws_size, (size_t)WS_END); grid = -1; return; }
        int dev = 0, cus = 0, per_cu = 0;
        hipGetDevice(&dev); hipDeviceGetAttribute(&cus, hipDeviceAttributeMultiprocessorCount, dev);
        if (hipFuncSetAttribute((const void*)fwd_kernel, hipFuncAttributeMaxDynamicSharedMemorySize, LDS_BYTES) != hipSuccess) { fprintf(stderr, "kernel_launch: hipFuncSetAttribute failed\n"); grid = -1; return; }
        hipOccupancyMaxActiveBlocksPerMultiprocessor(&per_cu, (const void*)fwd_kernel, 512, LDS_BYTES);
        (void)hipGetLastError();
        if (per_cu < 1) per_cu = 1;
        grid = cus * 1;
        if (grid <= 0) grid = 256;
    }
    if (grid < 0) return;
    Args a{};
    for (int i = 0; i < 27; ++i) a.in[i] = (const float*)d_in[i];
    a.out = (float*)d_out; a.ws = (unsigned char*)d_ws;
#if ONE_LAUNCH
    a.coop = 1; a.ph_lo = 0; a.ph_hi = NPH;
    void* args[] = {&a};
    hipError_t e = hipLaunchCooperativeKernel((const void*)fwd_kernel, dim3(grid), dim3(512), args, LDS_BYTES, stream);
    if (e != hipSuccess) fprintf(stderr, "cooperative launch failed: %s (grid %d)\n", hipGetErrorString(e), grid);
#else
    a.coop = 0;
    for (int ph = 0; ph < NPH; ++ph) { a.ph_lo = ph; a.ph_hi = ph + 1; hipLaunchKernelGGL(fwd_kernel, dim3(grid), dim3(512), LDS_BYTES, stream, a); }
#endif
}
```

```cpp
#include <hip/hip_runtime.h>
#include <hip/hip_cooperative_groups.h>
#include <cstdio>
namespace cg = cooperative_groups;

#define DEVI __device__ __forceinline__
#define LAS __attribute__((address_space(3)))
typedef unsigned short bf16_t;
typedef short bf16x8 __attribute__((ext_vector_type(8)));
typedef short bf16x4 __attribute__((ext_vector_type(4)));
typedef float f32x4 __attribute__((ext_vector_type(4)));

#ifndef ONE_LAUNCH
#define ONE_LAUNCH 1
#endif

constexpr int MP = 32768, MS = 512, M = MP + MS, DM = 1024, FF = 2816, PS = 2824  , NPAD = 3072;
constexpr int C_AQ = 0, C_AZ = 768, C_BB = 1024, C_BC = 1280, C_BH = 1536, C_CQ = 1792, C_CK = 2048, C_DU = 2304, C_DV = 2560, C_AB = 2816, C_AA = 2820;
constexpr float EPS = 1e-6f;

constexpr size_t O_YP = 0, O_YS = O_YP + (size_t)MP * DM, O_SDP = O_YS + (size_t)MS * DM, O_SDS = O_SDP + 2 * 8 * 4 * 4096, O_SCP = O_SDS + 2 * 128 * 4 * 4096,
                 O_SCS = O_SCP + 2 * 8 * 3 * 768, O_SSP = O_SCS + 2 * 128 * 3 * 768, O_SSS = O_SSP + 2 * 8 * 2 * 256, O_CKP = O_SSS + 2 * 128 * 2 * 256,
                 O_CKS = O_CKP + 2 * 8 * 128 * 128, O_CVP = O_CKS + 2 * 128 * 128 * 128, O_CVS = O_CVP + 2 * 8 * 128 * 128, O_SFP = O_CVS + 2 * 128 * 128 * 128,
                 O_SFS = O_SFP + 2 * 8 * 2 * 2816, O_CHV = O_SFS + 2 * 128 * 2 * 2816, O_END = O_CHV + 2 * 128 * 4 * 256;
static_assert(O_END == 50008064, "output size");

constexpr size_t WS_WIN = 0, WS_WOUT = WS_WIN + (size_t)2 * NPAD * 1024 * 2, WS_WGU = WS_WOUT + (size_t)2 * 1024 * 1024 * 2, WS_WDN = WS_WGU + (size_t)2 * 5632 * 1024 * 2,
                 WS_XB = WS_WDN + (size_t)2 * 1024 * 2816 * 2,
                 WS_PROJ = WS_XB + (size_t)M * 1024 * 2,
                 WS_MIX = WS_PROJ + (size_t)M * PS * 2,
                 WS_SSQA = WS_MIX + (size_t)M * 1024 * 2, WS_SSQB = WS_SSQA + (size_t)M * 16 * 4, WS_BG = WS_SSQB + (size_t)M * 16 * 4,
                 WS_GLS = WS_BG + (size_t)M * 8 * 4,
                 WS_QR = WS_GLS + 2048 * 4,
                 WS_KVR = WS_QR + (size_t)M * 256 * 2, WS_DVN = WS_KVR + (size_t)M * 256 * 2, WS_ORAW = WS_QR,
                 WS_A2 = WS_DVN + (size_t)M * 256 * 2,
                 WS_SG = WS_A2, WS_SU = WS_SG + (size_t)512 * 4 * 2816 * 4,
                 WS_END = WS_A2 + (size_t)2048 * 49152;
static_assert(WS_END <= (size_t)536870912, "workspace too large");
static_assert(WS_SU + (size_t)512 * 2 * 2816 * 4 <= WS_END, "side buffers");
static_assert((size_t)M * 256 * 4 <= (size_t)3 * M * 256 * 2, "oraw alias");

struct Args { const float* in[27]; float* out; unsigned char* ws; int coop; int ph_lo; int ph_hi; int pad; };

DEVI int tidx() { int t = threadIdx.x; asm volatile("" : "+v"(t)); return t; }
DEVI int bidx() { int t = blockIdx.x; asm volatile("" : "+s"(t)); return t; }
DEVI int gdim() { int t = gridDim.x; asm volatile("" : "+s"(t)); return t; }
DEVI float bf2f(bf16_t v) { return __uint_as_float(((unsigned)v) << 16); }
DEVI bf16_t f2bf(float f) { unsigned u = __float_as_uint(f); u += 0x7FFFu + ((u >> 16) & 1u); return (bf16_t)(u >> 16); }
DEVI unsigned pk2(float lo, float hi) { unsigned r; asm("v_cvt_pk_bf16_f32 %0, %1, %2" : "=v"(r) : "v"(lo), "v"(hi)); return r; }
DEVI f32x4 ld4bf(const bf16_t* p) { const uint2 u = *(const uint2*)p; f32x4 o; o[0] = __uint_as_float(u.x << 16); o[1] = __uint_as_float(u.x & 0xffff0000u); o[2] = __uint_as_float(u.y << 16); o[3] = __uint_as_float(u.y & 0xffff0000u); return o; }
DEVI void st4bf(bf16_t* p, f32x4 v) { uint2 u; u.x = pk2(v[0], v[1]); u.y = pk2(v[2], v[3]); *(uint2*)p = u; }
DEVI bf16x8 pack8(f32x4 a, f32x4 b) { union { uint4 u; bf16x8 v; } x; x.u.x = pk2(a[0], a[1]); x.u.y = pk2(a[2], a[3]); x.u.z = pk2(b[0], b[1]); x.u.w = pk2(b[2], b[3]); return x.v; }
DEVI uint4 pack8u(f32x4 a, f32x4 b) { uint4 u; u.x = pk2(a[0], a[1]); u.y = pk2(a[2], a[3]); u.z = pk2(b[0], b[1]); u.w = pk2(b[2], b[3]); return u; }
DEVI float wave_sum(float v) { for (int d = 1; d < 64; d <<= 1) v += __shfl_xor(v, d); return v; }
DEVI float red16(float v) { v += __shfl_xor(v, 1); v += __shfl_xor(v, 2); v += __shfl_xor(v, 4); v += __shfl_xor(v, 8); return v; }
DEVI float silu_f(float y) { return y / (1.f + __expf(-y)); }
DEVI float gelu_f(float x) { const float z = 0.7978845608028654f * (x + 0.044715f * x * x * x); return x / (1.f + __expf(-2.f * z)); }
DEVI f32x4 silu4(f32x4 v) { f32x4 o; for (int i = 0; i < 4; ++i) o[i] = silu_f(v[i]); return o; }
DEVI f32x4 gelu4(f32x4 v) { f32x4 o; for (int i = 0; i < 4; ++i) o[i] = gelu_f(v[i]); return o; }
DEVI float rdlane(float v, int l) { return __builtin_bit_cast(float, __builtin_amdgcn_readlane(__builtin_bit_cast(int, v), l)); }
DEVI void wave_lds_fence() { asm volatile("s_waitcnt lgkmcnt(0)" ::: "memory"); }
template <int CTRL> DEVI float dppf(float x) { return __builtin_bit_cast(float, __builtin_amdgcn_update_dpp(0, __builtin_bit_cast(int, x), CTRL, 0xf, 0xf, true)); }
DEVI float rowscale(const float* ssq, int r) { const f32x4* p = (const f32x4*)(ssq + (size_t)r * 16); const f32x4 a = p[0], b = p[1], c = p[2], d = p[3];
    const float s = (a[0] + a[1] + a[2] + a[3]) + (b[0] + b[1] + b[2] + b[3]) + (c[0] + c[1] + c[2] + c[3]) + (d[0] + d[1] + d[2] + d[3]); return rsqrtf(s * (1.f / 1024.f) + EPS); }
#define GLB __attribute__((address_space(1)))
DEVI unsigned char* wsp(const Args& a) { GLB unsigned char* p = (GLB unsigned char*)a.ws; asm volatile("" : "+s"(p)); return (unsigned char*)p; }
DEVI float* outp(const Args& a) { GLB float* p = (GLB float*)a.out; asm volatile("" : "+s"(p)); return (float*)p; }
DEVI const float* inp(const Args& a, int k) { GLB const float* p = (GLB const float*)a.in[k]; asm volatile("" : "+s"(p)); return (const float*)p; }
#define MFMA16(a, b, c) __builtin_amdgcn_mfma_f32_16x16x32_bf16((a), (b), (c), 0, 0, 0)

namespace pg8 {
constexpr int BM = 256, BK = 64, HALF = 128, HTB = HALF * BK * 2, STAGE_BYTES = 8 * HTB, NXCD = 8, WGM = 8;
DEVI int lds_byte(int r, int c) { const int st = (r >> 4) * 2 + (c >> 5), rr = r & 15, cc = c & 31, ob = rr * 64 + cc * 2; return st * 1024 + (ob ^ (((ob >> 9) & 1) << 5)); }
DEVI void stage_rc(int b, int& R, int& C) { const int st = b / 1024, sb = b % 1024, swz = sb ^ (((sb >> 9) & 1) << 5); R = (st >> 1) * 16 + swz / 64; C = (st & 1) * 32 + (swz % 64) / 2; }
DEVI int perm32(int rho) { const int n = rho >> 4, i = rho & 15; return 8 * (i >> 2) + 4 * n + (i & 3); }
struct Unit { int pm, pn; };
struct Gemm { const bf16_t* A; const bf16_t* Bt; int M, N, K; };
struct StaticOrder {
    int nM, nN, nwg, G, c;
    DEVI void init(int M_, int N_, int G_, int c_) { nM = M_ / BM; nN = N_ / BM; nwg = nM * nN; G = G_; c = c_; }
    DEVI bool next(int i, Unit& u) const {
        const long L = (long)i * G + c; if (L >= nwg) return false;
        int wgid = (int)L; { const int q = nwg / NXCD, r = nwg % NXCD, xcd = wgid % NXCD, off = wgid / NXCD; wgid = (xcd < r ? xcd * (q + 1) : r * (q + 1) + (xcd - r) * q) + off; }
        const int nig = WGM * nN, gid = wgid / nig, fm = gid * WGM, gsz = (nM - fm) < WGM ? (nM - fm) : WGM;
        u.pm = fm + ((wgid % nig) % gsz); u.pn = (wgid % nig) / gsz; return true;
    }
    DEVI void a_ready(const Unit&) const {}
    DEVI void done(const Unit&) const {}
};
template <class Epi, class Sched>
DEVI void gemm_phase(LAS unsigned char* lds, const Gemm g, const Sched& S, const Epi& E) {
    const int tid = tidx(), wid = __builtin_amdgcn_readfirstlane(tid >> 6), lane = tid & 63, wr = wid >> 2, wc = wid & 3, fr = lane & 15, fq = lane >> 4;
    const int K = g.K, nt = K / BK;
    unsigned voffA[2], voffB[2];
#pragma unroll
    for (int i = 0; i < 2; ++i) { int R, C; stage_rc(tid * 16 + i * 8192, R, C); const int Rb = Epi::PERM ? ((R & ~31) + perm32(R & 31)) : R;
        voffA[i] = (unsigned)(R * K + C) * 2u; voffB[i] = (unsigned)(Rb * K + C) * 2u; }
    const size_t kstep = (size_t)(BK * 2);
    const size_t hstep = (size_t)HALF * K * 2;
    const size_t tstep = 2 * hstep;
    const unsigned ldsw = (unsigned)wid * 1024u;
    const int aoff = lds_byte(wr * 64 + fr, fq * 8), boff = lds_byte(wc * 32 + fr, fq * 8);
#define PG8_SA(b, h) (((b) * 2 + (h)) * HTB)
#define PG8_SB(b, h) ((4 + (b) * 2 + (h)) * HTB)
#define PG8_STAGE(bufoff, gbase, voff) do { _Pragma("unroll") for (int _i = 0; _i < 2; ++_i) \
        __builtin_amdgcn_global_load_lds((const unsigned*)((const char*)(gbase) + (voff)[_i]), (LAS unsigned*)(lds + (bufoff) + ldsw + _i * 8192), 16, 0, 0); } while (0)
#define PG8_LDA(dst, b, h) do { _Pragma("unroll") for (int m = 0; m < 4; ++m) _Pragma("unroll") for (int k = 0; k < 2; ++k) dst[m][k] = *(const LAS bf16x8*)(lds + PG8_SA(b, h) + aoff + m * 2048 + k * 1024); } while (0)
#define PG8_LDB(dst, b, h) do { _Pragma("unroll") for (int n = 0; n < 2; ++n) _Pragma("unroll") for (int k = 0; k < 2; ++k) dst[n][k] = *(const LAS bf16x8*)(lds + PG8_SB(b, h) + boff + n * 2048 + k * 1024); } while (0)
#define PG8_MMA(ai, bj, At, Bt) do { __builtin_amdgcn_s_setprio(1); _Pragma("unroll") for (int m = 0; m < 4; ++m) _Pragma("unroll") for (int n = 0; n < 2; ++n) _Pragma("unroll") for (int k = 0; k < 2; ++k) \
        acc[ai][bj][m][n] = __builtin_amdgcn_mfma_f32_16x16x32_bf16(Bt[n][k], At[m][k], acc[ai][bj][m][n], 0, 0, 0); __builtin_amdgcn_s_setprio(0); } while (0)
#define PG8_WAIT_V(n) asm volatile("s_waitcnt vmcnt(" #n ")" ::: "memory")
#define PG8_WAIT_L(n) asm volatile("s_waitcnt lgkmcnt(" #n ")" ::: "memory")
#define PG8_BAR __builtin_amdgcn_s_barrier()
#define PG8_SCHED __builtin_amdgcn_sched_barrier(0)
    Unit cur, nxt; int ui = 0;
    if (!S.next(0, cur)) return;
    f32x4 acc[2][2][4][2];
#pragma unroll
    for (int a = 0; a < 2; ++a)
#pragma unroll
        for (int b = 0; b < 2; ++b)
#pragma unroll
            for (int m = 0; m < 4; ++m)
#pragma unroll
                for (int n = 0; n < 2; ++n) acc[a][b][m][n] = (f32x4){0.f, 0.f, 0.f, 0.f};
    bf16x8 At[4][2], B0[2][2], B1[2][2];
    const char* cA = (const char*)g.A + (size_t)cur.pm * tstep; const char* cB = (const char*)g.Bt + (size_t)cur.pn * tstep;
    S.a_ready(cur);
    PG8_STAGE(PG8_SB(0, 0), cB, voffB); PG8_STAGE(PG8_SA(0, 0), cA, voffA); PG8_STAGE(PG8_SB(0, 1), cB + hstep, voffB); PG8_STAGE(PG8_SA(0, 1), cA + hstep, voffA);
    if (wr == 1) PG8_BAR;
    PG8_WAIT_V(4); PG8_BAR;
    PG8_STAGE(PG8_SB(1, 0), cB + kstep, voffB); PG8_STAGE(PG8_SA(1, 0), cA + kstep, voffA); PG8_STAGE(PG8_SB(1, 1), cB + hstep + kstep, voffB);
    PG8_WAIT_V(6); PG8_BAR;
    for (;;) {
        const bool has_next = S.next(ui + 1, nxt);
        const char* nA = has_next ? (const char*)g.A + (size_t)nxt.pm * tstep : cA; const char* nB = has_next ? (const char*)g.Bt + (size_t)nxt.pn * tstep : cB;
        for (int t = 0; t < nt; t += 2) {
            const bool last = (t == nt - 2);
            const char* a1 = cA + (size_t)(t + 1) * kstep;
            const char* a2 = last ? nA : cA + (size_t)(t + 2) * kstep; const char* b2 = last ? nB : cB + (size_t)(t + 2) * kstep;
            const char* a3 = a2 + kstep; const char* b3 = b2 + kstep;
            if (last && has_next) S.a_ready(nxt);
            PG8_LDB(B0, 0, 0); PG8_SCHED; PG8_LDA(At, 0, 0); PG8_STAGE(PG8_SA(1, 1), a1 + hstep, voffA);
            PG8_WAIT_L(8); PG8_BAR; PG8_WAIT_L(0); PG8_MMA(0, 0, At, B0); PG8_BAR; PG8_SCHED;
            PG8_LDB(B1, 0, 1); PG8_STAGE(PG8_SB(0, 0), b2, voffB);
            PG8_BAR; PG8_WAIT_L(0); PG8_MMA(0, 1, At, B1); PG8_BAR;
            PG8_LDA(At, 0, 1); PG8_STAGE(PG8_SA(0, 0), a2, voffA);
            PG8_BAR; PG8_WAIT_L(0); PG8_MMA(1, 0, At, B0); PG8_BAR; PG8_SCHED;
            PG8_STAGE(PG8_SB(0, 1), b2 + hstep, voffB);
            PG8_WAIT_V(6); PG8_BAR; PG8_MMA(1, 1, At, B1); PG8_BAR;
            PG8_LDB(B0, 1, 0); PG8_SCHED; PG8_LDA(At, 1, 0); PG8_STAGE(PG8_SA(0, 1), a2 + hstep, voffA);
            PG8_WAIT_L(8); PG8_BAR; PG8_WAIT_L(0); PG8_MMA(0, 0, At, B0); PG8_BAR; PG8_SCHED;
            PG8_LDB(B1, 1, 1); PG8_STAGE(PG8_SB(1, 0), b3, voffB);
            PG8_BAR; PG8_WAIT_L(0); PG8_MMA(0, 1, At, B1); PG8_BAR;
            PG8_LDA(At, 1, 1); PG8_STAGE(PG8_SA(1, 0), a3, voffA);
            PG8_BAR; PG8_WAIT_L(0); PG8_MMA(1, 0, At, B0); PG8_BAR; PG8_SCHED;
            PG8_STAGE(PG8_SB(1, 1), b3 + hstep, voffB);
            PG8_WAIT_V(6); PG8_BAR; PG8_MMA(1, 1, At, B1); PG8_BAR;
        }
        E(acc, cur, wr, wc, fr, fq); S.done(cur);
        if (!has_next) break;
#pragma unroll
        for (int a = 0; a < 2; ++a)
#pragma unroll
            for (int b = 0; b < 2; ++b)
#pragma unroll
                for (int m = 0; m < 4; ++m)
#pragma unroll
                    for (int n = 0; n < 2; ++n) acc[a][b][m][n] = (f32x4){0.f, 0.f, 0.f, 0.f};
        cur = nxt; cA = nA; cB = nB; ++ui;
    }
    PG8_WAIT_V(0);
    if (wr == 0) PG8_BAR;
    PG8_BAR;
#undef PG8_SA
#undef PG8_SB
#undef PG8_STAGE
#undef PG8_LDA
#undef PG8_LDB
#undef PG8_MMA
#undef PG8_WAIT_V
#undef PG8_WAIT_L
#undef PG8_BAR
#undef PG8_SCHED
}
}
using pg8::Unit;

struct EpiProj {
    static constexpr bool PERM = true;
    bf16_t* P; const float* ssq;
    DEVI void operator()(const f32x4 (&acc)[2][2][4][2], const Unit& u, int wr, int wc, int fr, int fq) const {
        const int row0 = u.pm * 256 + wr * 64 + fr, colb = u.pn * 256 + wc * 32 + 8 * fq;
#pragma unroll
        for (int ai = 0; ai < 2; ++ai)
#pragma unroll
            for (int m = 0; m < 4; ++m) { const int r = row0 + ai * 128 + m * 16; const float sc = rowscale(ssq, r);
#pragma unroll
                for (int bj = 0; bj < 2; ++bj) { const int c = colb + bj * 128;
                    if (c < PS) *(uint4*)(P + (size_t)r * PS + c) = pack8u(acc[ai][bj][m][0] * sc, acc[ai][bj][m][1] * sc); } }
    }
};
struct EpiRes {
    static constexpr bool PERM = true;
    const float* res_p; const float* res_s; float* xf; bf16_t* xb; float* ssq;
    DEVI void operator()(const f32x4 (&acc)[2][2][4][2], const Unit& u, int wr, int wc, int fr, int fq) const {
        const int row0 = u.pm * 256 + wr * 64 + fr, colb = u.pn * 256 + wc * 32 + 8 * fq;
#pragma unroll
        for (int ai = 0; ai < 2; ++ai)
#pragma unroll
            for (int m = 0; m < 4; ++m) { const int r = row0 + ai * 128 + m * 16;
                const float* rp = (r < MP) ? res_p + (size_t)r * DM : res_s + (size_t)(r - MP) * DM; float part = 0.f;
#pragma unroll
                for (int bj = 0; bj < 2; ++bj) { const int c = colb + bj * 128;
                    const f32x4 v0 = acc[ai][bj][m][0] + *(const f32x4*)(rp + c), v1 = acc[ai][bj][m][1] + *(const f32x4*)(rp + c + 4);
                    *(f32x4*)(xf + (size_t)r * DM + c) = v0; *(f32x4*)(xf + (size_t)r * DM + c + 4) = v1;
                    *(uint4*)(xb + (size_t)r * DM + c) = pack8u(v0, v1);
                    part += v0[0] * v0[0] + v0[1] * v0[1] + v0[2] * v0[2] + v0[3] * v0[3] + v1[0] * v1[0] + v1[1] * v1[1] + v1[2] * v1[2] + v1[3] * v1[3]; }
                part += __shfl_xor(part, 16); part += __shfl_xor(part, 32);
                if (fq == 0) ssq[(size_t)r * 16 + u.pn * 4 + wc] = part; }
    }
};
struct EpiGU {
    static constexpr bool PERM = true;
    bf16_t* act; const float* ssq; const float* cw; const float* st; float* sg; float* su; float* osfp; float* osfs;
    DEVI void operator()(const f32x4 (&acc)[2][2][4][2], const Unit& u, int wr, int wc, int fr, int fq) const {
        const int f0 = u.pn * 128 + wc * 32 + 8 * fq;
        const f32x4 w0a = *(const f32x4*)(cw + f0), w0b = *(const f32x4*)(cw + f0 + 4), w1a = *(const f32x4*)(cw + FF + f0), w1b = *(const f32x4*)(cw + FF + f0 + 4),
                    w2a = *(const f32x4*)(cw + 2 * FF + f0), w2b = *(const f32x4*)(cw + 2 * FF + f0 + 4);
        const bool smp = u.pm >= 128;
#pragma unroll
        for (int ai = 0; ai < 2; ++ai) {
            const int rb = u.pm * 256 + ai * 128 + wr * 64;
            f32x4 gpa[4], gpb[4]; float scs[4];
#pragma unroll
            for (int m = 0; m < 4; ++m) { scs[m] = rowscale(ssq, rb + 16 * m + fr); gpa[m] = acc[ai][0][m][0] * scs[m]; gpb[m] = acc[ai][0][m][1] * scs[m]; }
#pragma unroll
            for (int m = 0; m < 4; ++m) {
                const int r = rb + 16 * m + fr;
                const f32x4 ua = acc[ai][1][m][0] * scs[m], ub = acc[ai][1][m][1] * scs[m];
                f32x4 p1a, p1b, p2a, p2b;
#pragma unroll
                for (int jj = 0; jj < 4; ++jj) {
                    const float ca = gpa[m][jj], cb = gpb[m][jj], pa = m > 0 ? gpa[m > 0 ? m - 1 : 0][jj] : 0.f, pb = m > 0 ? gpb[m > 0 ? m - 1 : 0][jj] : 0.f;
                    const float a1 = dppf<0x111>(ca), a2 = dppf<0x112>(ca), b1 = dppf<0x10F>(pa), b2 = dppf<0x10E>(pa);
                    p1a[jj] = fr >= 1 ? a1 : b1; p2a[jj] = fr >= 2 ? a2 : b2;
                    const float c1 = dppf<0x111>(cb), c2 = dppf<0x112>(cb), d1 = dppf<0x10F>(pb), d2 = dppf<0x10E>(pb);
                    p1b[jj] = fr >= 1 ? c1 : d1; p2b[jj] = fr >= 2 ? c2 : d2;
                }
                if (smp) {
                    const int t = fr & 3, bb = (r - MP) >> 2; const float* sp = st + (size_t)bb * 2 * FF + f0;
                    if (t == 0) { p2a = *(const f32x4*)sp; p2b = *(const f32x4*)(sp + 4); p1a = *(const f32x4*)(sp + FF); p1b = *(const f32x4*)(sp + FF + 4); }
                    else if (t == 1) { p2a = *(const f32x4*)(sp + FF); p2b = *(const f32x4*)(sp + FF + 4); }
                    if (t >= 2) { float* o = osfs + ((size_t)bb * 2 + (t - 2)) * FF + f0; *(f32x4*)o = gpa[m]; *(f32x4*)(o + 4) = gpb[m]; }
                }
                const bool head = !smp && m == 0 && fr < 2;
                if (!head) {
                    const f32x4 ga = w0a * p2a + w1a * p1a + w2a * gpa[m], gb = w0b * p2b + w1b * p1b + w2b * gpb[m];
                    *(uint4*)(act + (size_t)r * FF + f0) = pack8u(silu4(ga) * ua, silu4(gb) * ub);
                }
                if (!smp) {
                    const int blk = rb >> 6;
                    if (m == 0 && fr < 2) { float* o = sg + ((size_t)blk * 4 + fr) * FF + f0; *(f32x4*)o = gpa[m]; *(f32x4*)(o + 4) = gpb[m];
                        float* o2 = su + ((size_t)blk * 2 + fr) * FF + f0; *(f32x4*)o2 = ua; *(f32x4*)(o2 + 4) = ub; }
                    if (m == 3 && fr >= 14) { float* o = sg + ((size_t)blk * 4 + 2 + (fr - 14)) * FF + f0; *(f32x4*)o = gpa[m]; *(f32x4*)(o + 4) = gpb[m];
                        const int t = r & 4095; if (t >= 4094) { float* o3 = osfp + ((size_t)(r >> 12) * 2 + (t - 4094)) * FF + f0; *(f32x4*)o3 = gpa[m]; *(f32x4*)(o3 + 4) = gpb[m]; } }
                }
            }
        }
    }
};

__device__ void phase_prep(const Args& a, unsigned char* smem) {
    float* tile = (float*)smem;
    const int tid = tidx(), tx = tid & 63, ty = tid >> 6, lane = tid & 63, wid = tid >> 6;
    constexpr int T_IN = 48 * 16, T_OUT = 16 * 16, T_GU = 88 * 16, T_DN = 16 * 44, T_L = T_IN + T_OUT + T_GU + T_DN;
    for (int it = bidx(); it < 2 * T_L; it += gdim()) {
        const int l = it / T_L; int r = it % T_L;
        const float* src; int ld, col, kt, nt, Kd; const float* gk = nullptr; bf16_t* dst;
        if (r < T_IN) { nt = r / 16; kt = r % 16; Kd = 1024; ld = PS; src = inp(a, 9) + (size_t)l * 1024 * PS; gk = inp(a, 8) + l * 1024; dst = (bf16_t*)(wsp(a) + WS_WIN) + (size_t)l * NPAD * 1024;
            const int n = nt * 64 + tx; col = n < 1024 ? n : (n < 2816 ? n + 8 : (n < 2824 ? 1024 + (n - 2816) : -1)); }
        else if ((r -= T_IN) < T_OUT) { nt = r / 16; kt = r % 16; Kd = 1024; ld = 1024; src = inp(a, 20) + (size_t)l * 1024 * 1024; dst = (bf16_t*)(wsp(a) + WS_WOUT) + (size_t)l * 1024 * 1024; col = nt * 64 + tx; }
        else if ((r -= T_OUT) < T_GU) { nt = r / 16; kt = r % 16; Kd = 1024; ld = FF; gk = inp(a, 21) + l * 1024; dst = (bf16_t*)(wsp(a) + WS_WGU) + (size_t)l * 5632 * 1024;
            const int n = nt * 64, pn = n >> 8, cc = n & 255; src = (cc < 128 ? inp(a, 22) : inp(a, 23)) + (size_t)l * 1024 * FF; col = pn * 128 + (cc & 127) + tx; }
        else { r -= T_GU; nt = r / 44; kt = r % 44; Kd = FF; ld = 1024; src = inp(a, 25) + (size_t)l * FF * 1024; dst = (bf16_t*)(wsp(a) + WS_WDN) + (size_t)l * 1024 * FF; col = nt * 64 + tx; }
        for (int i = ty; i < 64; i += 8) { const int k = kt * 64 + i; float v = 0.f; if (col >= 0) { v = src[(size_t)k * ld + col]; if (gk) v *= gk[k]; } tile[i * 65 + tx] = v; }
        __syncthreads();
        for (int i = ty; i < 64; i += 8) dst[(size_t)(nt * 64 + i) * Kd + kt * 64 + tx] = f2bf(tile[tx * 65 + i]);
        __syncthreads();
    }
    bf16_t* xb = (bf16_t*)(wsp(a) + WS_XB); float* ssq = (float*)(wsp(a) + WS_SSQA);
    for (int r = bidx() * 8 + wid; r < M; r += gdim() * 8) {
        const float* xr = (r < MP) ? inp(a, 0) + (size_t)r * DM : inp(a, 1) + (size_t)(r - MP) * DM; float ss = 0.f;
#pragma unroll
        for (int q = 0; q < 4; ++q) { const f32x4 v = *(const f32x4*)(xr + q * 256 + lane * 4); ss += v[0] * v[0] + v[1] * v[1] + v[2] * v[2] + v[3] * v[3]; st4bf(xb + (size_t)r * DM + q * 256 + lane * 4, v); }
        ss = wave_sum(ss);
        if (lane < 16) ssq[(size_t)r * 16 + lane] = lane == 0 ? ss : 0.f;
    }
}

DEVI f32x4 cv4bf(const uint2 u) { f32x4 o; o[0] = __uint_as_float(u.x << 16); o[1] = __uint_as_float(u.x & 0xffff0000u); o[2] = __uint_as_float(u.y << 16); o[3] = __uint_as_float(u.y & 0xffff0000u); return o; }
struct TokRaw { uint2 a0, a1, a2, bc, bh, bb, q, kv, dv, du; bf16_t ab, aa; };
DEVI TokRaw ldtok(const bf16_t* pr, int c4, int lane) { TokRaw t; t.a0 = *(const uint2*)(pr + C_AQ + c4); t.a1 = *(const uint2*)(pr + C_AQ + 256 + c4); t.a2 = *(const uint2*)(pr + C_AQ + 512 + c4);
    t.bc = *(const uint2*)(pr + C_BC + c4); t.bh = *(const uint2*)(pr + C_BH + c4); t.bb = *(const uint2*)(pr + C_BB + c4); t.q = *(const uint2*)(pr + C_CQ + c4); t.kv = *(const uint2*)(pr + C_CK + c4);
    t.dv = *(const uint2*)(pr + C_DV + c4); t.du = *(const uint2*)(pr + C_DU + c4); t.ab = pr[C_AB + (lane & 3)]; t.aa = pr[C_AA + (lane & 3)]; return t; }
__device__ void phase_tok(const Args& a, const int l) {
    const int lane = tidx() & 63, wid = tidx() >> 6, c4 = lane * 4;
    const bf16_t* proj = (const bf16_t*)(wsp(a) + WS_PROJ);
    bf16_t* qkvn = (bf16_t*)(wsp(a) + WS_XB); bf16_t* mix = (bf16_t*)(wsp(a) + WS_MIX); float* bg = (float*)(wsp(a) + WS_BG);
    bf16_t* qr = (bf16_t*)(wsp(a) + WS_QR); bf16_t* kvr = (bf16_t*)(wsp(a) + WS_KVR); bf16_t* dvn = (bf16_t*)(wsp(a) + WS_DVN);
    float* out = outp(a);
    const float* cwp = inp(a, 10) + (size_t)l * 4 * 768 + c4;
    const float* bwp = inp(a, 14) + (size_t)l * 3 * 256 + c4; const float* lngp = inp(a, 16) + l * 256 + c4; const float* lnbp = inp(a, 17) + l * 256 + c4;
    float inv[4];
#pragma unroll
    for (int e = 0; e < 4; ++e) inv[e] = powf(500000.f, -(float)(4 * (lane & 1) + e) * 0.125f);
    const int j16 = lane & 15, gD = lane >> 4;
    const float* Wd = inp(a, 18) + ((size_t)(l * 4 + gD) * 128) * 128; const float* biasd = inp(a, 19) + (size_t)(l * 4 + gD) * 128;
    {
        const float* ck = inp(a, 5) + (size_t)l * 128 * 16384; const float* cv = inp(a, 6) + (size_t)l * 128 * 16384;
        float* ok = out + O_CKS + (size_t)l * 128 * 16384; float* ov = out + O_CVS + (size_t)l * 128 * 16384;
        for (int i = bidx() * 512 + tidx(); i < 128 * 3968; i += gdim() * 512) { const int bb = i / 3968, j = i - bb * 3968; const size_t o = (size_t)bb * 16384 + (size_t)j * 4;
            *(f32x4*)(ok + o) = *(const f32x4*)(ck + o + 512); *(f32x4*)(ov + o) = *(const f32x4*)(cv + o + 512); }
    }
    for (int run = bidx() * 8 + wid; run < 2048 + 128; run += gdim() * 8) {
        const bool smp = run >= 2048;
        int b, t0, ntok, pos0; size_t r0;
        if (!smp) { b = run >> 8; t0 = (run & 255) * 16; ntok = 16; r0 = (size_t)b * 4096 + t0; pos0 = t0; }
        else { b = run - 2048; t0 = 0; ntok = 4; r0 = (size_t)MP + 4 * b; pos0 = 16384; }
        f32x4 ha[3][3], hb[2];
        const f32x4 z4 = {0.f, 0.f, 0.f, 0.f};
        if (smp) {
            const float* st = inp(a, 3) + ((size_t)(l * 128 + b) * 3) * 768;
#pragma unroll
            for (int p = 0; p < 3; ++p)
#pragma unroll
                for (int j = 0; j < 3; ++j) ha[p][j] = *(const f32x4*)(st + j * 768 + p * 256 + c4);
            const float* sb = inp(a, 4) + ((size_t)(l * 128 + b) * 2) * 256; hb[0] = *(const f32x4*)(sb + c4); hb[1] = *(const f32x4*)(sb + 256 + c4);
        } else if (t0 == 0) {
#pragma unroll
            for (int p = 0; p < 3; ++p)
#pragma unroll
                for (int j = 0; j < 3; ++j) ha[p][j] = z4;
            hb[0] = z4; hb[1] = z4;
        } else {
#pragma unroll
            for (int p = 0; p < 3; ++p)
#pragma unroll
                for (int j = 0; j < 3; ++j) ha[p][j] = ld4bf(proj + (r0 - 3 + j) * PS + C_AQ + p * 256 + c4);
#pragma unroll
            for (int j = 0; j < 2; ++j) hb[j] = ld4bf(proj + (r0 - 2 + j) * PS + C_BC + c4) * ld4bf(proj + (r0 - 2 + j) * PS + C_BH + c4);
        }
        f32x4 h0 = z4, h1 = z4, h2 = z4, h3 = z4;
        TokRaw nx = ldtok(proj + r0 * PS, c4, lane);
#pragma unroll 1
        for (int i = 0; i < ntok; ++i) {
            const size_t r = r0 + i; const int t = t0 + i;
            const TokRaw tk = nx;
            GLB const float* cwq = (GLB const float*)cwp; asm volatile("" : "+v"(cwq)); GLB const float* bwq = (GLB const float*)bwp; asm volatile("" : "+v"(bwq));
            nx = ldtok(proj + (r0 + (i + 1 < ntok ? i + 1 : i)) * PS, c4, lane);
#pragma unroll
            for (int p = 0; p < 3; ++p) {
                const f32x4 cur = cv4bf(p == 0 ? tk.a0 : (p == 1 ? tk.a1 : tk.a2));
                f32x4 s = silu4(*(GLB const f32x4*)(cwq + p * 256) * ha[p][0] + *(GLB const f32x4*)(cwq + 768 + p * 256) * ha[p][1] + *(GLB const f32x4*)(cwq + 1536 + p * 256) * ha[p][2] + *(GLB const f32x4*)(cwq + 2304 + p * 256) * cur);
                ha[p][0] = ha[p][1]; ha[p][1] = ha[p][2]; ha[p][2] = cur;
                if (p < 2) { float ss = red16(s[0] * s[0] + s[1] * s[1] + s[2] * s[2] + s[3] * s[3]); const float sc = rsqrtf(ss + EPS) * (p == 0 ? 0.125f : 1.f); s = s * sc; }
                st4bf(qkvn + r * 768 + p * 256 + c4, s);
                if (!smp) { if (t >= 4093) *(f32x4*)(out + O_SCP + ((size_t)(l * 8 + b) * 3 + (t - 4093)) * 768 + p * 256 + c4) = cur; }
                else if (i >= 1) *(f32x4*)(out + O_SCS + ((size_t)(l * 128 + b) * 3 + (i - 1)) * 768 + p * 256 + c4) = cur;
            }
            if (lane < 4) {
                const float ab = bf2f(tk.ab), aa = bf2f(tk.aa);
                const float beta = 1.f / (1.f + __expf(-ab)); const float x = aa + inp(a, 12)[l * 4 + lane]; const float sp = x > 20.f ? x : log1pf(__expf(x));
                bg[r * 8 + lane] = beta; bg[r * 8 + 4 + lane] = -__expf(inp(a, 11)[l * 4 + lane]) * sp;
            }
            {
                const f32x4 s = cv4bf(tk.bc) * cv4bf(tk.bh), bb = cv4bf(tk.bb);
                const f32x4 bx = *(GLB const f32x4*)bwq * hb[0] + *(GLB const f32x4*)(bwq + 256) * hb[1] + *(GLB const f32x4*)(bwq + 512) * s;
                st4bf(mix + r * DM + 256 + c4, bb * bx); hb[0] = hb[1]; hb[1] = s;
                if (!smp) { if (t >= 4094) *(f32x4*)(out + O_SSP + ((size_t)(l * 8 + b) * 2 + (t - 4094)) * 256 + c4) = s; }
                else if (i >= 2) *(f32x4*)(out + O_SSS + ((size_t)(l * 128 + b) * 2 + (i - 2)) * 256 + c4) = s;
            }
            {
                f32x4 q = cv4bf(tk.q), kv = cv4bf(tk.kv), qo, ko;
#pragma unroll
                for (int e = 0; e < 4; ++e) { qo[e] = __shfl_xor(q[e], 2); ko[e] = __shfl_xor(kv[e], 2); }
                const float posf = (float)(pos0 + i);
                if (j16 < 4) {
                    const float sgn = j16 < 2 ? -1.f : 1.f;
#pragma unroll
                    for (int e = 0; e < 4; ++e) {
                        const float ang = posf * inv[e]; const double rd = (double)ang * 0.15915494309189535; const float rr = (float)((rd - floor(rd)) * 6.283185307179586);
                        const float cs = __cosf(rr), sn = __sinf(rr);
                        q[e] = q[e] * cs + sgn * qo[e] * sn;
                        if (lane < 32) kv[e] = kv[e] * cs + sgn * ko[e] * sn;
                    }
                }
                st4bf(qr + r * 256 + c4, q); st4bf(kvr + r * 256 + c4, kv);
                if (!smp) { if (t >= 3968) { float* o = (lane < 32 ? out + O_CKP : out + O_CVP) + ((size_t)(l * 8 + b) * 128 + (t - 3968)) * 128 + (c4 & 127); *(f32x4*)o = kv; } }
                else { float* o = (lane < 32 ? out + O_CKS : out + O_CVS) + ((size_t)(l * 128 + b) * 128 + 124 + i) * 128 + (c4 & 127); *(f32x4*)o = kv; }
            }
            {
                const f32x4 x = gelu4(cv4bf(tk.dv));
                const float mean = wave_sum(x[0] + x[1] + x[2] + x[3]) * (1.f / 256.f);
                const f32x4 xc = x - mean;
                const float var = wave_sum(xc[0] * xc[0] + xc[1] * xc[1] + xc[2] * xc[2] + xc[3] * xc[3]) * (1.f / 256.f);
                GLB const float* lq = (GLB const float*)lngp; asm volatile("" : "+v"(lq)); GLB const float* lb = (GLB const float*)lnbp; asm volatile("" : "+v"(lb));
                const f32x4 y = xc * rsqrtf(var + EPS) * *(GLB const f32x4*)lq + *(GLB const f32x4*)lb;
                st4bf(dvn + r * 256 + c4, y);
                if (smp) {
                    *(f32x4*)(out + O_CHV + ((size_t)(l * 128 + b) * 4 + i) * 256 + c4) = y;
                    if (i == 0) h0 = y; else if (i == 1) h1 = y; else if (i == 2) h2 = y; else h3 = y;
                    f32x4 mx = Wd[i * 128 + 0] * h0 + biasd[i];
                    if (i >= 1) mx = mx + Wd[i * 128 + 1] * h1;
                    if (i >= 2) mx = mx + Wd[i * 128 + 2] * h2;
                    if (i >= 3) mx = mx + Wd[i * 128 + 3] * h3;
                    st4bf(mix + r * DM + 768 + c4, gelu4(cv4bf(tk.du)) * mx);
                }
            }
        }
    }
}

constexpr int A2_LDS = 64 * 68 * 4 + 512;
DEVI int fragidx(int row, int col) { return (((row >> 4) * 2 + (col >> 5)) * 64 + ((col >> 2) & 3) * 16 + (row & 15)) * 8 + 4 * ((col >> 4) & 1) + (col & 3); }
__device__ void a2_item(const Args& a, const int it, unsigned char* wl) {
    const int lane = tidx() & 63, fr = lane & 15, fq = lane >> 4;
    float* Aw = (float*)wl; float* gcs = Aw + 64 * 68; float* bts = gcs + 64;
    const int h = it & 3, n = (it >> 2) & 63, b = it >> 8;
    const size_t t0 = (size_t)b * 4096 + n * 64;
    const float* bg = (const float*)(wsp(a) + WS_BG); const bf16_t* qkvn = (const bf16_t*)(wsp(a) + WS_XB);
    float gcv = bg[(t0 + lane) * 8 + 4 + h]; const float bt = bg[(t0 + lane) * 8 + h];
    for (int d = 1; d < 64; d <<= 1) { const float o = __shfl_up(gcv, d); if (lane >= d) gcv += o; }
    const float gl = __shfl(gcv, 63);
    gcs[lane] = gcv; bts[lane] = bt;
    const bf16_t* qb = qkvn + t0 * 768 + h * 64; const bf16_t* kb = qb + 256; const bf16_t* vb = qb + 512;
    bf16x8 kf[4][2], qf[4][2];
#pragma unroll
    for (int m = 0; m < 4; ++m)
#pragma unroll
        for (int kk = 0; kk < 2; ++kk) { kf[m][kk] = *(const bf16x8*)(kb + (size_t)(16 * m + fr) * 768 + 32 * kk + 8 * fq); qf[m][kk] = *(const bf16x8*)(qb + (size_t)(16 * m + fr) * 768 + 32 * kk + 8 * fq); }
    wave_lds_fence();
    unsigned char* cbase = wsp(a) + WS_A2 + (size_t)it * 49152;
    if (lane == 0) ((float*)(wsp(a) + WS_GLS))[it] = gl;
#pragma unroll
    for (int m = 0; m < 4; ++m) {
        const int i = 16 * m + fr; const float gi = gcs[i], bi = bts[i];
#pragma unroll
        for (int k2 = 0; k2 < 2; ++k2) {
            f32x4 ak[2], aq[2];
#pragma unroll
            for (int hh = 0; hh < 2; ++hh) {
                const int nn = 2 * k2 + hh;
                ak[hh] = (f32x4){0.f, 0.f, 0.f, 0.f}; aq[hh] = (f32x4){0.f, 0.f, 0.f, 0.f};
                if (nn <= m) {
#pragma unroll
                    for (int kk = 0; kk < 2; ++kk) { ak[hh] = MFMA16(kf[nn][kk], kf[m][kk], ak[hh]); aq[hh] = MFMA16(kf[nn][kk], qf[m][kk], aq[hh]); }
                    const f32x4 gj = *(const f32x4*)(gcs + 16 * nn + 4 * fq);
#pragma unroll
                    for (int jj = 0; jj < 4; ++jj) { const int j = 16 * nn + 4 * fq + jj; const float e = __expf(fminf(gi - gj[jj], 0.f));
                        ak[hh][jj] = (j < i) ? bi * ak[hh][jj] * e : 0.f; aq[hh][jj] = (j <= i) ? aq[hh][jj] * e : 0.f; }
                }
                *(f32x4*)(Aw + i * 68 + 16 * nn + 4 * fq) = ak[hh];
            }
            *(uint4*)(cbase + ((m * 2 + k2) * 64 + lane) * 16) = pack8u(aq[0], aq[1]);
        }
    }
#pragma unroll
    for (int m = 0; m < 4; ++m)
#pragma unroll
        for (int kk = 0; kk < 2; ++kk) { const int i = 16 * m + fr; const float e = __expf(gcs[i]);
            const f32x4 lo = ld4bf(qb + (size_t)i * 768 + 32 * kk + 4 * fq) * e, hi = ld4bf(qb + (size_t)i * 768 + 32 * kk + 16 + 4 * fq) * e;
            *(uint4*)(cbase + 16384 + ((m * 2 + kk) * 64 + lane) * 16) = pack8u(lo, hi); }
    wave_lds_fence();
    const int c = lane;
    bf16_t* wF = (bf16_t*)(cbase + 8192); bf16_t* kdF = (bf16_t*)(cbase + 24576); float* uS = (float*)(cbase + 32768);
    {
        float U[64];
#pragma unroll
        for (int i = 0; i < 64; ++i) U[i] = bf2f(vb[(size_t)i * 768 + c]);
#pragma unroll
        for (int i = 0; i < 64; ++i) {
            const float vi = U[i];
            float su = bts[i] * vi;
#pragma unroll
            for (int j0 = 0; j0 < i; j0 += 4) { const f32x4 a4 = *(const f32x4*)(Aw + i * 68 + j0);
#pragma unroll
                for (int jj = 0; jj < 4; ++jj) if (j0 + jj < i) su -= a4[jj] * U[j0 + jj]; }
            U[i] = su;
            uS[(((c >> 4) * 4 + (i >> 4)) * 64 + ((i >> 2) & 3) * 16 + (c & 15)) * 4 + (i & 3)] = su;
            asm volatile("" ::: "memory");
        }
    }
    {
        float W[64];
#pragma unroll
        for (int i = 0; i < 64; ++i) W[i] = bf2f(kb[(size_t)i * 768 + c]);
#pragma unroll
        for (int i = 0; i < 64; ++i) {
            const float ki = W[i];
            const float bi = bts[i], gi = gcs[i];
            float sw = bi * __expf(gi) * ki;
#pragma unroll
            for (int j0 = 0; j0 < i; j0 += 4) { const f32x4 a4 = *(const f32x4*)(Aw + i * 68 + j0);
#pragma unroll
                for (int jj = 0; jj < 4; ++jj) if (j0 + jj < i) sw -= a4[jj] * W[j0 + jj]; }
            W[i] = sw;
            kdF[fragidx(c, i)] = f2bf(ki * __expf(gl - gi));
            wF[fragidx(i, c)] = f2bf(sw);
            asm volatile("" ::: "memory");
        }
    }
}

__device__ void sdelta_item(const Args& a, const int l, const int it) {
    const int lane = tidx() & 63, h = it & 3, b = it >> 2;
    const float* S0 = inp(a, 2) + ((size_t)(l * 128 + b) * 4 + h) * 4096;
    const float* bg = (const float*)(wsp(a) + WS_BG); const bf16_t* qkvn = (const bf16_t*)(wsp(a) + WS_XB); float* oraw = (float*)(wsp(a) + WS_ORAW);
    float S[64];
#pragma unroll
    for (int i = 0; i < 64; ++i) S[i] = S0[i * 64 + lane];
    for (int t = 0; t < 4; ++t) {
        const size_t r = (size_t)MP + 4 * b + t; const bf16_t* p = qkvn + r * 768 + h * 64 + lane;
        const float qv = bf2f(p[0]), kv = bf2f(p[256]), vv = bf2f(p[512]); const float beta = bg[r * 8 + h], eg = __expf(bg[r * 8 + 4 + h]);
        float rr = 0.f;
#pragma unroll
        for (int i = 0; i < 64; ++i) { S[i] *= eg; rr += rdlane(kv, i) * S[i]; }
        const float cc = beta * (vv - rr); float oo = 0.f;
#pragma unroll
        for (int i = 0; i < 64; ++i) { S[i] += rdlane(kv, i) * cc; oo += rdlane(qv, i) * S[i]; }
        oraw[r * 256 + h * 64 + lane] = oo;
    }
    float* So = outp(a) + O_SDS + ((size_t)(l * 128 + b) * 4 + h) * 4096;
#pragma unroll
    for (int i = 0; i < 64; ++i) So[i * 64 + lane] = S[i];
}

__device__ void sattn_item(const Args& a, const int l, const int it) {
    const int lane = tidx() & 63, hq = it & 3, b = it >> 2, kvh = hq >> 1;
    const float* ck = inp(a, 5) + (size_t)(l * 128 + b) * 16384 + kvh * 64; const float* cv = inp(a, 6) + (size_t)(l * 128 + b) * 16384 + kvh * 64;
    const bf16_t* qr = (const bf16_t*)(wsp(a) + WS_QR); const bf16_t* kvr = (const bf16_t*)(wsp(a) + WS_KVR); bf16_t* mix = (bf16_t*)(wsp(a) + WS_MIX);
    const size_t r0 = (size_t)MP + 4 * b;
    float qv[4];
#pragma unroll
    for (int i = 0; i < 4; ++i) qv[i] = bf2f(qr[(r0 + i) * 256 + hq * 64 + lane]);
    float s[3][4];
#pragma unroll
    for (int sl = 0; sl < 3; ++sl) {
        float acc0 = 0.f, acc1 = 0.f, acc2 = 0.f, acc3 = 0.f;
        if (sl < 2) { const float* kp = ck + (size_t)(sl * 64 + lane) * 128;
#pragma unroll
            for (int d4 = 0; d4 < 16; ++d4) { const f32x4 kx = *(const f32x4*)(kp + d4 * 4);
#pragma unroll
                for (int e = 0; e < 4; ++e) { const int d = d4 * 4 + e; acc0 += rdlane(qv[0], d) * kx[e]; acc1 += rdlane(qv[1], d) * kx[e]; acc2 += rdlane(qv[2], d) * kx[e]; acc3 += rdlane(qv[3], d) * kx[e]; } }
        } else { const bf16_t* kp = kvr + (r0 + (lane & 3)) * 256 + kvh * 64;
#pragma unroll
            for (int d4 = 0; d4 < 16; ++d4) { const f32x4 kx = ld4bf(kp + d4 * 4);
#pragma unroll
                for (int e = 0; e < 4; ++e) { const int d = d4 * 4 + e; acc0 += rdlane(qv[0], d) * kx[e]; acc1 += rdlane(qv[1], d) * kx[e]; acc2 += rdlane(qv[2], d) * kx[e]; acc3 += rdlane(qv[3], d) * kx[e]; } }
        }
        s[sl][0] = acc0; s[sl][1] = acc1; s[sl][2] = acc2; s[sl][3] = acc3;
    }
    const float sink = inp(a, 15)[l * 4 + hq];
    float inv[4];
#pragma unroll
    for (int i = 0; i < 4; ++i) {
        const bool v0 = lane > i, v1 = true, v2 = lane <= i && lane < 4;
        const float x0 = v0 ? s[0][i] * 0.125f : -1e30f, x1 = v1 ? s[1][i] * 0.125f : -1e30f, x2 = v2 ? s[2][i] * 0.125f : -1e30f;
        float mx = fmaxf(fmaxf(x0, x1), x2);
        for (int d = 1; d < 64; d <<= 1) mx = fmaxf(mx, __shfl_xor(mx, d));
        mx = fmaxf(mx, sink);
        const float p0 = v0 ? __expf(x0 - mx) : 0.f, p1 = __expf(x1 - mx), p2 = v2 ? __expf(x2 - mx) : 0.f;
        const float sum = wave_sum(p0 + p1 + p2) + __expf(sink - mx);
        s[0][i] = p0; s[1][i] = p1; s[2][i] = p2; inv[i] = 1.f / sum;
    }
    float o[4] = {0.f, 0.f, 0.f, 0.f};
#pragma unroll
    for (int sl = 0; sl < 2; ++sl)
        for (int jj = 0; jj < 64; ++jj) { const float vv = cv[(size_t)(sl * 64 + jj) * 128 + lane];
#pragma unroll
            for (int i = 0; i < 4; ++i) o[i] += rdlane(s[sl][i], jj) * vv; }
#pragma unroll
    for (int jj = 0; jj < 4; ++jj) { const float vv = bf2f(kvr[(r0 + jj) * 256 + 128 + kvh * 64 + lane]);
#pragma unroll
        for (int i = 0; i < 4; ++i) o[i] += rdlane(s[2][i], jj) * vv; }
#pragma unroll
    for (int i = 0; i < 4; ++i) mix[(r0 + i) * DM + 512 + hq * 64 + lane] = f2bf(o[i] * inv[i]);
}

__device__ void c_item(const Args& a, const int l, const int it, unsigned char* smem) {
    const int tid = tidx(), lane = tid & 63, w = tid >> 6, fr = lane & 15, fq = lane >> 4;
    const int qb = it & 63, kvh = (it >> 6) & 1, b = it >> 7;
    bf16_t* Ks = (bf16_t*)smem; bf16_t* Vt = Ks + 192 * 72;
    const bf16_t* kvr = (const bf16_t*)(wsp(a) + WS_KVR); const bf16_t* qr = (const bf16_t*)(wsp(a) + WS_QR); bf16_t* mix = (bf16_t*)(wsp(a) + WS_MIX);
    const int kp0 = 64 * qb - 128;
    for (int id = tid; id < 1536; id += 512) { const int row = id >> 3, c8 = id & 7, kp = kp0 + row; uint4 kq = {0u, 0u, 0u, 0u}, vq = {0u, 0u, 0u, 0u};
        if (kp >= 0) { const bf16_t* src = kvr + ((size_t)b * 4096 + kp) * 256 + kvh * 64 + c8 * 8; kq = *(const uint4*)src; vq = *(const uint4*)(src + 128); }
        *(uint4*)(Ks + row * 72 + c8 * 8) = kq; bf16_t* vd = Vt + (c8 * 8) * 200 + row;
        vd[0] = (bf16_t)(vq.x & 0xffffu); vd[200] = (bf16_t)(vq.x >> 16); vd[400] = (bf16_t)(vq.y & 0xffffu); vd[600] = (bf16_t)(vq.y >> 16);
        vd[800] = (bf16_t)(vq.z & 0xffffu); vd[1000] = (bf16_t)(vq.z >> 16); vd[1200] = (bf16_t)(vq.w & 0xffffu); vd[1400] = (bf16_t)(vq.w >> 16); }
    __syncthreads();
    const int hq = 2 * kvh + (w >> 2), wq = w & 3, qrow0 = 64 * qb + 16 * wq, kb = 16 * wq;
    const bf16_t* qp = qr + ((size_t)b * 4096 + qrow0 + fr) * 256 + hq * 64 + 8 * fq;
    const bf16x8 qf0 = *(const bf16x8*)qp, qf1 = *(const bf16x8*)(qp + 32);
    f32x4 s[9];
#pragma unroll
    for (int nn = 0; nn < 9; ++nn) { const bf16_t* kr = Ks + (kb + 16 * nn + fr) * 72 + 8 * fq; s[nn] = (f32x4){0.f, 0.f, 0.f, 0.f};
        s[nn] = MFMA16(*(const bf16x8*)kr, qf0, s[nn]); s[nn] = MFMA16(*(const bf16x8*)(kr + 32), qf1, s[nn]); }
    const int tq = qrow0 + fr; const float sink = inp(a, 15)[l * 4 + hq];
    float mx = sink;
#pragma unroll
    for (int nn = 0; nn < 9; ++nn)
#pragma unroll
        for (int jj = 0; jj < 4; ++jj) { const int tk = kp0 + kb + 16 * nn + 4 * fq + jj; const bool ok = tk >= 0 && tk <= tq && tk > tq - 128;
            const float v = ok ? s[nn][jj] * 0.125f : -1e30f; s[nn][jj] = v; mx = fmaxf(mx, v); }
    mx = fmaxf(mx, __shfl_xor(mx, 16)); mx = fmaxf(mx, __shfl_xor(mx, 32));
    float sum = 0.f;
#pragma unroll
    for (int nn = 0; nn < 9; ++nn)
#pragma unroll
        for (int jj = 0; jj < 4; ++jj) { const float p = s[nn][jj] > -1e29f ? __expf(s[nn][jj] - mx) : 0.f; s[nn][jj] = p; sum += p; }
    sum += __shfl_xor(sum, 16); sum += __shfl_xor(sum, 32); sum += __expf(sink - mx);
    bf16x8 pb[5];
#pragma unroll
    for (int kk = 0; kk < 4; ++kk) pb[kk] = pack8(s[2 * kk], s[2 * kk + 1]);
    pb[4] = pack8(s[8], (f32x4){0.f, 0.f, 0.f, 0.f});
    const float inv = 1.f / sum;
#pragma unroll
    for (int m = 0; m < 4; ++m) { f32x4 o = {0.f, 0.f, 0.f, 0.f};
#pragma unroll
        for (int kk = 0; kk < 5; ++kk) { const bf16_t* vp = Vt + (16 * m + fr) * 200 + kb + 32 * kk + 4 * fq;
            const bf16x4 lo = *(const bf16x4*)vp; bf16x4 hi = {0, 0, 0, 0}; if (kk < 4) hi = *(const bf16x4*)(vp + 16);
            const bf16x8 af = {lo[0], lo[1], lo[2], lo[3], hi[0], hi[1], hi[2], hi[3]};
            o = MFMA16(af, pb[kk], o); }
        st4bf(mix + ((size_t)b * 4096 + tq) * DM + 512 + hq * 64 + 16 * m + 4 * fq, o * inv); }
    __syncthreads();
}

__device__ void d_item(const Args& a, const int l, const int it, unsigned char* smem) {
    const int tid = tidx(), lane = tid & 63, w = tid >> 6, fr = lane & 15, fq = lane >> 4;
    const int g = it & 3, ch = (it >> 2) & 31, b = it >> 7;
    bf16_t* vT = (bf16_t*)smem;
    const bf16_t* dvn = (const bf16_t*)(wsp(a) + WS_DVN); const bf16_t* proj = (const bf16_t*)(wsp(a) + WS_PROJ); bf16_t* mix = (bf16_t*)(wsp(a) + WS_MIX);
    const size_t r0 = (size_t)b * 4096 + 128 * ch;
    for (int id = tid; id < 1024; id += 512) { const int row = id >> 3, c8 = id & 7; const uint4 vq = *(const uint4*)(dvn + (r0 + row) * 256 + g * 64 + c8 * 8); bf16_t* vd = vT + (c8 * 8) * 136 + row;
        vd[0] = (bf16_t)(vq.x & 0xffffu); vd[136] = (bf16_t)(vq.x >> 16); vd[272] = (bf16_t)(vq.y & 0xffffu); vd[408] = (bf16_t)(vq.y >> 16);
        vd[544] = (bf16_t)(vq.z & 0xffffu); vd[680] = (bf16_t)(vq.z >> 16); vd[816] = (bf16_t)(vq.w & 0xffffu); vd[952] = (bf16_t)(vq.w >> 16); }
    __syncthreads();
    const float* Wg = inp(a, 18) + ((size_t)(l * 4 + g) * 128) * 128;
    const int t = 16 * w + fr;
    f32x4 acc[4];
#pragma unroll
    for (int n = 0; n < 4; ++n) acc[n] = (f32x4){0.f, 0.f, 0.f, 0.f};
#pragma unroll
    for (int kk = 0; kk < 4; ++kk) if (kk <= (w >> 1)) {
        const float* wp = Wg + (size_t)t * 128 + 32 * kk + 8 * fq; f32x4 w0 = *(const f32x4*)wp, w1 = *(const f32x4*)(wp + 4);
#pragma unroll
        for (int e = 0; e < 4; ++e) { if (32 * kk + 8 * fq + e > t) w0[e] = 0.f; if (32 * kk + 8 * fq + 4 + e > t) w1[e] = 0.f; }
        const bf16x8 bfr = pack8(w0, w1);
#pragma unroll
        for (int n = 0; n < 4; ++n) acc[n] = MFMA16(*(const bf16x8*)(vT + (16 * n + fr) * 136 + 32 * kk + 8 * fq), bfr, acc[n]);
    }
    const float bias = inp(a, 19)[(size_t)(l * 4 + g) * 128 + t];
    const size_t r = r0 + t;
#pragma unroll
    for (int n = 0; n < 4; ++n) { const f32x4 du = gelu4(ld4bf(proj + r * PS + C_DU + g * 64 + 16 * n + 4 * fq)); st4bf(mix + r * DM + 768 + g * 64 + 16 * n + 4 * fq, du * (acc[n] + bias)); }
    __syncthreads();
}

__device__ void phase_chunk(const Args& a, const int l, unsigned char* smem) {
    const int wid = tidx() >> 6, gw = bidx() * 8 + wid, nw = gdim() * 8;
#ifndef CHMASK
#define CHMASK 15
#endif
    if (CHMASK & 1) for (int it = gw; it < 2048; it += nw) a2_item(a, it, smem + wid * A2_LDS);
    if (CHMASK & 2) for (int it = gw; it < 512; it += nw) sattn_item(a, l, it);
    __syncthreads();
    if (CHMASK & 4) for (int it = bidx(); it < 1024; it += gdim()) c_item(a, l, it, smem);
    if (CHMASK & 8) for (int it = bidx(); it < 1024; it += gdim()) d_item(a, l, it, smem);
}

__device__ void phase_scan(const Args& a, const int l) {
    const int lane = tidx() & 63, wid = tidx() >> 6, fr = lane & 15, fq = lane >> 4;
    float* oraw = (float*)(wsp(a) + WS_ORAW);
    if (bidx() >= 32 || gdim() < 64) {
        const int nb = gdim() < 64 ? gdim() : gdim() - 32, bi = gdim() < 64 ? bidx() : bidx() - 32;
        for (int it = bi * 8 + wid; it < 512; it += nb * 8) sdelta_item(a, l, it);
        if (gdim() >= 64) return;
    }
    if (wid >= 4) return;
    for (int bh = bidx(); bh < 32; bh += gdim()) {
        const int b = bh >> 2, h = bh & 3, sl = wid;
        f32x4 S[4];
#pragma unroll
        for (int m = 0; m < 4; ++m) S[m] = (f32x4){0.f, 0.f, 0.f, 0.f};
        bf16x8 wf[4][2], qd[4][2], qk[4][2], kd[4][2]; f32x4 u[4]; float glv;
        const unsigned char* a2b = wsp(a) + WS_A2; const float* glsp = (const float*)(wsp(a) + WS_GLS);
#define SC_BASE(n_) (a2b + (size_t)((b * 64 + (n_)) * 4 + h) * 49152)
#define SC_LD_W(n_) do { const unsigned char* cb_ = SC_BASE(n_); _Pragma("unroll") for (int m = 0; m < 4; ++m) { _Pragma("unroll") for (int kk = 0; kk < 2; ++kk) wf[m][kk] = *(const bf16x8*)(cb_ + 8192 + (size_t)((m * 2 + kk) * 64 + lane) * 16); \
            u[m] = *(const f32x4*)(cb_ + 32768 + (size_t)((sl * 4 + m) * 64 + lane) * 16); } glv = glsp[(b * 64 + (n_)) * 4 + h]; } while (0)
#define SC_LD_Q(n_) do { const unsigned char* cb_ = SC_BASE(n_); _Pragma("unroll") for (int m = 0; m < 4; ++m) _Pragma("unroll") for (int kk = 0; kk < 2; ++kk) { const size_t o_ = (size_t)((m * 2 + kk) * 64 + lane) * 16; \
            qk[m][kk] = *(const bf16x8*)(cb_ + o_); qd[m][kk] = *(const bf16x8*)(cb_ + 16384 + o_); } } while (0)
#define SC_LD_K(n_) do { const unsigned char* cb_ = SC_BASE(n_); _Pragma("unroll") for (int m = 0; m < 4; ++m) _Pragma("unroll") for (int kk = 0; kk < 2; ++kk) kd[m][kk] = *(const bf16x8*)(cb_ + 24576 + (size_t)((m * 2 + kk) * 64 + lane) * 16); } while (0)
        SC_LD_W(0); SC_LD_Q(0); SC_LD_K(0);
#pragma unroll 1
        for (int n = 0; n < 64; ++n) {
            const int nn = n < 63 ? n + 1 : 63;
            const float egl = __expf(glv);
            bf16x8 Sb[2], Vb[2];
            Sb[0] = pack8(S[0], S[1]); Sb[1] = pack8(S[2], S[3]);
            f32x4 vn[4], O[4];
#pragma unroll
            for (int m = 0; m < 4; ++m) { f32x4 T = {0.f, 0.f, 0.f, 0.f}; T = MFMA16(wf[m][0], Sb[0], T); T = MFMA16(wf[m][1], Sb[1], T); vn[m] = u[m] - T; }
            SC_LD_W(nn);
            Vb[0] = pack8(vn[0], vn[1]); Vb[1] = pack8(vn[2], vn[3]);
#pragma unroll
            for (int m = 0; m < 4; ++m) { f32x4 o = {0.f, 0.f, 0.f, 0.f}; o = MFMA16(qd[m][0], Sb[0], o); o = MFMA16(qd[m][1], Sb[1], o); o = MFMA16(qk[m][0], Vb[0], o); o = MFMA16(qk[m][1], Vb[1], o); O[m] = o; }
            SC_LD_Q(nn);
#pragma unroll
            for (int m = 0; m < 4; ++m) { f32x4 s2 = S[m] * egl; s2 = MFMA16(kd[m][0], Vb[0], s2); s2 = MFMA16(kd[m][1], Vb[1], s2); S[m] = s2; }
            SC_LD_K(nn);
            const size_t t0 = (size_t)b * 4096 + n * 64;
#pragma unroll
            for (int m = 0; m < 4; ++m)
#pragma unroll
                for (int jj = 0; jj < 4; ++jj) oraw[(t0 + 16 * m + 4 * fq + jj) * 256 + h * 64 + 16 * sl + fr] = O[m][jj];
        }
#undef SC_BASE
#undef SC_LD_W
#undef SC_LD_Q
#undef SC_LD_K
        float* So = outp(a) + O_SDP + ((size_t)(l * 8 + b) * 4 + h) * 4096;
#pragma unroll
        for (int m = 0; m < 4; ++m)
#pragma unroll
            for (int jj = 0; jj < 4; ++jj) So[(16 * m + 4 * fq + jj) * 64 + 16 * sl + fr] = S[m][jj];
    }
}

__device__ void phase_aout(const Args& a, const int l) {
    const int lane = tidx() & 63, wid = tidx() >> 6, c4 = lane * 4;
    const float* oraw = (const float*)(wsp(a) + WS_ORAW); const bf16_t* proj = (const bf16_t*)(wsp(a) + WS_PROJ); bf16_t* mix = (bf16_t*)(wsp(a) + WS_MIX);
    const f32x4 g = *(const f32x4*)(inp(a, 13) + l * 64 + (c4 & 63));
    for (int r = bidx() * 8 + wid; r < M; r += gdim() * 8) {
        const f32x4 o = *(const f32x4*)(oraw + (size_t)r * 256 + c4);
        const float ss = red16(o[0] * o[0] + o[1] * o[1] + o[2] * o[2] + o[3] * o[3]);
        const f32x4 y = o * rsqrtf(ss * (1.f / 64.f) + EPS) * g;
        st4bf(mix + (size_t)r * DM + c4, y * silu4(ld4bf(proj + (size_t)r * PS + C_AZ + c4)));
    }
}

__device__ void phase_fix(const Args& a, const int l) {
    const float* sg = (const float*)(wsp(a) + WS_SG); const float* su = (const float*)(wsp(a) + WS_SU); bf16_t* act = (bf16_t*)(wsp(a) + WS_PROJ);
    const float* cw = inp(a, 24) + (size_t)l * 3 * FF;
    for (int idx = bidx() * 512 + tidx(); idx < 512 * 2 * 704; idx += gdim() * 512) {
        const int f = (idx % 704) * 4, q = (idx / 704) & 1, blk = idx / 1408; const bool prev = (blk & 63) != 0;
        const f32x4 z4 = {0.f, 0.f, 0.f, 0.f};
        const f32x4 g0 = *(const f32x4*)(sg + ((size_t)blk * 4 + q) * FF + f), up = *(const f32x4*)(su + ((size_t)blk * 2 + q) * FF + f);
        f32x4 gm2, gm1;
        if (q == 0) { gm2 = prev ? *(const f32x4*)(sg + ((size_t)(blk - 1) * 4 + 2) * FF + f) : z4; gm1 = prev ? *(const f32x4*)(sg + ((size_t)(blk - 1) * 4 + 3) * FF + f) : z4; }
        else { gm2 = prev ? *(const f32x4*)(sg + ((size_t)(blk - 1) * 4 + 3) * FF + f) : z4; gm1 = *(const f32x4*)(sg + ((size_t)blk * 4 + 0) * FF + f); }
        const f32x4 gc = *(const f32x4*)(cw + f) * gm2 + *(const f32x4*)(cw + FF + f) * gm1 + *(const f32x4*)(cw + 2 * FF + f) * g0;
        st4bf(act + ((size_t)blk * 64 + q) * FF + f, silu4(gc) * up);
    }
}

__device__ void phase_final(const Args& a) {
    const int lane = tidx() & 63, wid = tidx() >> 6;
    const float* ssq = (const float*)(wsp(a) + WS_SSQA); const float* g = inp(a, 26);
    for (int r = bidx() * 8 + wid; r < M; r += gdim() * 8) {
        const float sc = rowscale(ssq, r); float* xr = outp(a) + (size_t)r * DM;
#pragma unroll
        for (int q = 0; q < 4; ++q) { const int c = q * 256 + lane * 4; *(f32x4*)(xr + c) = *(const f32x4*)(xr + c) * sc * *(const f32x4*)(g + c); }
    }
}

constexpr int NPH = 20, LDS_BYTES = 147456;
__global__ void __launch_bounds__(512) fwd_kernel(Args a0) {
    extern __shared__ __attribute__((aligned(16))) unsigned char smem[];
    LAS unsigned char* lds = (LAS unsigned char*)smem;
#ifndef DUPMASK
#define DUPMASK 0
#endif
    int dup = 0;
#pragma unroll 1
    for (int ph = a0.ph_lo; ph < a0.ph_hi; ++ph) {
        if (ph > a0.ph_lo && a0.coop) cg::this_grid().sync();
        const Args& a = a0;
#ifndef PHMASK
#define PHMASK 0xFFFFF
#endif
        if (ph == 0) { if (PHMASK & 1) phase_prep(a, smem); continue; }
        if (ph == NPH - 1) { if (PHMASK & 2) phase_final(a); continue; }
        const int l = (ph - 1) / 9, sp = (ph - 1) % 9;
        pg8::StaticOrder S;
        if (!((PHMASK >> (2 + sp)) & 1)) continue;
        switch (sp) {
        case 0: { pg8::Gemm g{(const bf16_t*)(wsp(a) + WS_XB), (const bf16_t*)(wsp(a) + WS_WIN) + (size_t)l * NPAD * 1024, M, NPAD, 1024}; S.init(M, NPAD, gdim(), bidx());
            EpiProj E{(bf16_t*)(wsp(a) + WS_PROJ), (const float*)(wsp(a) + WS_SSQA)}; pg8::gemm_phase(lds, g, S, E); } break;
        case 1: phase_tok(a, l); break;
        case 2: phase_chunk(a, l, smem); break;
        case 3: phase_scan(a, l); break;
        case 4: phase_aout(a, l); break;
        case 5: { pg8::Gemm g{(const bf16_t*)(wsp(a) + WS_MIX), (const bf16_t*)(wsp(a) + WS_WOUT) + (size_t)l * 1024 * 1024, M, 1024, 1024}; S.init(M, 1024, gdim(), bidx());
            EpiRes E{l == 0 ? inp(a, 0) : outp(a), l == 0 ? inp(a, 1) : outp(a) + O_YS, outp(a), (bf16_t*)(wsp(a) + WS_XB), (float*)(wsp(a) + WS_SSQB)}; pg8::gemm_phase(lds, g, S, E); } break;
        case 6: { pg8::Gemm g{(const bf16_t*)(wsp(a) + WS_XB), (const bf16_t*)(wsp(a) + WS_WGU) + (size_t)l * 5632 * 1024, M, 5632, 1024}; S.init(M, 5632, gdim(), bidx());
            EpiGU E{(bf16_t*)(wsp(a) + WS_PROJ), (const float*)(wsp(a) + WS_SSQB), inp(a, 24) + (size_t)l * 3 * FF, inp(a, 7) + (size_t)l * 128 * 2 * FF, (float*)(wsp(a) + WS_SG), (float*)(wsp(a) + WS_SU),
                    outp(a) + O_SFP + (size_t)l * 8 * 2 * FF, outp(a) + O_SFS + (size_t)l * 128 * 2 * FF}; pg8::gemm_phase(lds, g, S, E); } break;
        case 7: phase_fix(a, l); break;
        default: { pg8::Gemm g{(const bf16_t*)(wsp(a) + WS_PROJ), (const bf16_t*)(wsp(a) + WS_WDN) + (size_t)l * 1024 * FF, M, 1024, FF}; S.init(M, 1024, gdim(), bidx());
            EpiRes E{outp(a), outp(a) + O_YS, outp(a), (bf16_t*)(wsp(a) + WS_XB), (float*)(wsp(a) + WS_SSQA)}; pg8::gemm_phase(lds, g, S, E); } break;
        }
        if (DUPMASK && !dup && ph >= 1 && ph <= 9 && ((DUPMASK >> (ph - 1)) & 1)) { dup = 1; --ph; } else dup = 0;
    }
}

extern "C" void kernel_launch(void* const* d_in, const int* in_sizes, int n_in, void* d_out, int out_size, void* d_ws, size_t ws_size, hipStream_t stream) {
    static int grid = 0;
    if (grid == 0) {
        if (n_in != 27 || (size_t)out_size != O_END || ws_size < WS_END) { fprintf(stderr, "kernel_launch: unexpected sizes n_in %d out %d ws %zu (need %zu)\n", n_in, out_size, ws_size, (size_t)WS_END); grid = -1; return; }
        int dev = 0, cus = 0, per_cu = 0;
        hipGetDevice(&dev); hipDeviceGetAttribute(&cus, hipDeviceAttributeMultiprocessorCount, dev);
        if (hipFuncSetAttribute((const void*)fwd_kernel, hipFuncAttributeMaxDynamicSharedMemorySize, LDS_BYTES) != hipSuccess) { fprintf(stderr, "kernel_launch: hipFuncSetAttribute failed\n"); grid = -1; return; }
        hipOccupancyMaxActiveBlocksPerMultiprocessor(&per_cu, (const void*)fwd_kernel, 512, LDS_BYTES);
        (void)hipGetLastError();
        if (per_cu < 1) per_cu = 1;
        grid = cus * 1;
        if (grid <= 0) grid = 256;
    }
    if (grid < 0) return;
    Args a{};
    for (int i = 0; i < 27; ++i) a.in[i] = (const float*)d_in[i];
    a.out = (float*)d_out; a.ws = (unsigned char*)d_ws;
#if ONE_LAUNCH
    a.coop = 1; a.ph_lo = 0; a.ph_hi = NPH;
    void* args[] = {&a};
    hipError_t e = hipLaunchCooperativeKernel((const void*)fwd_kernel, dim3(grid), dim3(512), args, LDS_BYTES, stream);
    if (e != hipSuccess) fprintf(stderr, "cooperative launch failed: %s (grid %d)\n", hipGetErrorString(e), grid);
#else
    a.coop = 0;
    for (int ph = 0; ph < NPH; ++ph) { a.ph_lo = ph; a.ph_hi = ph + 1; hipLaunchKernelGGL(fwd_kernel, dim3(grid), dim3(512), LDS_BYTES, stream, a); }
#endif
}
```

```cpp
#include <hip/hip_runtime.h>
#include <hip/hip_cooperative_groups.h>
#include <cstdio>
namespace cg = cooperative_groups;

#define DEVI __device__ __forceinline__
#define LAS __attribute__((address_space(3)))
typedef unsigned short bf16_t;
typedef short bf16x8 __attribute__((ext_vector_type(8)));
typedef short bf16x4 __attribute__((ext_vector_type(4)));
typedef float f32x4 __attribute__((ext_vector_type(4)));

#ifndef ONE_LAUNCH
#define ONE_LAUNCH 1
#endif

constexpr int MP = 32768, MS = 512, M = MP + MS, DM = 1024, FF = 2816, PS = 2824  , NPAD = 3072;
constexpr int C_AQ = 0, C_AZ = 768, C_BB = 1024, C_BC = 1280, C_BH = 1536, C_CQ = 1792, C_CK = 2048, C_DU = 2304, C_DV = 2560, C_AB = 2816, C_AA = 2820;
constexpr float EPS = 1e-6f;

constexpr size_t O_YP = 0, O_YS = O_YP + (size_t)MP * DM, O_SDP = O_YS + (size_t)MS * DM, O_SDS = O_SDP + 2 * 8 * 4 * 4096, O_SCP = O_SDS + 2 * 128 * 4 * 4096,
                 O_SCS = O_SCP + 2 * 8 * 3 * 768, O_SSP = O_SCS + 2 * 128 * 3 * 768, O_SSS = O_SSP + 2 * 8 * 2 * 256, O_CKP = O_SSS + 2 * 128 * 2 * 256,
                 O_CKS = O_CKP + 2 * 8 * 128 * 128, O_CVP = O_CKS + 2 * 128 * 128 * 128, O_CVS = O_CVP + 2 * 8 * 128 * 128, O_SFP = O_CVS + 2 * 128 * 128 * 128,
                 O_SFS = O_SFP + 2 * 8 * 2 * 2816, O_CHV = O_SFS + 2 * 128 * 2 * 2816, O_END = O_CHV + 2 * 128 * 4 * 256;
static_assert(O_END == 50008064, "output size");

constexpr size_t WS_WIN = 0, WS_WOUT = WS_WIN + (size_t)2 * NPAD * 1024 * 2, WS_WGU = WS_WOUT + (size_t)2 * 1024 * 1024 * 2, WS_WDN = WS_WGU + (size_t)2 * 5632 * 1024 * 2,
                 WS_XB = WS_WDN + (size_t)2 * 1024 * 2816 * 2,
                 WS_PROJ = WS_XB + (size_t)M * 1024 * 2,
                 WS_MIX = WS_PROJ + (size_t)M * PS * 2,
                 WS_SSQA = WS_MIX + (size_t)M * 1024 * 2, WS_SSQB = WS_SSQA + (size_t)M * 16 * 4, WS_BG = WS_SSQB + (size_t)M * 16 * 4,
                 WS_GLS = WS_BG + (size_t)M * 8 * 4,
                 WS_QR = WS_GLS + 2048 * 4,
                 WS_KVR = WS_QR + (size_t)M * 256 * 2, WS_DVN = WS_KVR + (size_t)M * 256 * 2, WS_ORAW = WS_QR,
                 WS_A2 = WS_DVN + (size_t)M * 256 * 2,
                 WS_SG = WS_A2, WS_SU = WS_SG + (size_t)512 * 4 * 2816 * 4,
                 WS_END = WS_A2 + (size_t)2048 * 49152;
static_assert(WS_END <= (size_t)536870912, "workspace too large");
static_assert(WS_SU + (size_t)512 * 2 * 2816 * 4 <= WS_END, "side buffers");
static_assert((size_t)M * 256 * 4 <= (size_t)3 * M * 256 * 2, "oraw alias");

struct Args { const float* in[27]; float* out; unsigned char* ws; int coop; int ph_lo; int ph_hi; int pad; };

DEVI int tidx() { int t = threadIdx.x; asm volatile("" : "+v"(t)); return t; }
DEVI int bidx() { int t = blockIdx.x; asm volatile("" : "+s"(t)); return t; }
DEVI int gdim() { int t = gridDim.x; asm volatile("" : "+s"(t)); return t; }
DEVI float bf2f(bf16_t v) { return __uint_as_float(((unsigned)v) << 16); }
DEVI bf16_t f2bf(float f) { unsigned u = __float_as_uint(f); u += 0x7FFFu + ((u >> 16) & 1u); return (bf16_t)(u >> 16); }
DEVI unsigned pk2(float lo, float hi) { unsigned r; asm("v_cvt_pk_bf16_f32 %0, %1, %2" : "=v"(r) : "v"(lo), "v"(hi)); return r; }
DEVI f32x4 ld4bf(const bf16_t* p) { const uint2 u = *(const uint2*)p; f32x4 o; o[0] = __uint_as_float(u.x << 16); o[1] = __uint_as_float(u.x & 0xffff0000u); o[2] = __uint_as_float(u.y << 16); o[3] = __uint_as_float(u.y & 0xffff0000u); return o; }
DEVI f32x4 cv4bf(const uint2 u) { f32x4 o; o[0] = __uint_as_float(u.x << 16); o[1] = __uint_as_float(u.x & 0xffff0000u); o[2] = __uint_as_float(u.y << 16); o[3] = __uint_as_float(u.y & 0xffff0000u); return o; }
DEVI void st4bf(bf16_t* p, f32x4 v) { uint2 u; u.x = pk2(v[0], v[1]); u.y = pk2(v[2], v[3]); *(uint2*)p = u; }
DEVI bf16x8 pack8(f32x4 a, f32x4 b) { union { uint4 u; bf16x8 v; } x; x.u.x = pk2(a[0], a[1]); x.u.y = pk2(a[2], a[3]); x.u.z = pk2(b[0], b[1]); x.u.w = pk2(b[2], b[3]); return x.v; }
DEVI uint4 pack8u(f32x4 a, f32x4 b) { uint4 u; u.x = pk2(a[0], a[1]); u.y = pk2(a[2], a[3]); u.z = pk2(b[0], b[1]); u.w = pk2(b[2], b[3]); return u; }
DEVI float wave_sum(float v) { for (int d = 1; d < 64; d <<= 1) v += __shfl_xor(v, d); return v; }
DEVI float red16(float v) { v += __shfl_xor(v, 1); v += __shfl_xor(v, 2); v += __shfl_xor(v, 4); v += __shfl_xor(v, 8); return v; }
DEVI float silu_f(float y) { return y / (1.f + __expf(-y)); }
DEVI float gelu_f(float x) { const float z = 0.7978845608028654f * (x + 0.044715f * x * x * x); return x / (1.f + __expf(-2.f * z)); }
DEVI f32x4 silu4(f32x4 v) { f32x4 o; for (int i = 0; i < 4; ++i) o[i] = silu_f(v[i]); return o; }
DEVI f32x4 gelu4(f32x4 v) { f32x4 o; for (int i = 0; i < 4; ++i) o[i] = gelu_f(v[i]); return o; }
DEVI float rdlane(float v, int l) { return __builtin_bit_cast(float, __builtin_amdgcn_readlane(__builtin_bit_cast(int, v), l)); }
DEVI void wave_lds_fence() { asm volatile("s_waitcnt lgkmcnt(0)" ::: "memory"); }
template <int CTRL> DEVI float dppf(float x) { return __builtin_bit_cast(float, __builtin_amdgcn_update_dpp(0, __builtin_bit_cast(int, x), CTRL, 0xf, 0xf, true)); }
DEVI float rowscale(const float* ssq, int r) { const f32x4* p = (const f32x4*)(ssq + (size_t)r * 16); const f32x4 a = p[0], b = p[1], c = p[2], d = p[3];
    const float s = (a[0] + a[1] + a[2] + a[3]) + (b[0] + b[1] + b[2] + b[3]) + (c[0] + c[1] + c[2] + c[3]) + (d[0] + d[1] + d[2] + d[3]); return rsqrtf(s * (1.f / 1024.f) + EPS); }
#define GLB __attribute__((address_space(1)))
DEVI unsigned char* wsp(const Args& a) { GLB unsigned char* p = (GLB unsigned char*)a.ws; asm volatile("" : "+s"(p)); return (unsigned char*)p; }
DEVI float* outp(const Args& a) { GLB float* p = (GLB float*)a.out; asm volatile("" : "+s"(p)); return (float*)p; }
DEVI const float* inp(const Args& a, int k) { GLB const float* p = (GLB const float*)a.in[k]; asm volatile("" : "+s"(p)); return (const float*)p; }
#define MFMA16(a, b, c) __builtin_amdgcn_mfma_f32_16x16x32_bf16((a), (b), (c), 0, 0, 0)

namespace pg8 {
constexpr int BM = 256, BK = 64, HALF = 128, HTB = HALF * BK * 2, STAGE_BYTES = 8 * HTB, NXCD = 8, WGM = 8;
DEVI int lds_byte(int r, int c) { const int st = (r >> 4) * 2 + (c >> 5), rr = r & 15, cc = c & 31, ob = rr * 64 + cc * 2; return st * 1024 + (ob ^ (((ob >> 9) & 1) << 5)); }
DEVI void stage_rc(int b, int& R, int& C) { const int st = b / 1024, sb = b % 1024, swz = sb ^ (((sb >> 9) & 1) << 5); R = (st >> 1) * 16 + swz / 64; C = (st & 1) * 32 + (swz % 64) / 2; }
DEVI int perm32(int rho) { const int n = rho >> 4, i = rho & 15; return 8 * (i >> 2) + 4 * n + (i & 3); }
struct Unit { int pm, pn; };
struct Gemm { const bf16_t* A; const bf16_t* Bt; int M, N, K; };
struct StaticOrder {
    int nM, nN, nwg, G, c;
    DEVI void init(int M_, int N_, int G_, int c_) { nM = M_ / BM; nN = N_ / BM; nwg = nM * nN; G = G_; c = c_; }
    DEVI bool next(int i, Unit& u) const {
        const long L = (long)i * G + c; if (L >= nwg) return false;
        int wgid = (int)L; { const int q = nwg / NXCD, r = nwg % NXCD, xcd = wgid % NXCD, off = wgid / NXCD; wgid = (xcd < r ? xcd * (q + 1) : r * (q + 1) + (xcd - r) * q) + off; }
        const int nig = WGM * nN, gid = wgid / nig, fm = gid * WGM, gsz = (nM - fm) < WGM ? (nM - fm) : WGM;
        u.pm = fm + ((wgid % nig) % gsz); u.pn = (wgid % nig) / gsz; return true;
    }
    DEVI void a_ready(const Unit&) const {}
    DEVI void done(const Unit&) const {}
};
template <class Epi, class Sched>
DEVI void gemm_phase(LAS unsigned char* lds, const Gemm g, const Sched& S, const Epi& E) {
    const int tid = tidx(), wid = __builtin_amdgcn_readfirstlane(tid >> 6), lane = tid & 63, wr = wid >> 2, wc = wid & 3, fr = lane & 15, fq = lane >> 4;
    const int K = g.K, nt = K / BK;
    unsigned voffA[2], voffB[2];
#pragma unroll
    for (int i = 0; i < 2; ++i) { int R, C; stage_rc(tid * 16 + i * 8192, R, C); const int Rb = Epi::PERM ? ((R & ~31) + perm32(R & 31)) : R;
        voffA[i] = (unsigned)(R * K + C) * 2u; voffB[i] = (unsigned)(Rb * K + C) * 2u; }
    const size_t kstep = (size_t)(BK * 2);
    const size_t hstep = (size_t)HALF * K * 2;
    const size_t tstep = 2 * hstep;
    const unsigned ldsw = (unsigned)wid * 1024u;
    const int aoff = lds_byte(wr * 64 + fr, fq * 8), boff = lds_byte(wc * 32 + fr, fq * 8);
#define PG8_SA(b, h) (((b) * 2 + (h)) * HTB)
#define PG8_SB(b, h) ((4 + (b) * 2 + (h)) * HTB)
#define PG8_STAGE(bufoff, gbase, voff) do { _Pragma("unroll") for (int _i = 0; _i < 2; ++_i) \
        __builtin_amdgcn_global_load_lds((const unsigned*)((const char*)(gbase) + (voff)[_i]), (LAS unsigned*)(lds + (bufoff) + ldsw + _i * 8192), 16, 0, 0); } while (0)
#define PG8_LDA(dst, b, h) do { _Pragma("unroll") for (int m = 0; m < 4; ++m) _Pragma("unroll") for (int k = 0; k < 2; ++k) dst[m][k] = *(const LAS bf16x8*)(lds + PG8_SA(b, h) + aoff + m * 2048 + k * 1024); } while (0)
#define PG8_LDB(dst, b, h) do { _Pragma("unroll") for (int n = 0; n < 2; ++n) _Pragma("unroll") for (int k = 0; k < 2; ++k) dst[n][k] = *(const LAS bf16x8*)(lds + PG8_SB(b, h) + boff + n * 2048 + k * 1024); } while (0)
#define PG8_MMA(ai, bj, At, Bt) do { __builtin_amdgcn_s_setprio(1); _Pragma("unroll") for (int m = 0; m < 4; ++m) _Pragma("unroll") for (int n = 0; n < 2; ++n) _Pragma("unroll") for (int k = 0; k < 2; ++k) \
        acc[ai][bj][m][n] = __builtin_amdgcn_mfma_f32_16x16x32_bf16(Bt[n][k], At[m][k], acc[ai][bj][m][n], 0, 0, 0); __builtin_amdgcn_s_setprio(0); } while (0)
#define PG8_WAIT_V(n) asm volatile("s_waitcnt vmcnt(" #n ")" ::: "memory")
#define PG8_WAIT_L(n) asm volatile("s_waitcnt lgkmcnt(" #n ")" ::: "memory")
#define PG8_BAR __builtin_amdgcn_s_barrier()
#define PG8_SCHED __builtin_amdgcn_sched_barrier(0)
    Unit cur, nxt; int ui = 0;
    if (!S.next(0, cur)) return;
    f32x4 acc[2][2][4][2];
#pragma unroll
    for (int a = 0; a < 2; ++a)
#pragma unroll
        for (int b = 0; b < 2; ++b)
#pragma unroll
            for (int m = 0; m < 4; ++m)
#pragma unroll
                for (int n = 0; n < 2; ++n) acc[a][b][m][n] = (f32x4){0.f, 0.f, 0.f, 0.f};
    bf16x8 At[4][2], B0[2][2], B1[2][2];
    const char* cA = (const char*)g.A + (size_t)cur.pm * tstep; const char* cB = (const char*)g.Bt + (size_t)cur.pn * tstep;
    S.a_ready(cur);
    PG8_STAGE(PG8_SB(0, 0), cB, voffB); PG8_STAGE(PG8_SA(0, 0), cA, voffA); PG8_STAGE(PG8_SB(0, 1), cB + hstep, voffB); PG8_STAGE(PG8_SA(0, 1), cA + hstep, voffA);
    if (wr == 1) PG8_BAR;
    PG8_WAIT_V(4); PG8_BAR;
    PG8_STAGE(PG8_SB(1, 0), cB + kstep, voffB); PG8_STAGE(PG8_SA(1, 0), cA + kstep, voffA); PG8_STAGE(PG8_SB(1, 1), cB + hstep + kstep, voffB);
    PG8_WAIT_V(6); PG8_BAR;
    for (;;) {
        const bool has_next = S.next(ui + 1, nxt);
        const char* nA = has_next ? (const char*)g.A + (size_t)nxt.pm * tstep : cA; const char* nB = has_next ? (const char*)g.Bt + (size_t)nxt.pn * tstep : cB;
        for (int t = 0; t < nt; t += 2) {
            const bool last = (t == nt - 2);
            const char* a1 = cA + (size_t)(t + 1) * kstep;
            const char* a2 = last ? nA : cA + (size_t)(t + 2) * kstep; const char* b2 = last ? nB : cB + (size_t)(t + 2) * kstep;
            const char* a3 = a2 + kstep; const char* b3 = b2 + kstep;
            if (last && has_next) S.a_ready(nxt);
            PG8_LDB(B0, 0, 0); PG8_SCHED; PG8_LDA(At, 0, 0); PG8_STAGE(PG8_SA(1, 1), a1 + hstep, voffA);
            PG8_WAIT_L(8); PG8_BAR; PG8_WAIT_L(0); PG8_MMA(0, 0, At, B0); PG8_BAR; PG8_SCHED;
            PG8_LDB(B1, 0, 1); PG8_STAGE(PG8_SB(0, 0), b2, voffB);
            PG8_BAR; PG8_WAIT_L(0); PG8_MMA(0, 1, At, B1); PG8_BAR;
            PG8_LDA(At, 0, 1); PG8_STAGE(PG8_SA(0, 0), a2, voffA);
            PG8_BAR; PG8_WAIT_L(0); PG8_MMA(1, 0, At, B0); PG8_BAR; PG8_SCHED;
            PG8_STAGE(PG8_SB(0, 1), b2 + hstep, voffB);
            PG8_WAIT_V(6); PG8_BAR; PG8_MMA(1, 1, At, B1); PG8_BAR;
            PG8_LDB(B0, 1, 0); PG8_SCHED; PG8_LDA(At, 1, 0); PG8_STAGE(PG8_SA(0, 1), a2 + hstep, voffA);
            PG8_WAIT_L(8); PG8_BAR; PG8_WAIT_L(0); PG8_MMA(0, 0, At, B0); PG8_BAR; PG8_SCHED;
            PG8_LDB(B1, 1, 1); PG8_STAGE(PG8_SB(1, 0), b3, voffB);
            PG8_BAR; PG8_WAIT_L(0); PG8_MMA(0, 1, At, B1); PG8_BAR;
            PG8_LDA(At, 1, 1); PG8_STAGE(PG8_SA(1, 0), a3, voffA);
            PG8_BAR; PG8_WAIT_L(0); PG8_MMA(1, 0, At, B0); PG8_BAR; PG8_SCHED;
            PG8_STAGE(PG8_SB(1, 1), b3 + hstep, voffB);
            PG8_WAIT_V(6); PG8_BAR; PG8_MMA(1, 1, At, B1); PG8_BAR;
        }
        E(acc, cur, wr, wc, fr, fq); S.done(cur);
#ifdef EPI_TWICE
        if (Epi::TWICE) E(acc, cur, wr, wc, fr, fq);
#endif
        if (!has_next) break;
#pragma unroll
        for (int a = 0; a < 2; ++a)
#pragma unroll
            for (int b = 0; b < 2; ++b)
#pragma unroll
                for (int m = 0; m < 4; ++m)
#pragma unroll
                    for (int n = 0; n < 2; ++n) acc[a][b][m][n] = (f32x4){0.f, 0.f, 0.f, 0.f};
        cur = nxt; cA = nA; cB = nB; ++ui;
    }
    PG8_WAIT_V(0);
    if (wr == 0) PG8_BAR;
    PG8_BAR;
#undef PG8_SA
#undef PG8_SB
#undef PG8_STAGE
#undef PG8_LDA
#undef PG8_LDB
#undef PG8_MMA
#undef PG8_WAIT_V
#undef PG8_WAIT_L
#undef PG8_BAR
#undef PG8_SCHED
}
}
using pg8::Unit;

struct EpiProj {
    static constexpr bool PERM = true, TWICE = true;
    bf16_t* P; const float* ssq;
    DEVI void operator()(const f32x4 (&acc)[2][2][4][2], const Unit& u, int wr, int wc, int fr, int fq) const {
        const int row0 = u.pm * 256 + wr * 64 + fr, colb = u.pn * 256 + wc * 32 + 8 * fq;
#pragma unroll
        for (int ai = 0; ai < 2; ++ai)
#pragma unroll
            for (int m = 0; m < 4; ++m) { const int r = row0 + ai * 128 + m * 16; const float sc = rowscale(ssq, r);
#pragma unroll
                for (int bj = 0; bj < 2; ++bj) { const int c = colb + bj * 128;
                    if (c < PS) *(uint4*)(P + (size_t)r * PS + c) = pack8u(acc[ai][bj][m][0] * sc, acc[ai][bj][m][1] * sc); } }
    }
};
struct EpiRes {
    static constexpr bool PERM = true, TWICE = false;
    bf16_t* xb; float* ssq;
    DEVI void operator()(const f32x4 (&acc)[2][2][4][2], const Unit& u, int wr, int wc, int fr, int fq) const {
        const int row0 = u.pm * 256 + wr * 64 + fr, colb = u.pn * 256 + wc * 32 + 8 * fq;
#pragma unroll
        for (int ai = 0; ai < 2; ++ai)
#pragma unroll
            for (int m = 0; m < 4; ++m) { const int r = row0 + ai * 128 + m * 16; float part = 0.f;
#pragma unroll
                for (int bj = 0; bj < 2; ++bj) { const int c = colb + bj * 128; bf16_t* xp = xb + (size_t)r * DM + c;
                    const uint4 rv = *(const uint4*)xp;
                    const f32x4 v0 = acc[ai][bj][m][0] + cv4bf((uint2){rv.x, rv.y}), v1 = acc[ai][bj][m][1] + cv4bf((uint2){rv.z, rv.w});
                    *(uint4*)xp = pack8u(v0, v1);
                    part += v0[0] * v0[0] + v0[1] * v0[1] + v0[2] * v0[2] + v0[3] * v0[3] + v1[0] * v1[0] + v1[1] * v1[1] + v1[2] * v1[2] + v1[3] * v1[3]; }
                part += __shfl_xor(part, 16); part += __shfl_xor(part, 32);
                if (fq == 0) ssq[(size_t)r * 16 + u.pn * 4 + wc] = part; }
    }
};
struct EpiGU {
    static constexpr bool PERM = true, TWICE = true;
    bf16_t* act; const float* ssq; const float* cw; const float* st; float* sg; float* su; float* osfp; float* osfs;
    DEVI void operator()(const f32x4 (&acc)[2][2][4][2], const Unit& u, int wr, int wc, int fr, int fq) const {
        const int f0 = u.pn * 128 + wc * 32 + 8 * fq;
        const f32x4 w0a = *(const f32x4*)(cw + f0), w0b = *(const f32x4*)(cw + f0 + 4), w1a = *(const f32x4*)(cw + FF + f0), w1b = *(const f32x4*)(cw + FF + f0 + 4),
                    w2a = *(const f32x4*)(cw + 2 * FF + f0), w2b = *(const f32x4*)(cw + 2 * FF + f0 + 4);
        const bool smp = u.pm >= 128;
#pragma unroll
        for (int ai = 0; ai < 2; ++ai) {
            const int rb = u.pm * 256 + ai * 128 + wr * 64;
            f32x4 gpa[4], gpb[4]; float scs[4];
#pragma unroll
            for (int m = 0; m < 4; ++m) { scs[m] = rowscale(ssq, rb + 16 * m + fr); gpa[m] = acc[ai][0][m][0] * scs[m]; gpb[m] = acc[ai][0][m][1] * scs[m]; }
#pragma unroll
            for (int m = 0; m < 4; ++m) {
                const int r = rb + 16 * m + fr;
                const f32x4 ua = acc[ai][1][m][0] * scs[m], ub = acc[ai][1][m][1] * scs[m];
                f32x4 p1a, p1b, p2a, p2b;
#pragma unroll
                for (int jj = 0; jj < 4; ++jj) {
                    const float ca = gpa[m][jj], cb = gpb[m][jj], pa = m > 0 ? gpa[m > 0 ? m - 1 : 0][jj] : 0.f, pb = m > 0 ? gpb[m > 0 ? m - 1 : 0][jj] : 0.f;
                    const float a1 = dppf<0x111>(ca), a2 = dppf<0x112>(ca), b1 = dppf<0x10F>(pa), b2 = dppf<0x10E>(pa);
                    p1a[jj] = fr >= 1 ? a1 : b1; p2a[jj] = fr >= 2 ? a2 : b2;
                    const float c1 = dppf<0x111>(cb), c2 = dppf<0x112>(cb), d1 = dppf<0x10F>(pb), d2 = dppf<0x10E>(pb);
                    p1b[jj] = fr >= 1 ? c1 : d1; p2b[jj] = fr >= 2 ? c2 : d2;
                }
                if (smp) {
                    const int t = fr & 3, bb = (r - MP) >> 2; const float* sp = st + (size_t)bb * 2 * FF + f0;
                    if (t == 0) { p2a = *(const f32x4*)sp; p2b = *(const f32x4*)(sp + 4); p1a = *(const f32x4*)(sp + FF); p1b = *(const f32x4*)(sp + FF + 4); }
                    else if (t == 1) { p2a = *(const f32x4*)(sp + FF); p2b = *(const f32x4*)(sp + FF + 4); }
                    if (t >= 2) { float* o = osfs + ((size_t)bb * 2 + (t - 2)) * FF + f0; *(f32x4*)o = gpa[m]; *(f32x4*)(o + 4) = gpb[m]; }
                }
                const bool head = !smp && m == 0 && fr < 2;
                if (!head) {
                    const f32x4 ga = w0a * p2a + w1a * p1a + w2a * gpa[m], gb = w0b * p2b + w1b * p1b + w2b * gpb[m];
                    *(uint4*)(act + (size_t)r * FF + f0) = pack8u(silu4(ga) * ua, silu4(gb) * ub);
                }
                if (!smp) {
                    const int blk = rb >> 6;
                    if (m == 0 && fr < 2) { float* o = sg + ((size_t)blk * 4 + fr) * FF + f0; *(f32x4*)o = gpa[m]; *(f32x4*)(o + 4) = gpb[m];
                        float* o2 = su + ((size_t)blk * 2 + fr) * FF + f0; *(f32x4*)o2 = ua; *(f32x4*)(o2 + 4) = ub; }
                    if (m == 3 && fr >= 14) { float* o = sg + ((size_t)blk * 4 + 2 + (fr - 14)) * FF + f0; *(f32x4*)o = gpa[m]; *(f32x4*)(o + 4) = gpb[m];
                        const int t = r & 4095; if (t >= 4094) { float* o3 = osfp + ((size_t)(r >> 12) * 2 + (t - 4094)) * FF + f0; *(f32x4*)o3 = gpa[m]; *(f32x4*)(o3 + 4) = gpb[m]; } }
                }
            }
        }
    }
};

__device__ void phase_prep(const Args& a, unsigned char* smem) {
    float* tile = (float*)smem;
    const int tid = tidx(), tx = tid & 63, ty = tid >> 6, lane = tid & 63, wid = tid >> 6;
    constexpr int T_IN = 48 * 4, T_OUT = 16 * 4, T_GU = 88 * 4, T_DN = 16 * 11, T_L = T_IN + T_OUT + T_GU + T_DN;
    for (int it = bidx(); it < 2 * T_L; it += gdim()) {
        const int l = it / T_L; int r = it % T_L;
        const float* src; int ld, col, kt, nt, Kd; const float* gk = nullptr; bf16_t* dst;
        if (r < T_IN) { nt = r / 4; kt = r % 4; Kd = 1024; ld = PS; src = inp(a, 9) + (size_t)l * 1024 * PS; gk = inp(a, 8) + l * 1024; dst = (bf16_t*)(wsp(a) + WS_WIN) + (size_t)l * NPAD * 1024;
            const int n = nt * 64 + tx; col = n < 1024 ? n : (n < 2816 ? n + 8 : (n < 2824 ? 1024 + (n - 2816) : -1)); }
        else if ((r -= T_IN) < T_OUT) { nt = r / 4; kt = r % 4; Kd = 1024; ld = 1024; src = inp(a, 20) + (size_t)l * 1024 * 1024; dst = (bf16_t*)(wsp(a) + WS_WOUT) + (size_t)l * 1024 * 1024; col = nt * 64 + tx; }
        else if ((r -= T_OUT) < T_GU) { nt = r / 4; kt = r % 4; Kd = 1024; ld = FF; gk = inp(a, 21) + l * 1024; dst = (bf16_t*)(wsp(a) + WS_WGU) + (size_t)l * 5632 * 1024;
            const int n = nt * 64, pn = n >> 8, cc = n & 255; src = (cc < 128 ? inp(a, 22) : inp(a, 23)) + (size_t)l * 1024 * FF; col = pn * 128 + (cc & 127) + tx; }
        else { r -= T_GU; nt = r / 11; kt = r % 11; Kd = FF; ld = 1024; src = inp(a, 25) + (size_t)l * FF * 1024; dst = (bf16_t*)(wsp(a) + WS_WDN) + (size_t)l * 1024 * FF; col = nt * 64 + tx; }
        float v[32];
#pragma unroll
        for (int i = 0; i < 32; ++i) { const int k = kt * 256 + ty + 8 * i; v[i] = col >= 0 ? src[(size_t)k * ld + col] : 0.f; }
        if (gk) {
#pragma unroll
            for (int i = 0; i < 32; ++i) v[i] *= gk[kt * 256 + ty + 8 * i]; }
#pragma unroll
        for (int i = 0; i < 32; ++i) tile[(ty + 8 * i) * 65 + tx] = v[i];
        __syncthreads();
#pragma unroll
        for (int i = 0; i < 8; ++i) { const int n = wid * 8 + i; const int k0 = lane * 4;
            f32x4 o = {tile[(k0 + 0) * 65 + n], tile[(k0 + 1) * 65 + n], tile[(k0 + 2) * 65 + n], tile[(k0 + 3) * 65 + n]};
            st4bf(dst + (size_t)(nt * 64 + n) * Kd + kt * 256 + k0, o); }
        __syncthreads();
    }
    bf16_t* xb = (bf16_t*)(wsp(a) + WS_XB); float* ssq = (float*)(wsp(a) + WS_SSQA);
    for (int r = bidx() * 8 + wid; r < M; r += gdim() * 8) {
        const float* xr = (r < MP) ? inp(a, 0) + (size_t)r * DM : inp(a, 1) + (size_t)(r - MP) * DM; float ss = 0.f;
#pragma unroll
        for (int q = 0; q < 4; ++q) { const f32x4 v = *(const f32x4*)(xr + q * 256 + lane * 4); ss += v[0] * v[0] + v[1] * v[1] + v[2] * v[2] + v[3] * v[3]; st4bf(xb + (size_t)r * DM + q * 256 + lane * 4, v); }
        ss = wave_sum(ss);
        if (lane < 16) ssq[(size_t)r * 16 + lane] = lane == 0 ? ss : 0.f;
    }
}

struct TokRaw { uint2 a0, a1, a2, bc, bh, bb, q, kv, dv, du; bf16_t ab, aa; };
DEVI TokRaw ldtok(const bf16_t* pr, int c4, int lane) { TokRaw t; t.a0 = *(const uint2*)(pr + C_AQ + c4); t.a1 = *(const uint2*)(pr + C_AQ + 256 + c4); t.a2 = *(const uint2*)(pr + C_AQ + 512 + c4);
    t.bc = *(const uint2*)(pr + C_BC + c4); t.bh = *(const uint2*)(pr + C_BH + c4); t.bb = *(const uint2*)(pr + C_BB + c4); t.q = *(const uint2*)(pr + C_CQ + c4); t.kv = *(const uint2*)(pr + C_CK + c4);
    t.dv = *(const uint2*)(pr + C_DV + c4); t.du = *(const uint2*)(pr + C_DU + c4); t.ab = pr[C_AB + (lane & 3)]; t.aa = pr[C_AA + (lane & 3)]; return t; }
__device__ void phase_tok(const Args& a, const int l, unsigned char* smem) {
    const int lane = tidx() & 63, wid = tidx() >> 6, c4 = lane * 4;
    const bf16_t* proj = (const bf16_t*)(wsp(a) + WS_PROJ);
    bf16_t* qkvn = (bf16_t*)outp(a); bf16_t* mix = (bf16_t*)(wsp(a) + WS_MIX); float* bg = (float*)(wsp(a) + WS_BG);
    bf16_t* qr = (bf16_t*)(wsp(a) + WS_QR); bf16_t* kvr = (bf16_t*)(wsp(a) + WS_KVR); bf16_t* dvn = (bf16_t*)(wsp(a) + WS_DVN);
    float* out = outp(a);
    float* sw = (float*)smem;
    for (int i = tidx(); i < 4352; i += 512) sw[i] = i < 3072 ? inp(a, 10)[(size_t)l * 3072 + i] : (i < 3840 ? inp(a, 14)[(size_t)l * 768 + i - 3072] : (i < 4096 ? inp(a, 16)[l * 256 + i - 3840] : inp(a, 17)[l * 256 + i - 4096]));
    __syncthreads();
    const float* cwp = sw + c4;
    const float* bwp = sw + 3072 + c4; const float* lngp = sw + 3840 + c4; const float* lnbp = sw + 4096 + c4;
    float inv[4];
#pragma unroll
    for (int e = 0; e < 4; ++e) inv[e] = powf(500000.f, -(float)(4 * (lane & 1) + e) * 0.125f);
    const int j16 = lane & 15, gD = lane >> 4;
    const float dtb = inp(a, 12)[l * 4 + (lane & 3)], nega = -__expf(inp(a, 11)[l * 4 + (lane & 3)]);
    const float* Wd = inp(a, 18) + ((size_t)(l * 4 + gD) * 128) * 128; const float* biasd = inp(a, 19) + (size_t)(l * 4 + gD) * 128;
    {
        const float* ck = inp(a, 5) + (size_t)l * 128 * 16384; const float* cv = inp(a, 6) + (size_t)l * 128 * 16384;
        float* ok = out + O_CKS + (size_t)l * 128 * 16384; float* ov = out + O_CVS + (size_t)l * 128 * 16384;
        for (int i = bidx() * 512 + tidx(); i < 128 * 3968; i += gdim() * 512) { const int bb = i / 3968, j = i - bb * 3968; const size_t o = (size_t)bb * 16384 + (size_t)j * 4;
            *(f32x4*)(ok + o) = *(const f32x4*)(ck + o + 512); *(f32x4*)(ov + o) = *(const f32x4*)(cv + o + 512); }
    }
    for (int run = bidx() * 8 + wid; run < 2048 + 128; run += gdim() * 8) {
        const bool smp = run >= 2048;
        int b, t0, ntok, pos0; size_t r0;
        if (!smp) { b = run >> 8; t0 = (run & 255) * 16; ntok = 16; r0 = (size_t)b * 4096 + t0; pos0 = t0; }
        else { b = run - 2048; t0 = 0; ntok = 4; r0 = (size_t)MP + 4 * b; pos0 = 16384; }
        f32x4 ha[3][3], hb[2];
        const f32x4 z4 = {0.f, 0.f, 0.f, 0.f};
        if (smp) {
            const float* st = inp(a, 3) + ((size_t)(l * 128 + b) * 3) * 768;
#pragma unroll
            for (int p = 0; p < 3; ++p)
#pragma unroll
                for (int j = 0; j < 3; ++j) ha[p][j] = *(const f32x4*)(st + j * 768 + p * 256 + c4);
            const float* sb = inp(a, 4) + ((size_t)(l * 128 + b) * 2) * 256; hb[0] = *(const f32x4*)(sb + c4); hb[1] = *(const f32x4*)(sb + 256 + c4);
        } else if (t0 == 0) {
#pragma unroll
            for (int p = 0; p < 3; ++p)
#pragma unroll
                for (int j = 0; j < 3; ++j) ha[p][j] = z4;
            hb[0] = z4; hb[1] = z4;
        } else {
#pragma unroll
            for (int p = 0; p < 3; ++p)
#pragma unroll
                for (int j = 0; j < 3; ++j) ha[p][j] = ld4bf(proj + (r0 - 3 + j) * PS + C_AQ + p * 256 + c4);
#pragma unroll
            for (int j = 0; j < 2; ++j) hb[j] = ld4bf(proj + (r0 - 2 + j) * PS + C_BC + c4) * ld4bf(proj + (r0 - 2 + j) * PS + C_BH + c4);
        }
        f32x4 h0 = z4, h1 = z4, h2 = z4, h3 = z4;
        TokRaw nx = ldtok(proj + r0 * PS, c4, lane);
#pragma unroll 1
        for (int i = 0; i < ntok; ++i) {
            const size_t r = r0 + i; const int t = t0 + i;
            const TokRaw tk = nx;
            const float* cwq = cwp; const float* bwq = bwp;
            nx = ldtok(proj + (r0 + (i + 1 < ntok ? i + 1 : i)) * PS, c4, lane);
#pragma unroll
            for (int p = 0; p < 3; ++p) {
                const f32x4 cur = cv4bf(p == 0 ? tk.a0 : (p == 1 ? tk.a1 : tk.a2));
                f32x4 s = silu4(*(const f32x4*)(cwq + p * 256) * ha[p][0] + *(const f32x4*)(cwq + 768 + p * 256) * ha[p][1] + *(const f32x4*)(cwq + 1536 + p * 256) * ha[p][2] + *(const f32x4*)(cwq + 2304 + p * 256) * cur);
                ha[p][0] = ha[p][1]; ha[p][1] = ha[p][2]; ha[p][2] = cur;
                if (p < 2) { float ss = red16(s[0] * s[0] + s[1] * s[1] + s[2] * s[2] + s[3] * s[3]); const float sc = rsqrtf(ss + EPS) * (p == 0 ? 0.125f : 1.f); s = s * sc; }
                st4bf(qkvn + r * 768 + p * 256 + c4, s);
                if (!smp) { if (t >= 4093) *(f32x4*)(out + O_SCP + ((size_t)(l * 8 + b) * 3 + (t - 4093)) * 768 + p * 256 + c4) = cur; }
                else if (i >= 1) *(f32x4*)(out + O_SCS + ((size_t)(l * 128 + b) * 3 + (i - 1)) * 768 + p * 256 + c4) = cur;
            }
            if (lane < 4) {
                const float ab = bf2f(tk.ab), aa = bf2f(tk.aa);
                const float beta = 1.f / (1.f + __expf(-ab)); const float x = aa + dtb; const float sp = x > 20.f ? x : log1pf(__expf(x));
                bg[r * 8 + lane] = beta; bg[r * 8 + 4 + lane] = nega * sp;
            }
            {
                const f32x4 s = cv4bf(tk.bc) * cv4bf(tk.bh), bb = cv4bf(tk.bb);
                const f32x4 bx = *(const f32x4*)bwq * hb[0] + *(const f32x4*)(bwq + 256) * hb[1] + *(const f32x4*)(bwq + 512) * s;
                st4bf(mix + r * DM + 256 + c4, bb * bx); hb[0] = hb[1]; hb[1] = s;
                if (!smp) { if (t >= 4094) *(f32x4*)(out + O_SSP + ((size_t)(l * 8 + b) * 2 + (t - 4094)) * 256 + c4) = s; }
                else if (i >= 2) *(f32x4*)(out + O_SSS + ((size_t)(l * 128 + b) * 2 + (i - 2)) * 256 + c4) = s;
            }
            {
                f32x4 q = cv4bf(tk.q), kv = cv4bf(tk.kv), qo, ko;
#pragma unroll
                for (int e = 0; e < 4; ++e) { qo[e] = __shfl_xor(q[e], 2); ko[e] = __shfl_xor(kv[e], 2); }
                const float posf = (float)(pos0 + i);
                if (j16 < 4) {
                    const float sgn = j16 < 2 ? -1.f : 1.f;
#pragma unroll
                    for (int e = 0; e < 4; ++e) {
                        const float ang = posf * inv[e]; const double rd = (double)ang * 0.15915494309189535; const float rr = (float)((rd - floor(rd)) * 6.283185307179586);
                        const float cs = __cosf(rr), sn = __sinf(rr);
                        q[e] = q[e] * cs + sgn * qo[e] * sn;
                        if (lane < 32) kv[e] = kv[e] * cs + sgn * ko[e] * sn;
                    }
                }
                st4bf(qr + r * 256 + c4, q); st4bf(kvr + r * 256 + c4, kv);
                if (!smp) { if (t >= 3968) { float* o = (lane < 32 ? out + O_CKP : out + O_CVP) + ((size_t)(l * 8 + b) * 128 + (t - 3968)) * 128 + (c4 & 127); *(f32x4*)o = kv; } }
                else { float* o = (lane < 32 ? out + O_CKS : out + O_CVS) + ((size_t)(l * 128 + b) * 128 + 124 + i) * 128 + (c4 & 127); *(f32x4*)o = kv; }
            }
            {
                const f32x4 x = gelu4(cv4bf(tk.dv));
                const float mean = wave_sum(x[0] + x[1] + x[2] + x[3]) * (1.f / 256.f);
                const f32x4 xc = x - mean;
                const float var = wave_sum(xc[0] * xc[0] + xc[1] * xc[1] + xc[2] * xc[2] + xc[3] * xc[3]) * (1.f / 256.f);
                const f32x4 y = xc * rsqrtf(var + EPS) * *(const f32x4*)lngp + *(const f32x4*)lnbp;
                st4bf(dvn + r * 256 + c4, y);
                if (smp) {
                    *(f32x4*)(out + O_CHV + ((size_t)(l * 128 + b) * 4 + i) * 256 + c4) = y;
                    if (i == 0) h0 = y; else if (i == 1) h1 = y; else if (i == 2) h2 = y; else h3 = y;
                    f32x4 mx = Wd[i * 128 + 0] * h0 + biasd[i];
                    if (i >= 1) mx = mx + Wd[i * 128 + 1] * h1;
                    if (i >= 2) mx = mx + Wd[i * 128 + 2] * h2;
                    if (i >= 3) mx = mx + Wd[i * 128 + 3] * h3;
                    st4bf(mix + r * DM + 768 + c4, gelu4(cv4bf(tk.du)) * mx);
                }
            }
        }
    }
}

constexpr int A2_LDS = 64 * 68 * 4 + 512;
DEVI int fragidx(int row, int col) { return (((row >> 4) * 2 + (col >> 5)) * 64 + ((col >> 2) & 3) * 16 + (row & 15)) * 8 + 4 * ((col >> 4) & 1) + (col & 3); }
__device__ void a2_item(const Args& a, const int it, unsigned char* wl) {
    const int lane = tidx() & 63, fr = lane & 15, fq = lane >> 4;
    float* Aw = (float*)wl; float* gcs = Aw + 64 * 68; float* bts = gcs + 64;
    const int h = it & 3, n = (it >> 2) & 63, b = it >> 8;
    const size_t t0 = (size_t)b * 4096 + n * 64;
    const float* bg = (const float*)(wsp(a) + WS_BG); const bf16_t* qkvn = (const bf16_t*)outp(a);
    float gcv = bg[(t0 + lane) * 8 + 4 + h]; const float bt = bg[(t0 + lane) * 8 + h];
    for (int d = 1; d < 64; d <<= 1) { const float o = __shfl_up(gcv, d); if (lane >= d) gcv += o; }
    const float gl = __shfl(gcv, 63);
    gcs[lane] = gcv; bts[lane] = bt;
    const bf16_t* qb = qkvn + t0 * 768 + h * 64; const bf16_t* kb = qb + 256; const bf16_t* vb = qb + 512;
    bf16x8 kf[4][2], qf[4][2];
#pragma unroll
    for (int m = 0; m < 4; ++m)
#pragma unroll
        for (int kk = 0; kk < 2; ++kk) { kf[m][kk] = *(const bf16x8*)(kb + (size_t)(16 * m + fr) * 768 + 32 * kk + 8 * fq); qf[m][kk] = *(const bf16x8*)(qb + (size_t)(16 * m + fr) * 768 + 32 * kk + 8 * fq); }
    wave_lds_fence();
    unsigned char* cbase = wsp(a) + WS_A2 + (size_t)it * 49152;
    if (lane == 0) ((float*)(wsp(a) + WS_GLS))[it] = gl;
#pragma unroll
    for (int m = 0; m < 4; ++m) {
        const int i = 16 * m + fr; const float gi = gcs[i], bi = bts[i];
#pragma unroll
        for (int k2 = 0; k2 < 2; ++k2) {
            f32x4 ak[2], aq[2];
#pragma unroll
            for (int hh = 0; hh < 2; ++hh) {
                const int nn = 2 * k2 + hh;
                ak[hh] = (f32x4){0.f, 0.f, 0.f, 0.f}; aq[hh] = (f32x4){0.f, 0.f, 0.f, 0.f};
                if (nn <= m) {
#pragma unroll
                    for (int kk = 0; kk < 2; ++kk) { ak[hh] = MFMA16(kf[nn][kk], kf[m][kk], ak[hh]); aq[hh] = MFMA16(kf[nn][kk], qf[m][kk], aq[hh]); }
                    const f32x4 gj = *(const f32x4*)(gcs + 16 * nn + 4 * fq);
#pragma unroll
                    for (int jj = 0; jj < 4; ++jj) { const int j = 16 * nn + 4 * fq + jj; const float e = __expf(fminf(gi - gj[jj], 0.f));
                        ak[hh][jj] = (j < i) ? bi * ak[hh][jj] * e : 0.f; aq[hh][jj] = (j <= i) ? aq[hh][jj] * e : 0.f; }
                }
                *(f32x4*)(Aw + i * 68 + 16 * nn + 4 * fq) = ak[hh];
            }
            *(uint4*)(cbase + ((m * 2 + k2) * 64 + lane) * 16) = pack8u(aq[0], aq[1]);
        }
    }
#pragma unroll
    for (int m = 0; m < 4; ++m)
#pragma unroll
        for (int kk = 0; kk < 2; ++kk) { const int i = 16 * m + fr; const float e = __expf(gcs[i]);
            const f32x4 lo = ld4bf(qb + (size_t)i * 768 + 32 * kk + 4 * fq) * e, hi = ld4bf(qb + (size_t)i * 768 + 32 * kk + 16 + 4 * fq) * e;
            *(uint4*)(cbase + 16384 + ((m * 2 + kk) * 64 + lane) * 16) = pack8u(lo, hi); }
    wave_lds_fence();
    const int c = lane;
    bf16_t* wF = (bf16_t*)(cbase + 8192); bf16_t* kdF = (bf16_t*)(cbase + 24576); float* uS = (float*)(cbase + 32768);
    {
        float U[64];
#pragma unroll
        for (int i = 0; i < 64; ++i) U[i] = bf2f(vb[(size_t)i * 768 + c]);
#pragma unroll
        for (int i = 0; i < 64; ++i) {
            const float vi = U[i];
            float su = bts[i] * vi;
#pragma unroll
            for (int j0 = 0; j0 < i; j0 += 4) { const f32x4 a4 = *(const f32x4*)(Aw + i * 68 + j0);
#pragma unroll
                for (int jj = 0; jj < 4; ++jj) if (j0 + jj < i) su -= a4[jj] * U[j0 + jj]; }
            U[i] = su;
            uS[(((c >> 4) * 4 + (i >> 4)) * 64 + ((i >> 2) & 3) * 16 + (c & 15)) * 4 + (i & 3)] = su;
            asm volatile("" ::: "memory");
        }
    }
    {
        float W[64];
#pragma unroll
        for (int i = 0; i < 64; ++i) W[i] = bf2f(kb[(size_t)i * 768 + c]);
#pragma unroll
        for (int i = 0; i < 64; ++i) {
            const float ki = W[i];
            const float bi = bts[i], gi = gcs[i];
            float sw = bi * __expf(gi) * ki;
#pragma unroll
            for (int j0 = 0; j0 < i; j0 += 4) { const f32x4 a4 = *(const f32x4*)(Aw + i * 68 + j0);
#pragma unroll
                for (int jj = 0; jj < 4; ++jj) if (j0 + jj < i) sw -= a4[jj] * W[j0 + jj]; }
            W[i] = sw;
            kdF[fragidx(c, i)] = f2bf(ki * __expf(gl - gi));
            wF[fragidx(i, c)] = f2bf(sw);
            asm volatile("" ::: "memory");
        }
    }
}

__device__ void sdelta_item(const Args& a, const int l, const int it) {
    const int lane = tidx() & 63, h = it & 3, b = it >> 2;
    const float* S0 = inp(a, 2) + ((size_t)(l * 128 + b) * 4 + h) * 4096;
    const float* bg = (const float*)(wsp(a) + WS_BG); const bf16_t* qkvn = (const bf16_t*)outp(a); float* oraw = (float*)(wsp(a) + WS_ORAW);
    float S[64];
#pragma unroll
    for (int i = 0; i < 64; ++i) S[i] = S0[i * 64 + lane];
    for (int t = 0; t < 4; ++t) {
        const size_t r = (size_t)MP + 4 * b + t; const bf16_t* p = qkvn + r * 768 + h * 64 + lane;
        const float qv = bf2f(p[0]), kv = bf2f(p[256]), vv = bf2f(p[512]); const float beta = bg[r * 8 + h], eg = __expf(bg[r * 8 + 4 + h]);
        float rr = 0.f;
#pragma unroll
        for (int i = 0; i < 64; ++i) { S[i] *= eg; rr += rdlane(kv, i) * S[i]; }
        const float cc = beta * (vv - rr); float oo = 0.f;
#pragma unroll
        for (int i = 0; i < 64; ++i) { S[i] += rdlane(kv, i) * cc; oo += rdlane(qv, i) * S[i]; }
        oraw[r * 256 + h * 64 + lane] = oo;
    }
    float* So = outp(a) + O_SDS + ((size_t)(l * 128 + b) * 4 + h) * 4096;
#pragma unroll
    for (int i = 0; i < 64; ++i) So[i * 64 + lane] = S[i];
}

__device__ void sattn_item(const Args& a, const int l, const int it) {
    const int lane = tidx() & 63, hq = it & 3, b = it >> 2, kvh = hq >> 1;
    const float* ck = inp(a, 5) + (size_t)(l * 128 + b) * 16384 + kvh * 64; const float* cv = inp(a, 6) + (size_t)(l * 128 + b) * 16384 + kvh * 64;
    const bf16_t* qr = (const bf16_t*)(wsp(a) + WS_QR); const bf16_t* kvr = (const bf16_t*)(wsp(a) + WS_KVR); bf16_t* mix = (bf16_t*)(wsp(a) + WS_MIX);
    const size_t r0 = (size_t)MP + 4 * b;
    float qv[4];
#pragma unroll
    for (int i = 0; i < 4; ++i) qv[i] = bf2f(qr[(r0 + i) * 256 + hq * 64 + lane]);
    float s[3][4];
#pragma unroll
    for (int sl = 0; sl < 3; ++sl) {
        float acc0 = 0.f, acc1 = 0.f, acc2 = 0.f, acc3 = 0.f;
        if (sl < 2) { const float* kp = ck + (size_t)(sl * 64 + lane) * 128;
#pragma unroll
            for (int d4 = 0; d4 < 16; ++d4) { const f32x4 kx = *(const f32x4*)(kp + d4 * 4);
#pragma unroll
                for (int e = 0; e < 4; ++e) { const int d = d4 * 4 + e; acc0 += rdlane(qv[0], d) * kx[e]; acc1 += rdlane(qv[1], d) * kx[e]; acc2 += rdlane(qv[2], d) * kx[e]; acc3 += rdlane(qv[3], d) * kx[e]; } }
        } else { const bf16_t* kp = kvr + (r0 + (lane & 3)) * 256 + kvh * 64;
#pragma unroll
            for (int d4 = 0; d4 < 16; ++d4) { const f32x4 kx = ld4bf(kp + d4 * 4);
#pragma unroll
                for (int e = 0; e < 4; ++e) { const int d = d4 * 4 + e; acc0 += rdlane(qv[0], d) * kx[e]; acc1 += rdlane(qv[1], d) * kx[e]; acc2 += rdlane(qv[2], d) * kx[e]; acc3 += rdlane(qv[3], d) * kx[e]; } }
        }
        s[sl][0] = acc0; s[sl][1] = acc1; s[sl][2] = acc2; s[sl][3] = acc3;
    }
    const float sink = inp(a, 15)[l * 4 + hq];
    float inv[4];
#pragma unroll
    for (int i = 0; i < 4; ++i) {
        const bool v0 = lane > i, v1 = true, v2 = lane <= i && lane < 4;
        const float x0 = v0 ? s[0][i] * 0.125f : -1e30f, x1 = v1 ? s[1][i] * 0.125f : -1e30f, x2 = v2 ? s[2][i] * 0.125f : -1e30f;
        float mx = fmaxf(fmaxf(x0, x1), x2);
        for (int d = 1; d < 64; d <<= 1) mx = fmaxf(mx, __shfl_xor(mx, d));
        mx = fmaxf(mx, sink);
        const float p0 = v0 ? __expf(x0 - mx) : 0.f, p1 = __expf(x1 - mx), p2 = v2 ? __expf(x2 - mx) : 0.f;
        const float sum = wave_sum(p0 + p1 + p2) + __expf(sink - mx);
        s[0][i] = p0; s[1][i] = p1; s[2][i] = p2; inv[i] = 1.f / sum;
    }
    float o[4] = {0.f, 0.f, 0.f, 0.f};
#pragma unroll
    for (int sl = 0; sl < 2; ++sl)
#pragma unroll 1
        for (int j0 = 0; j0 < 64; j0 += 16) { float vv[16];
#pragma unroll
            for (int e = 0; e < 16; ++e) vv[e] = cv[(size_t)(sl * 64 + j0 + e) * 128 + lane];
#pragma unroll
            for (int e = 0; e < 16; ++e)
#pragma unroll
                for (int i = 0; i < 4; ++i) o[i] += rdlane(s[sl][i], j0 + e) * vv[e]; }
#pragma unroll
    for (int jj = 0; jj < 4; ++jj) { const float vv = bf2f(kvr[(r0 + jj) * 256 + 128 + kvh * 64 + lane]);
#pragma unroll
        for (int i = 0; i < 4; ++i) o[i] += rdlane(s[2][i], jj) * vv; }
#pragma unroll
    for (int i = 0; i < 4; ++i) mix[(r0 + i) * DM + 512 + hq * 64 + lane] = f2bf(o[i] * inv[i]);
}

__device__ void c_item(const Args& a, const int l, const int it, unsigned char* smem) {
    const int tid = tidx(), lane = tid & 63, w = tid >> 6, fr = lane & 15, fq = lane >> 4;
    const int qb = it & 63, kvh = (it >> 6) & 1, b = it >> 7;
    bf16_t* Ks = (bf16_t*)smem; bf16_t* Vt = Ks + 192 * 72;
    const bf16_t* kvr = (const bf16_t*)(wsp(a) + WS_KVR); const bf16_t* qr = (const bf16_t*)(wsp(a) + WS_QR); bf16_t* mix = (bf16_t*)(wsp(a) + WS_MIX);
    const int kp0 = 64 * qb - 128;
    for (int id = tid; id < 1536; id += 512) { const int row = id >> 3, c8 = id & 7, kp = kp0 + row; uint4 kq = {0u, 0u, 0u, 0u}, vq = {0u, 0u, 0u, 0u};
        if (kp >= 0) { const bf16_t* src = kvr + ((size_t)b * 4096 + kp) * 256 + kvh * 64 + c8 * 8; kq = *(const uint4*)src; vq = *(const uint4*)(src + 128); }
        *(uint4*)(Ks + row * 72 + c8 * 8) = kq; bf16_t* vd = Vt + (c8 * 8) * 200 + row;
        vd[0] = (bf16_t)(vq.x & 0xffffu); vd[200] = (bf16_t)(vq.x >> 16); vd[400] = (bf16_t)(vq.y & 0xffffu); vd[600] = (bf16_t)(vq.y >> 16);
        vd[800] = (bf16_t)(vq.z & 0xffffu); vd[1000] = (bf16_t)(vq.z >> 16); vd[1200] = (bf16_t)(vq.w & 0xffffu); vd[1400] = (bf16_t)(vq.w >> 16); }
    __syncthreads();
    const int hq = 2 * kvh + (w >> 2), wq = w & 3, qrow0 = 64 * qb + 16 * wq, kb = 16 * wq;
    const bf16_t* qp = qr + ((size_t)b * 4096 + qrow0 + fr) * 256 + hq * 64 + 8 * fq;
    const bf16x8 qf0 = *(const bf16x8*)qp, qf1 = *(const bf16x8*)(qp + 32);
    f32x4 s[9];
#pragma unroll
    for (int nn = 0; nn < 9; ++nn) { const bf16_t* kr = Ks + (kb + 16 * nn + fr) * 72 + 8 * fq; s[nn] = (f32x4){0.f, 0.f, 0.f, 0.f};
        s[nn] = MFMA16(*(const bf16x8*)kr, qf0, s[nn]); s[nn] = MFMA16(*(const bf16x8*)(kr + 32), qf1, s[nn]); }
    const int tq = qrow0 + fr; const float sink = inp(a, 15)[l * 4 + hq];
    float mx = sink;
#pragma unroll
    for (int nn = 0; nn < 9; ++nn)
#pragma unroll
        for (int jj = 0; jj < 4; ++jj) { const int tk = kp0 + kb + 16 * nn + 4 * fq + jj; const bool ok = tk >= 0 && tk <= tq && tk > tq - 128;
            const float v = ok ? s[nn][jj] * 0.125f : -1e30f; s[nn][jj] = v; mx = fmaxf(mx, v); }
    mx = fmaxf(mx, __shfl_xor(mx, 16)); mx = fmaxf(mx, __shfl_xor(mx, 32));
    float sum = 0.f;
#pragma unroll
    for (int nn = 0; nn < 9; ++nn)
#pragma unroll
        for (int jj = 0; jj < 4; ++jj) { const float p = s[nn][jj] > -1e29f ? __expf(s[nn][jj] - mx) : 0.f; s[nn][jj] = p; sum += p; }
    sum += __shfl_xor(sum, 16); sum += __shfl_xor(sum, 32); sum += __expf(sink - mx);
    bf16x8 pb[5];
#pragma unroll
    for (int kk = 0; kk < 4; ++kk) pb[kk] = pack8(s[2 * kk], s[2 * kk + 1]);
    pb[4] = pack8(s[8], (f32x4){0.f, 0.f, 0.f, 0.f});
    const float inv = 1.f / sum;
#pragma unroll
    for (int m = 0; m < 4; ++m) { f32x4 o = {0.f, 0.f, 0.f, 0.f};
#pragma unroll
        for (int kk = 0; kk < 5; ++kk) { const bf16_t* vp = Vt + (16 * m + fr) * 200 + kb + 32 * kk + 4 * fq;
            const bf16x4 lo = *(const bf16x4*)vp; bf16x4 hi = {0, 0, 0, 0}; if (kk < 4) hi = *(const bf16x4*)(vp + 16);
            const bf16x8 af = {lo[0], lo[1], lo[2], lo[3], hi[0], hi[1], hi[2], hi[3]};
            o = MFMA16(af, pb[kk], o); }
        st4bf(mix + ((size_t)b * 4096 + tq) * DM + 512 + hq * 64 + 16 * m + 4 * fq, o * inv); }
    __syncthreads();
}

__device__ void d_item(const Args& a, const int l, const int it, unsigned char* smem) {
    const int tid = tidx(), lane = tid & 63, w = tid >> 6, fr = lane & 15, fq = lane >> 4;
    const int g = it & 3, ch = (it >> 2) & 31, b = it >> 7;
    bf16_t* vT = (bf16_t*)smem;
    const bf16_t* dvn = (const bf16_t*)(wsp(a) + WS_DVN); const bf16_t* proj = (const bf16_t*)(wsp(a) + WS_PROJ); bf16_t* mix = (bf16_t*)(wsp(a) + WS_MIX);
    const size_t r0 = (size_t)b * 4096 + 128 * ch;
    for (int id = tid; id < 1024; id += 512) { const int row = id >> 3, c8 = id & 7; const uint4 vq = *(const uint4*)(dvn + (r0 + row) * 256 + g * 64 + c8 * 8); bf16_t* vd = vT + (c8 * 8) * 136 + row;
        vd[0] = (bf16_t)(vq.x & 0xffffu); vd[136] = (bf16_t)(vq.x >> 16); vd[272] = (bf16_t)(vq.y & 0xffffu); vd[408] = (bf16_t)(vq.y >> 16);
        vd[544] = (bf16_t)(vq.z & 0xffffu); vd[680] = (bf16_t)(vq.z >> 16); vd[816] = (bf16_t)(vq.w & 0xffffu); vd[952] = (bf16_t)(vq.w >> 16); }
    __syncthreads();
    const float* Wg = inp(a, 18) + ((size_t)(l * 4 + g) * 128) * 128;
    const int t = 16 * w + fr;
    f32x4 acc[4];
#pragma unroll
    for (int n = 0; n < 4; ++n) acc[n] = (f32x4){0.f, 0.f, 0.f, 0.f};
#pragma unroll
    for (int kk = 0; kk < 4; ++kk) if (kk <= (w >> 1)) {
        const float* wp = Wg + (size_t)t * 128 + 32 * kk + 8 * fq; f32x4 w0 = *(const f32x4*)wp, w1 = *(const f32x4*)(wp + 4);
#pragma unroll
        for (int e = 0; e < 4; ++e) { if (32 * kk + 8 * fq + e > t) w0[e] = 0.f; if (32 * kk + 8 * fq + 4 + e > t) w1[e] = 0.f; }
        const bf16x8 bfr = pack8(w0, w1);
#pragma unroll
        for (int n = 0; n < 4; ++n) acc[n] = MFMA16(*(const bf16x8*)(vT + (16 * n + fr) * 136 + 32 * kk + 8 * fq), bfr, acc[n]);
    }
    const float bias = inp(a, 19)[(size_t)(l * 4 + g) * 128 + t];
    const size_t r = r0 + t;
#pragma unroll
    for (int n = 0; n < 4; ++n) { const f32x4 du = gelu4(ld4bf(proj + r * PS + C_DU + g * 64 + 16 * n + 4 * fq)); st4bf(mix + r * DM + 768 + g * 64 + 16 * n + 4 * fq, du * (acc[n] + bias)); }
    __syncthreads();
}

__device__ void phase_chunk(const Args& a, const int l, unsigned char* smem) {
    const int wid = tidx() >> 6, gw = bidx() * 8 + wid, nw = gdim() * 8;
#ifndef CHMASK
#define CHMASK 15
#endif
#ifndef CHDUP
#define CHDUP 0
#endif
    if (CHDUP & 1) { if (l == 0) for (int it = gw; it < 2048; it += nw) a2_item(a, it, smem + wid * A2_LDS); }
    if (CHDUP & 2) { if (l == 0) for (int it = gw; it < 512; it += nw) sattn_item(a, l, it); }
    if (CHDUP & 4) { if (l == 0) { __syncthreads(); for (int it = bidx(); it < 1024; it += gdim()) c_item(a, l, it, smem); } }
    if (CHDUP & 8) { if (l == 0) { __syncthreads(); for (int it = bidx(); it < 1024; it += gdim()) d_item(a, l, it, smem); } }
    if (CHDUP) __syncthreads();
    if (CHMASK & 1) for (int it = gw; it < 2048; it += nw) a2_item(a, it, smem + wid * A2_LDS);
    if (CHMASK & 2) for (int it = gw; it < 512; it += nw) sattn_item(a, l, it);
    __syncthreads();
    if (CHMASK & 4) for (int it = bidx(); it < 1024; it += gdim()) c_item(a, l, it, smem);
    if (CHMASK & 8) for (int it = bidx(); it < 1024; it += gdim()) d_item(a, l, it, smem);
}

__device__ void phase_scan(const Args& a, const int l) {
    const int lane = tidx() & 63, wid = tidx() >> 6, fr = lane & 15, fq = lane >> 4;
    float* oraw = (float*)(wsp(a) + WS_ORAW);
    if (bidx() >= 32 || gdim() < 64) {
        const int nb = gdim() < 64 ? gdim() : gdim() - 32, bi = gdim() < 64 ? bidx() : bidx() - 32;
        for (int it = bi * 8 + wid; it < 512; it += nb * 8) sdelta_item(a, l, it);
        if (gdim() >= 64) return;
    }
    if (wid >= 4) return;
    for (int bh = bidx(); bh < 32; bh += gdim()) {
        const int b = bh >> 2, h = bh & 3, sl = wid;
        f32x4 S[4];
#pragma unroll
        for (int m = 0; m < 4; ++m) S[m] = (f32x4){0.f, 0.f, 0.f, 0.f};
        bf16x8 wf[4][2], qd[4][2], qk[4][2], kd[4][2]; f32x4 u[4]; float glv;
        const unsigned char* a2b = wsp(a) + WS_A2; const float* glsp = (const float*)(wsp(a) + WS_GLS);
#define SC_BASE(n_) (a2b + (size_t)((b * 64 + (n_)) * 4 + h) * 49152)
#define SC_LD_W(n_) do { const unsigned char* cb_ = SC_BASE(n_); _Pragma("unroll") for (int m = 0; m < 4; ++m) { _Pragma("unroll") for (int kk = 0; kk < 2; ++kk) wf[m][kk] = *(const bf16x8*)(cb_ + 8192 + (size_t)((m * 2 + kk) * 64 + lane) * 16); \
            u[m] = *(const f32x4*)(cb_ + 32768 + (size_t)((sl * 4 + m) * 64 + lane) * 16); } glv = glsp[(b * 64 + (n_)) * 4 + h]; } while (0)
#define SC_LD_Q(n_) do { const unsigned char* cb_ = SC_BASE(n_); _Pragma("unroll") for (int m = 0; m < 4; ++m) _Pragma("unroll") for (int kk = 0; kk < 2; ++kk) { const size_t o_ = (size_t)((m * 2 + kk) * 64 + lane) * 16; \
            qk[m][kk] = *(const bf16x8*)(cb_ + o_); qd[m][kk] = *(const bf16x8*)(cb_ + 16384 + o_); } } while (0)
#define SC_LD_K(n_) do { const unsigned char* cb_ = SC_BASE(n_); _Pragma("unroll") for (int m = 0; m < 4; ++m) _Pragma("unroll") for (int kk = 0; kk < 2; ++kk) kd[m][kk] = *(const bf16x8*)(cb_ + 24576 + (size_t)((m * 2 + kk) * 64 + lane) * 16); } while (0)
        SC_LD_W(0); SC_LD_Q(0); SC_LD_K(0);
#pragma unroll 1
        for (int n = 0; n < 64; ++n) {
            const int nn = n < 63 ? n + 1 : 63;
            const float egl = __expf(glv);
            bf16x8 Sb[2], Vb[2];
            Sb[0] = pack8(S[0], S[1]); Sb[1] = pack8(S[2], S[3]);
            f32x4 vn[4], O[4];
#pragma unroll
            for (int m = 0; m < 4; ++m) { f32x4 T = {0.f, 0.f, 0.f, 0.f}; T = MFMA16(wf[m][0], Sb[0], T); T = MFMA16(wf[m][1], Sb[1], T); vn[m] = u[m] - T; }
            SC_LD_W(nn);
            Vb[0] = pack8(vn[0], vn[1]); Vb[1] = pack8(vn[2], vn[3]);
#pragma unroll
            for (int m = 0; m < 4; ++m) { f32x4 o = {0.f, 0.f, 0.f, 0.f}; o = MFMA16(qd[m][0], Sb[0], o); o = MFMA16(qd[m][1], Sb[1], o); o = MFMA16(qk[m][0], Vb[0], o); o = MFMA16(qk[m][1], Vb[1], o); O[m] = o; }
            SC_LD_Q(nn);
#pragma unroll
            for (int m = 0; m < 4; ++m) { f32x4 s2 = S[m] * egl; s2 = MFMA16(kd[m][0], Vb[0], s2); s2 = MFMA16(kd[m][1], Vb[1], s2); S[m] = s2; }
            SC_LD_K(nn);
            const size_t t0 = (size_t)b * 4096 + n * 64;
#pragma unroll
            for (int m = 0; m < 4; ++m)
#pragma unroll
                for (int jj = 0; jj < 4; ++jj) oraw[(t0 + 16 * m + 4 * fq + jj) * 256 + h * 64 + 16 * sl + fr] = O[m][jj];
        }
#undef SC_BASE
#undef SC_LD_W
#undef SC_LD_Q
#undef SC_LD_K
        float* So = outp(a) + O_SDP + ((size_t)(l * 8 + b) * 4 + h) * 4096;
#pragma unroll
        for (int m = 0; m < 4; ++m)
#pragma unroll
            for (int jj = 0; jj < 4; ++jj) So[(16 * m + 4 * fq + jj) * 64 + 16 * sl + fr] = S[m][jj];
    }
}

__device__ void phase_aout(const Args& a, const int l) {
    const int lane = tidx() & 63, wid = tidx() >> 6, c4 = lane * 4;
    const float* oraw = (const float*)(wsp(a) + WS_ORAW); const bf16_t* proj = (const bf16_t*)(wsp(a) + WS_PROJ); bf16_t* mix = (bf16_t*)(wsp(a) + WS_MIX);
    const f32x4 g = *(const f32x4*)(inp(a, 13) + l * 64 + (c4 & 63));
    for (int r = bidx() * 8 + wid; r < M; r += gdim() * 8) {
        const f32x4 o = *(const f32x4*)(oraw + (size_t)r * 256 + c4);
        const float ss = red16(o[0] * o[0] + o[1] * o[1] + o[2] * o[2] + o[3] * o[3]);
        const f32x4 y = o * rsqrtf(ss * (1.f / 64.f) + EPS) * g;
        st4bf(mix + (size_t)r * DM + c4, y * silu4(ld4bf(proj + (size_t)r * PS + C_AZ + c4)));
    }
}

__device__ void phase_fix(const Args& a, const int l) {
    const float* sg = (const float*)(wsp(a) + WS_SG); const float* su = (const float*)(wsp(a) + WS_SU); bf16_t* act = (bf16_t*)(wsp(a) + WS_PROJ);
    const float* cw = inp(a, 24) + (size_t)l * 3 * FF;
    for (int idx = bidx() * 512 + tidx(); idx < 512 * 2 * 704; idx += gdim() * 512) {
        const int f = (idx % 704) * 4, q = (idx / 704) & 1, blk = idx / 1408; const bool prev = (blk & 63) != 0;
        const f32x4 z4 = {0.f, 0.f, 0.f, 0.f};
        const f32x4 g0 = *(const f32x4*)(sg + ((size_t)blk * 4 + q) * FF + f), up = *(const f32x4*)(su + ((size_t)blk * 2 + q) * FF + f);
        f32x4 gm2, gm1;
        if (q == 0) { gm2 = prev ? *(const f32x4*)(sg + ((size_t)(blk - 1) * 4 + 2) * FF + f) : z4; gm1 = prev ? *(const f32x4*)(sg + ((size_t)(blk - 1) * 4 + 3) * FF + f) : z4; }
        else { gm2 = prev ? *(const f32x4*)(sg + ((size_t)(blk - 1) * 4 + 3) * FF + f) : z4; gm1 = *(const f32x4*)(sg + ((size_t)blk * 4 + 0) * FF + f); }
        const f32x4 gc = *(const f32x4*)(cw + f) * gm2 + *(const f32x4*)(cw + FF + f) * gm1 + *(const f32x4*)(cw + 2 * FF + f) * g0;
        st4bf(act + ((size_t)blk * 64 + q) * FF + f, silu4(gc) * up);
    }
}

__device__ void phase_final(const Args& a) {
    const int lane = tidx() & 63, wid = tidx() >> 6;
    const float* ssq = (const float*)(wsp(a) + WS_SSQA); const float* g = inp(a, 26); const bf16_t* xb = (const bf16_t*)(wsp(a) + WS_XB);
    for (int r = bidx() * 8 + wid; r < M; r += gdim() * 8) {
        const float sc = rowscale(ssq, r); float* yr = outp(a) + (size_t)r * DM; const bf16_t* xr = xb + (size_t)r * DM;
#pragma unroll
        for (int q = 0; q < 4; ++q) { const int c = q * 256 + lane * 4; *(f32x4*)(yr + c) = ld4bf(xr + c) * sc * *(const f32x4*)(g + c); }
    }
}

constexpr int NPH = 20, LDS_BYTES = 147456;
__global__ void __launch_bounds__(512) fwd_kernel(Args a0) {
    extern __shared__ __attribute__((aligned(16))) unsigned char smem[];
    LAS unsigned char* lds = (LAS unsigned char*)smem;
#ifndef DUPMASK
#define DUPMASK 0
#endif
    int dup = 0;
#pragma unroll 1
    for (int ph = a0.ph_lo; ph < a0.ph_hi; ++ph) {
        if (ph > a0.ph_lo && a0.coop) cg::this_grid().sync();
        const Args& a = a0;
#ifndef PHMASK
#define PHMASK 0xFFFFF
#endif
        if (ph == 0) { if (PHMASK & 1) phase_prep(a, smem);
#ifdef DUP_PREP
            __syncthreads(); phase_prep(a, smem);
#endif
            continue; }
        if (ph == NPH - 1) { if (PHMASK & 2) phase_final(a); continue; }
        const int l = (ph - 1) / 9, sp = (ph - 1) % 9;
        pg8::StaticOrder S;
        if (!((PHMASK >> (2 + sp)) & 1)) continue;
        switch (sp) {
        case 0: { pg8::Gemm g{(const bf16_t*)(wsp(a) + WS_XB), (const bf16_t*)(wsp(a) + WS_WIN) + (size_t)l * NPAD * 1024, M, NPAD, 1024}; S.init(M, NPAD, gdim(), bidx());
            EpiProj E{(bf16_t*)(wsp(a) + WS_PROJ), (const float*)(wsp(a) + WS_SSQA)}; pg8::gemm_phase(lds, g, S, E); } break;
        case 1: phase_tok(a, l, smem); break;
        case 2: phase_chunk(a, l, smem); break;
        case 3: phase_scan(a, l); break;
        case 4: phase_aout(a, l); break;
        case 5: { pg8::Gemm g{(const bf16_t*)(wsp(a) + WS_MIX), (const bf16_t*)(wsp(a) + WS_WOUT) + (size_t)l * 1024 * 1024, M, 1024, 1024}; S.init(M, 1024, gdim(), bidx());
            EpiRes E{(bf16_t*)(wsp(a) + WS_XB), (float*)(wsp(a) + WS_SSQB)}; pg8::gemm_phase(lds, g, S, E); } break;
        case 6: { pg8::Gemm g{(const bf16_t*)(wsp(a) + WS_XB), (const bf16_t*)(wsp(a) + WS_WGU) + (size_t)l * 5632 * 1024, M, 5632, 1024}; S.init(M, 5632, gdim(), bidx());
            EpiGU E{(bf16_t*)(wsp(a) + WS_PROJ), (const float*)(wsp(a) + WS_SSQB), inp(a, 24) + (size_t)l * 3 * FF, inp(a, 7) + (size_t)l * 128 * 2 * FF, (float*)(wsp(a) + WS_SG), (float*)(wsp(a) + WS_SU),
                    outp(a) + O_SFP + (size_t)l * 8 * 2 * FF, outp(a) + O_SFS + (size_t)l * 128 * 2 * FF}; pg8::gemm_phase(lds, g, S, E); } break;
        case 7: phase_fix(a, l); break;
        default: { pg8::Gemm g{(const bf16_t*)(wsp(a) + WS_PROJ), (const bf16_t*)(wsp(a) + WS_WDN) + (size_t)l * 1024 * FF, M, 1024, FF}; S.init(M, 1024, gdim(), bidx());
            EpiRes E{(bf16_t*)(wsp(a) + WS_XB), (float*)(wsp(a) + WS_SSQA)}; pg8::gemm_phase(lds, g, S, E); } break;
        }
        if (DUPMASK && !dup && ph >= 1 && ph <= 9 && ((DUPMASK >> (ph - 1)) & 1)) { dup = 1; --ph; } else dup = 0;
    }
}

extern "C" void kernel_launch(void* const* d_in, const int* in_sizes, int n_in, void* d_out, int out_size, void* d_ws, size_t ws_size, hipStream_t stream) {
    static int grid = 0;
    if (grid == 0) {
        if (n_in != 27 || (size_t)out_size != O_END || ws_size < WS_END) { fprintf(stderr, "kernel_launch: unexpected sizes n_in %d out %d ws %zu (need %zu)\n", n_in, out_size, ws_size, (size_t)WS_END); grid = -1; return; }
        int dev = 0, cus = 0, per_cu = 0;
        hipGetDevice(&dev); hipDeviceGetAttribute(&cus, hipDeviceAttributeMultiprocessorCount, dev);
        if (hipFuncSetAttribute((const void*)fwd_kernel, hipFuncAttributeMaxDynamicSharedMemorySize, LDS_BYTES) != hipSuccess) { fprintf(stderr, "kernel_launch: hipFuncSetAttribute failed\n"); grid = -1; return; }
        hipOccupancyMaxActiveBlocksPerMultiprocessor(&per_cu, (const void*)fwd_kernel, 512, LDS_BYTES);
        (void)hipGetLastError();
        if (per_cu < 1) per_cu = 1;
        grid = cus * 1;
        if (grid <= 0) grid = 256;
    }
    if (grid < 0) return;
    Args a{};
    for (int i = 0; i < 27; ++i) a.in[i] = (const float*)d_in[i];
    a.out = (float*)d_out; a.ws = (unsigned char*)d_ws;
#if ONE_LAUNCH
    a.coop = 1; a.ph_lo = 0; a.ph_hi = NPH;
    void* args[] = {&a};
    hipError_t e = hipLaunchCooperativeKernel((const void*)fwd_kernel, dim3(grid), dim3(512), args, LDS_BYTES, stream);
    if (e != hipSuccess) fprintf(stderr, "cooperative launch failed: %s (grid %d)\n", hipGetErrorString(e), grid);
#else
    a.coop = 0;
    for (int ph = 0; ph < NPH; ++ph) { a.ph_lo = ph; a.ph_hi = ph + 1; hipLaunchKernelGGL(fwd_kernel, dim3(grid), dim3(512), LDS_BYTES, stream, a); }
#endif
}
```

```cpp
#include <hip/hip_runtime.h>
#include <hip/hip_cooperative_groups.h>
#include <cstdio>
namespace cg = cooperative_groups;

#define DEVI __device__ __forceinline__
#define LAS __attribute__((address_space(3)))
typedef unsigned short bf16_t;
typedef short bf16x8 __attribute__((ext_vector_type(8)));
typedef short bf16x4 __attribute__((ext_vector_type(4)));
typedef float f32x4 __attribute__((ext_vector_type(4)));

#ifndef ONE_LAUNCH
#define ONE_LAUNCH 1
#endif

constexpr int MP = 32768, MS = 512, M = MP + MS, DM = 1024, FF = 2816, PS = 2824  , NPAD = 3072;
constexpr int C_AQ = 0, C_AZ = 768, C_BB = 1024, C_BC = 1280, C_BH = 1536, C_CQ = 1792, C_CK = 2048, C_DU = 2304, C_DV = 2560, C_AB = 2816, C_AA = 2820;
constexpr float EPS = 1e-6f;

constexpr size_t O_YP = 0, O_YS = O_YP + (size_t)MP * DM, O_SDP = O_YS + (size_t)MS * DM, O_SDS = O_SDP + 2 * 8 * 4 * 4096, O_SCP = O_SDS + 2 * 128 * 4 * 4096,
                 O_SCS = O_SCP + 2 * 8 * 3 * 768, O_SSP = O_SCS + 2 * 128 * 3 * 768, O_SSS = O_SSP + 2 * 8 * 2 * 256, O_CKP = O_SSS + 2 * 128 * 2 * 256,
                 O_CKS = O_CKP + 2 * 8 * 128 * 128, O_CVP = O_CKS + 2 * 128 * 128 * 128, O_CVS = O_CVP + 2 * 8 * 128 * 128, O_SFP = O_CVS + 2 * 128 * 128 * 128,
                 O_SFS = O_SFP + 2 * 8 * 2 * 2816, O_CHV = O_SFS + 2 * 128 * 2 * 2816, O_END = O_CHV + 2 * 128 * 4 * 256;
static_assert(O_END == 50008064, "output size");

constexpr size_t WS_WIN = 0, WS_WOUT = WS_WIN + (size_t)2 * NPAD * 1024 * 2, WS_WGU = WS_WOUT + (size_t)2 * 1024 * 1024 * 2, WS_WDN = WS_WGU + (size_t)2 * 5632 * 1024 * 2,
                 WS_XB = WS_WDN + (size_t)2 * 1024 * 2816 * 2,
                 WS_PROJ = WS_XB + (size_t)M * 1024 * 2,
                 WS_MIX = WS_PROJ + (size_t)M * PS * 2,
                 WS_SSQA = WS_MIX + (size_t)M * 1024 * 2, WS_SSQB = WS_SSQA + (size_t)M * 16 * 4, WS_BG = WS_SSQB + (size_t)M * 16 * 4,
                 WS_GLS = WS_BG + (size_t)M * 8 * 4,
                 WS_BAR = WS_GLS + 2048 * 4,
                 WS_ROPE = WS_BAR + 16384,
                 WS_QR = WS_ROPE + (size_t)4100 * 16 * 4 + 64,
                 WS_KVR = WS_QR + (size_t)M * 256 * 2, WS_DVN = WS_KVR + (size_t)M * 256 * 2, WS_ORAW = WS_QR,
                 WS_A2 = WS_DVN + (size_t)M * 256 * 2,
                 WS_SG = WS_A2, WS_SU = WS_SG + (size_t)512 * 4 * 2816 * 4,
                 WS_SACC = WS_SU + (size_t)512 * 2 * 2816 * 4,
                 WS_END = WS_A2 + (size_t)2048 * 49152;
static_assert(WS_SACC + (size_t)11 * MS * DM * 4 <= WS_END && WS_SACC + (size_t)4 * MS * 5632 * 4 <= WS_END, "split-K partials");
static_assert(WS_END <= (size_t)536870912, "workspace too large");
static_assert(WS_SU + (size_t)512 * 2 * 2816 * 4 <= WS_END, "side buffers");
static_assert((size_t)M * 256 * 4 <= (size_t)3 * M * 256 * 2, "oraw alias");

constexpr size_t OUT_ORAW = (size_t)M * 768 * 2;
static_assert(OUT_ORAW + (size_t)M * 256 * 4 <= (size_t)MP * DM * 4, "scratch in y region");
struct Args { const float* in[27]; float* out; unsigned char* ws; int coop; int ph_lo; int ph_hi; int pad; };

DEVI int tidx() { int t = threadIdx.x; asm volatile("" : "+v"(t)); return t; }
DEVI int bidx() { int t = blockIdx.x; asm volatile("" : "+s"(t)); return t; }
DEVI int gdim() { int t = gridDim.x; asm volatile("" : "+s"(t)); return t; }
DEVI float bf2f(bf16_t v) { return __uint_as_float(((unsigned)v) << 16); }
DEVI bf16_t f2bf(float f) { unsigned u = __float_as_uint(f); u += 0x7FFFu + ((u >> 16) & 1u); return (bf16_t)(u >> 16); }
DEVI unsigned pk2(float lo, float hi) { unsigned r; asm("v_cvt_pk_bf16_f32 %0, %1, %2" : "=v"(r) : "v"(lo), "v"(hi)); return r; }
DEVI f32x4 ld4bf(const bf16_t* p) { const uint2 u = *(const uint2*)p; f32x4 o; o[0] = __uint_as_float(u.x << 16); o[1] = __uint_as_float(u.x & 0xffff0000u); o[2] = __uint_as_float(u.y << 16); o[3] = __uint_as_float(u.y & 0xffff0000u); return o; }
DEVI f32x4 cv4bf(const uint2 u) { f32x4 o; o[0] = __uint_as_float(u.x << 16); o[1] = __uint_as_float(u.x & 0xffff0000u); o[2] = __uint_as_float(u.y << 16); o[3] = __uint_as_float(u.y & 0xffff0000u); return o; }
DEVI void st4bf(bf16_t* p, f32x4 v) { uint2 u; u.x = pk2(v[0], v[1]); u.y = pk2(v[2], v[3]); *(uint2*)p = u; }
DEVI bf16x8 pack8(f32x4 a, f32x4 b) { union { uint4 u; bf16x8 v; } x; x.u.x = pk2(a[0], a[1]); x.u.y = pk2(a[2], a[3]); x.u.z = pk2(b[0], b[1]); x.u.w = pk2(b[2], b[3]); return x.v; }
typedef unsigned u32x4 __attribute__((ext_vector_type(4)));
DEVI u32x4 pack8e(f32x4 a, f32x4 b) { u32x4 u; u[0] = pk2(a[0], a[1]); u[1] = pk2(a[2], a[3]); u[2] = pk2(b[0], b[1]); u[3] = pk2(b[2], b[3]); return u; }
DEVI uint4 pack8u(f32x4 a, f32x4 b) { uint4 u; u.x = pk2(a[0], a[1]); u.y = pk2(a[2], a[3]); u.z = pk2(b[0], b[1]); u.w = pk2(b[2], b[3]); return u; }

DEVI float silu_f(float y) { return y * __builtin_amdgcn_rcpf(1.f + __expf(-y)); }
DEVI float gelu_f(float x) { const float z = 0.7978845608028654f * (x + 0.044715f * x * x * x); return x * __builtin_amdgcn_rcpf(1.f + __expf(-2.f * z)); }
DEVI f32x4 silu4(f32x4 v) { f32x4 o; for (int i = 0; i < 4; ++i) o[i] = silu_f(v[i]); return o; }
DEVI f32x4 gelu4(f32x4 v) { f32x4 o; for (int i = 0; i < 4; ++i) o[i] = gelu_f(v[i]); return o; }
DEVI float rdlane(float v, int l) { return __builtin_bit_cast(float, __builtin_amdgcn_readlane(__builtin_bit_cast(int, v), l)); }
DEVI void wave_lds_fence() { asm volatile("s_waitcnt lgkmcnt(0)" ::: "memory"); }
template <int CTRL> DEVI float dppf(float x) { return __builtin_bit_cast(float, __builtin_amdgcn_update_dpp(0, __builtin_bit_cast(int, x), CTRL, 0xf, 0xf, true)); }
template <int CTRL> DEVI float dppo(float old, float x) { return __builtin_bit_cast(float, __builtin_amdgcn_update_dpp(__builtin_bit_cast(int, old), __builtin_bit_cast(int, x), CTRL, 0xf, 0xf, false)); }
DEVI float red16(float v) { v += dppf<0x121>(v); v += dppf<0x122>(v); v += dppf<0x124>(v); v += dppf<0x128>(v); return v; }
DEVI float wave_sum(float v) { v = red16(v); v += __shfl_xor(v, 16); v += __shfl_xor(v, 32); return v; }
DEVI float rowscale(const float* ssq, int r) { const f32x4* p = (const f32x4*)(ssq + (size_t)r * 16); const f32x4 a = p[0], b = p[1], c = p[2], d = p[3];
    const float s = (a[0] + a[1] + a[2] + a[3]) + (b[0] + b[1] + b[2] + b[3]) + (c[0] + c[1] + c[2] + c[3]) + (d[0] + d[1] + d[2] + d[3]); return rsqrtf(s * (1.f / 1024.f) + EPS); }
#define GLB __attribute__((address_space(1)))
typedef const __attribute__((address_space(4))) Args* KArgs;
DEVI KArgs kargs() { KArgs p = (KArgs)__builtin_amdgcn_kernarg_segment_ptr(); asm volatile("" : "+s"(p)); return p; }
DEVI unsigned char* wsp(const Args&) { return (unsigned char*)(GLB unsigned char*)kargs()->ws; }
DEVI float* outp(const Args&) { return (float*)(GLB float*)kargs()->out; }
DEVI const float* inp(const Args&, int k) { return (const float*)(GLB const float*)kargs()->in[k]; }
#define MFMA16(a, b, c) __builtin_amdgcn_mfma_f32_16x16x32_bf16((a), (b), (c), 0, 0, 0)

namespace pg8 {
constexpr int BM = 256, BK = 64, HALF = 128, HTB = HALF * BK * 2, STAGE_BYTES = 8 * HTB, NXCD = 8, WGM = 8;
DEVI int lds_byte(int r, int c) { const int st = (r >> 4) * 2 + (c >> 5), rr = r & 15, cc = c & 31, ob = rr * 64 + cc * 2; return st * 1024 + (ob ^ (((ob >> 9) & 1) << 5)); }
DEVI void stage_rc(int b, int& R, int& C) { const int st = b / 1024, sb = b % 1024, swz = sb ^ (((sb >> 9) & 1) << 5); R = (st >> 1) * 16 + swz / 64; C = (st & 1) * 32 + (swz % 64) / 2; }
DEVI int perm32(int rho) { const int n = rho >> 4, i = rho & 15; return 8 * (i >> 2) + 4 * n + (i & 3); }
struct Unit { int pm, pn, k0, nt; };
struct Gemm { const bf16_t* A; const bf16_t* Bt; int M, N, K; };
struct StaticOrder {
    int nM, nN, nwg, G, c, ntf;
    DEVI void init(int M_, int N_, int K_, int G_, int c_) { nM = M_ / BM; nN = N_ / BM; nwg = nM * nN; G = G_; c = c_; ntf = K_ / BK; }
    DEVI bool next(int i, Unit& u) const {
        const long L = (long)i * G + c; if (L >= nwg) return false;
        int wgid = (int)L; { const int q = nwg / NXCD, r = nwg % NXCD, xcd = wgid % NXCD, off = wgid / NXCD; wgid = (xcd < r ? xcd * (q + 1) : r * (q + 1) + (xcd - r) * q) + off; }
        const int nig = WGM * nN, gid = wgid / nig, fm = gid * WGM, gsz = (nM - fm) < WGM ? (nM - fm) : WGM;
        u.pm = fm + ((wgid % nig) % gsz); u.pn = (wgid % nig) / gsz; u.k0 = 0; u.nt = ntf; return true;
    }
    DEVI void a_ready(const Unit&) const {}
    DEVI void done(const Unit&) const {}
};
struct SplitOrder : StaticOrder {
    int nks;
    DEVI bool next(int i, Unit& u) const {
        if (StaticOrder::next(i, u)) return true;
        const long j = (long)i * G + c - nwg; if (j >= 2L * nN * nks) return false;
        const int un = (int)j / nks, ks = (int)j % nks; u.pm = nM + un / nN; u.pn = un % nN; u.k0 = ks * 256; u.nt = 4; return true;
    }
};
template <class Epi, class Sched>
DEVI void gemm_phase(LAS unsigned char* lds, const Gemm g, const Sched& S, const Epi& E) {
    const int tid = tidx(), wid = __builtin_amdgcn_readfirstlane(tid >> 6), lane = tid & 63, wr = wid >> 2, wc = wid & 3, fr = lane & 15, fq = lane >> 4;
    const int K = g.K;
    unsigned voffA[2], voffB[2];
#pragma unroll
    for (int i = 0; i < 2; ++i) { int R, C; stage_rc(tid * 16 + i * 8192, R, C); const int Rb = Epi::PERM ? ((R & ~31) + perm32(R & 31)) : R;
        voffA[i] = (unsigned)(R * K + C) * 2u; voffB[i] = (unsigned)(Rb * K + C) * 2u; }
    const size_t kstep = (size_t)(BK * 2);
    const size_t hstep = (size_t)HALF * K * 2;
    const size_t tstep = 2 * hstep;
    const unsigned ldsw = (unsigned)wid * 1024u;
    const int aoff = lds_byte(wr * 64 + fr, fq * 8), boff = lds_byte(wc * 32 + fr, fq * 8);
#define PG8_SA(b, h) (((b) * 2 + (h)) * HTB)
#define PG8_SB(b, h) ((4 + (b) * 2 + (h)) * HTB)
#define PG8_STAGE(bufoff, gbase, voff) do { _Pragma("unroll") for (int _i = 0; _i < 2; ++_i) \
        __builtin_amdgcn_global_load_lds((const unsigned*)((const char*)(gbase) + (voff)[_i]), (LAS unsigned*)(lds + (bufoff) + ldsw + _i * 8192), 16, 0, 0); } while (0)
#define PG8_LDA(dst, b, h) do { _Pragma("unroll") for (int m = 0; m < 4; ++m) _Pragma("unroll") for (int k = 0; k < 2; ++k) dst[m][k] = *(const LAS bf16x8*)(lds + PG8_SA(b, h) + aoff + m * 2048 + k * 1024); } while (0)
#define PG8_LDB(dst, b, h) do { _Pragma("unroll") for (int n = 0; n < 2; ++n) _Pragma("unroll") for (int k = 0; k < 2; ++k) dst[n][k] = *(const LAS bf16x8*)(lds + PG8_SB(b, h) + boff + n * 2048 + k * 1024); } while (0)
#define PG8_MMA(ai, bj, At, Bt) do { __builtin_amdgcn_s_setprio(1); _Pragma("unroll") for (int m = 0; m < 4; ++m) _Pragma("unroll") for (int n = 0; n < 2; ++n) _Pragma("unroll") for (int k = 0; k < 2; ++k) \
        acc[ai][bj][m][n] = __builtin_amdgcn_mfma_f32_16x16x32_bf16(Bt[n][k], At[m][k], acc[ai][bj][m][n], 0, 0, 0); __builtin_amdgcn_s_setprio(0); } while (0)
#define PG8_WAIT_V(n) asm volatile("s_waitcnt vmcnt(" #n ")" ::: "memory")
#define PG8_WAIT_L(n) asm volatile("s_waitcnt lgkmcnt(" #n ")" ::: "memory")
#define PG8_BAR __builtin_amdgcn_s_barrier()
#define PG8_SCHED __builtin_amdgcn_sched_barrier(0)
    Unit cur, nxt; int ui = 0;
    if (!S.next(0, cur)) return;
#ifndef STAG_TICKS
#define STAG_TICKS 0
#endif
    if (STAG_TICKS) {
        const unsigned long long t0 = __builtin_amdgcn_s_memrealtime(), dl = (unsigned long long)((S.c >> 3) & 7) * STAG_TICKS;
        while (__builtin_amdgcn_s_memrealtime() - t0 < dl) __builtin_amdgcn_s_sleep(8);
    }
    f32x4 acc[2][2][4][2];
#pragma unroll
    for (int a = 0; a < 2; ++a)
#pragma unroll
        for (int b = 0; b < 2; ++b)
#pragma unroll
            for (int m = 0; m < 4; ++m)
#pragma unroll
                for (int n = 0; n < 2; ++n) acc[a][b][m][n] = (f32x4){0.f, 0.f, 0.f, 0.f};
    bf16x8 At[4][2], B0[2][2], B1[2][2];
    const char* cA = (const char*)g.A + (size_t)cur.pm * tstep + (size_t)cur.k0 * 2; const char* cB = (const char*)g.Bt + (size_t)cur.pn * tstep + (size_t)cur.k0 * 2;
    S.a_ready(cur);
    PG8_STAGE(PG8_SB(0, 0), cB, voffB); PG8_STAGE(PG8_SA(0, 0), cA, voffA); PG8_STAGE(PG8_SB(0, 1), cB + hstep, voffB); PG8_STAGE(PG8_SA(0, 1), cA + hstep, voffA);
    if (wr == 1) PG8_BAR;
    PG8_WAIT_V(4); PG8_BAR;
    PG8_STAGE(PG8_SB(1, 0), cB + kstep, voffB); PG8_STAGE(PG8_SA(1, 0), cA + kstep, voffA); PG8_STAGE(PG8_SB(1, 1), cB + hstep + kstep, voffB);
    PG8_WAIT_V(6); PG8_BAR;
    for (;;) {
        const bool has_next = S.next(ui + 1, nxt);
        const char* nA = has_next ? (const char*)g.A + (size_t)nxt.pm * tstep + (size_t)nxt.k0 * 2 : cA; const char* nB = has_next ? (const char*)g.Bt + (size_t)nxt.pn * tstep + (size_t)nxt.k0 * 2 : cB;
        const int nt = cur.nt;
        for (int t = 0; t < nt; t += 2) {
            const bool last = (t == nt - 2);
            const char* a1 = cA + (size_t)(t + 1) * kstep;
            const char* a2 = last ? nA : cA + (size_t)(t + 2) * kstep; const char* b2 = last ? nB : cB + (size_t)(t + 2) * kstep;
            const char* a3 = a2 + kstep; const char* b3 = b2 + kstep;
            if (last && has_next) S.a_ready(nxt);
            PG8_LDB(B0, 0, 0); PG8_SCHED; PG8_LDA(At, 0, 0); PG8_STAGE(PG8_SA(1, 1), a1 + hstep, voffA);
            PG8_WAIT_L(8); PG8_BAR; PG8_WAIT_L(0); PG8_MMA(0, 0, At, B0); PG8_BAR; PG8_SCHED;
            PG8_LDB(B1, 0, 1); PG8_STAGE(PG8_SB(0, 0), b2, voffB);
            PG8_BAR; PG8_WAIT_L(0); PG8_MMA(0, 1, At, B1); PG8_BAR;
            PG8_LDA(At, 0, 1); PG8_STAGE(PG8_SA(0, 0), a2, voffA);
            PG8_BAR; PG8_WAIT_L(0); PG8_MMA(1, 0, At, B0); PG8_BAR; PG8_SCHED;
            PG8_STAGE(PG8_SB(0, 1), b2 + hstep, voffB);
            PG8_WAIT_V(6); PG8_BAR; PG8_MMA(1, 1, At, B1); PG8_BAR;
            PG8_LDB(B0, 1, 0); PG8_SCHED; PG8_LDA(At, 1, 0); PG8_STAGE(PG8_SA(0, 1), a2 + hstep, voffA);
            PG8_WAIT_L(8); PG8_BAR; PG8_WAIT_L(0); PG8_MMA(0, 0, At, B0); PG8_BAR; PG8_SCHED;
            PG8_LDB(B1, 1, 1); PG8_STAGE(PG8_SB(1, 0), b3, voffB);
            PG8_BAR; PG8_WAIT_L(0); PG8_MMA(0, 1, At, B1); PG8_BAR;
            PG8_LDA(At, 1, 1); PG8_STAGE(PG8_SA(1, 0), a3, voffA);
            PG8_BAR; PG8_WAIT_L(0); PG8_MMA(1, 0, At, B0); PG8_BAR; PG8_SCHED;
            PG8_STAGE(PG8_SB(1, 1), b3 + hstep, voffB);
            PG8_WAIT_V(6); PG8_BAR; PG8_MMA(1, 1, At, B1); PG8_BAR;
        }
        E(acc, cur, wr, wc, fr, fq); S.done(cur);
#ifdef EPI_TWICE
        if (Epi::TWICE) E(acc, cur, wr, wc, fr, fq);
#endif
        if (!has_next) break;
#pragma unroll
        for (int a = 0; a < 2; ++a)
#pragma unroll
            for (int b = 0; b < 2; ++b)
#pragma unroll
                for (int m = 0; m < 4; ++m)
#pragma unroll
                    for (int n = 0; n < 2; ++n) acc[a][b][m][n] = (f32x4){0.f, 0.f, 0.f, 0.f};
        cur = nxt; cA = nA; cB = nB; ++ui;
    }
    PG8_WAIT_V(0);
    if (wr == 0) PG8_BAR;
    PG8_BAR;
#undef PG8_SA
#undef PG8_SB
#undef PG8_STAGE
#undef PG8_LDA
#undef PG8_LDB
#undef PG8_MMA
#undef PG8_WAIT_V
#undef PG8_WAIT_L
#undef PG8_BAR
#undef PG8_SCHED
}
}
using pg8::Unit;

struct EpiProj {
    static constexpr bool PERM = true, TWICE = true;
    bf16_t* P; const float* ssq;
    DEVI void operator()(const f32x4 (&acc)[2][2][4][2], const Unit& u, int wr, int wc, int fr, int fq) const {
        const int row0 = u.pm * 256 + wr * 64 + fr, colb = u.pn * 256 + wc * 32 + 8 * fq;
#pragma unroll
        for (int ai = 0; ai < 2; ++ai)
#pragma unroll
            for (int m = 0; m < 4; ++m) { const int r = row0 + ai * 128 + m * 16; const float sc = rowscale(ssq, r);
#pragma unroll
                for (int bj = 0; bj < 2; ++bj) { const int c = colb + bj * 128;
                    if (c < PS) *(uint4*)(P + (size_t)r * PS + c) = pack8u(acc[ai][bj][m][0] * sc, acc[ai][bj][m][1] * sc); } }
    }
};
struct EpiRes {
    static constexpr bool PERM = true, TWICE = false;
    bf16_t* xb; float* ssq; float* sacc;
    DEVI void operator()(const f32x4 (&acc)[2][2][4][2], const Unit& u, int wr, int wc, int fr, int fq) const {
        const int row0 = u.pm * 256 + wr * 64 + fr, colb = u.pn * 256 + wc * 32 + 8 * fq;
        if (sacc != nullptr && u.pm >= 128) {
#pragma unroll
            for (int ai = 0; ai < 2; ++ai)
#pragma unroll
                for (int m = 0; m < 4; ++m) { float* dp = sacc + (size_t)(u.k0 >> 8) * ((size_t)MS * DM) + (size_t)(row0 + ai * 128 + m * 16 - MP) * DM + colb;
#pragma unroll
                    for (int bj = 0; bj < 2; ++bj) { *(f32x4*)(dp + bj * 128) = acc[ai][bj][m][0]; *(f32x4*)(dp + bj * 128 + 4) = acc[ai][bj][m][1]; } }
            return;
        }
#pragma unroll
        for (int ai = 0; ai < 2; ++ai)
#pragma unroll
            for (int m = 0; m < 4; ++m) { const int r = row0 + ai * 128 + m * 16; float part = 0.f;
#pragma unroll
                for (int bj = 0; bj < 2; ++bj) { const int c = colb + bj * 128; bf16_t* xp = xb + (size_t)r * DM + c;
                    const uint4 rv = *(const uint4*)xp;
                    const f32x4 v0 = acc[ai][bj][m][0] + cv4bf((uint2){rv.x, rv.y}), v1 = acc[ai][bj][m][1] + cv4bf((uint2){rv.z, rv.w});
                    *(uint4*)xp = pack8u(v0, v1);
                    part += v0[0] * v0[0] + v0[1] * v0[1] + v0[2] * v0[2] + v0[3] * v0[3] + v1[0] * v1[0] + v1[1] * v1[1] + v1[2] * v1[2] + v1[3] * v1[3]; }
                part += __shfl_xor(part, 16); part += __shfl_xor(part, 32);
                if (fq == 0) ssq[(size_t)r * 16 + u.pn * 4 + wc] = part; }
    }
};
struct EpiGU {
    static constexpr bool PERM = true, TWICE = false;
    bf16_t* act; const float* ssq; const float* cw; float* sg; float* su; float* osfp; float* sacc;
    DEVI void operator()(const f32x4 (&acc)[2][2][4][2], const Unit& u, int wr, int wc, int fr, int fq) const {
        if (u.pm >= 128) {
            const int row0 = u.pm * 256 + wr * 64 + fr - MP, colb = u.pn * 256 + wc * 32 + 8 * fq;
#pragma unroll
            for (int ai = 0; ai < 2; ++ai)
#pragma unroll
                for (int m = 0; m < 4; ++m) { float* dp = sacc + (size_t)(u.k0 >> 8) * ((size_t)MS * 5632) + (size_t)(row0 + ai * 128 + m * 16) * 5632 + colb;
#pragma unroll
                    for (int bj = 0; bj < 2; ++bj) { *(f32x4*)(dp + bj * 128) = acc[ai][bj][m][0]; *(f32x4*)(dp + bj * 128 + 4) = acc[ai][bj][m][1]; } }
            return;
        }
        const int f0 = u.pn * 128 + wc * 32 + 8 * fq;
        const f32x4 w0a = *(const f32x4*)(cw + f0), w0b = *(const f32x4*)(cw + f0 + 4), w1a = *(const f32x4*)(cw + FF + f0), w1b = *(const f32x4*)(cw + FF + f0 + 4),
                    w2a = *(const f32x4*)(cw + 2 * FF + f0), w2b = *(const f32x4*)(cw + 2 * FF + f0 + 4);
#pragma unroll
        for (int ai = 0; ai < 2; ++ai) {
            const int rb = u.pm * 256 + ai * 128 + wr * 64;
            f32x4 pva = {0.f, 0.f, 0.f, 0.f}, pvb = {0.f, 0.f, 0.f, 0.f};
#pragma unroll
            for (int m = 0; m < 4; ++m) {
                const int r = rb + 16 * m + fr;
                const float scm = rowscale(ssq, r);
                const f32x4 ga0 = acc[ai][0][m][0] * scm, gb0 = acc[ai][0][m][1] * scm;
                const f32x4 ua = acc[ai][1][m][0] * scm, ub = acc[ai][1][m][1] * scm;
                f32x4 p1a, p1b, p2a, p2b;
#pragma unroll
                for (int jj = 0; jj < 4; ++jj) {
                    const float ca = ga0[jj], cb = gb0[jj], pa = pva[jj], pb = pvb[jj];
                    p1a[jj] = dppo<0x111>(dppf<0x10F>(pa), ca); p2a[jj] = dppo<0x112>(dppf<0x10E>(pa), ca);
                    p1b[jj] = dppo<0x111>(dppf<0x10F>(pb), cb); p2b[jj] = dppo<0x112>(dppf<0x10E>(pb), cb);
                }
                const bool head = m == 0 && fr < 2;
                if (!head) {
                    const f32x4 ga = w0a * p2a + w1a * p1a + w2a * ga0, gb = w0b * p2b + w1b * p1b + w2b * gb0;
                    *(uint4*)(act + (size_t)r * FF + f0) = pack8u(silu4(ga) * ua, silu4(gb) * ub);
                }
                const int blk = rb >> 6;
                if (m == 0 && fr < 2) { float* o = sg + ((size_t)blk * 4 + fr) * FF + f0; *(f32x4*)o = ga0; *(f32x4*)(o + 4) = gb0;
                    float* o2 = su + ((size_t)blk * 2 + fr) * FF + f0; *(f32x4*)o2 = ua; *(f32x4*)(o2 + 4) = ub; }
                if (m == 3 && fr >= 14) { float* o = sg + ((size_t)blk * 4 + 2 + (fr - 14)) * FF + f0; *(f32x4*)o = ga0; *(f32x4*)(o + 4) = gb0;
                    const int t = r & 4095; if (t >= 4094) { float* o3 = osfp + ((size_t)(r >> 12) * 2 + (t - 4094)) * FF + f0; *(f32x4*)o3 = ga0; *(f32x4*)(o3 + 4) = gb0; } }
                pva = ga0; pvb = gb0;
            }
        }
    }
};

__device__ void phase_prep(const Args& a, unsigned char* smem) {
    float* tile = (float*)smem;
    const int tid = tidx(), tx = tid & 63, ty = tid >> 6, lane = tid & 63, wid = tid >> 6;
    constexpr int T_IN = 48 * 4, T_OUT = 16 * 4, T_GU = 88 * 4, T_DN = 16 * 11, T_L = T_IN + T_OUT + T_GU + T_DN;
    for (int it = bidx(); it < 2 * T_L; it += gdim()) {
        const int l = it / T_L; int r = it % T_L;
        const float* src; int ld, col, kt, nt, Kd; const float* gk = nullptr; bf16_t* dst;
        if (r < T_IN) { nt = r / 4; kt = r % 4; Kd = 1024; ld = PS; src = inp(a, 9) + (size_t)l * 1024 * PS; gk = inp(a, 8) + l * 1024; dst = (bf16_t*)(wsp(a) + WS_WIN) + (size_t)l * NPAD * 1024;
            const int n = nt * 64 + tx; col = n < 1024 ? n : (n < 2816 ? n + 8 : (n < 2824 ? 1024 + (n - 2816) : -1)); }
        else if ((r -= T_IN) < T_OUT) { nt = r / 4; kt = r % 4; Kd = 1024; ld = 1024; src = inp(a, 20) + (size_t)l * 1024 * 1024; dst = (bf16_t*)(wsp(a) + WS_WOUT) + (size_t)l * 1024 * 1024; col = nt * 64 + tx; }
        else if ((r -= T_OUT) < T_GU) { nt = r / 4; kt = r % 4; Kd = 1024; ld = FF; gk = inp(a, 21) + l * 1024; dst = (bf16_t*)(wsp(a) + WS_WGU) + (size_t)l * 5632 * 1024;
            const int n = nt * 64, pn = n >> 8, cc = n & 255; src = (cc < 128 ? inp(a, 22) : inp(a, 23)) + (size_t)l * 1024 * FF; col = pn * 128 + (cc & 127) + tx; }
        else { r -= T_GU; nt = r / 11; kt = r % 11; Kd = FF; ld = 1024; src = inp(a, 25) + (size_t)l * FF * 1024; dst = (bf16_t*)(wsp(a) + WS_WDN) + (size_t)l * 1024 * FF; col = nt * 64 + tx; }
        float v[32];
#pragma unroll
        for (int i = 0; i < 32; ++i) { const int k = kt * 256 + ty + 8 * i; v[i] = col >= 0 ? __builtin_nontemporal_load(src + (size_t)k * ld + col) : 0.f; }
        if (gk) {
#pragma unroll
            for (int i = 0; i < 32; ++i) v[i] *= gk[kt * 256 + ty + 8 * i]; }
#pragma unroll
        for (int i = 0; i < 32; ++i) tile[(ty + 8 * i) * 65 + tx] = v[i];
        __syncthreads();
#pragma unroll
        for (int i = 0; i < 8; ++i) { const int n = wid * 8 + i; const int k0 = lane * 4;
            f32x4 o = {tile[(k0 + 0) * 65 + n], tile[(k0 + 1) * 65 + n], tile[(k0 + 2) * 65 + n], tile[(k0 + 3) * 65 + n]};
            st4bf(dst + (size_t)(nt * 64 + n) * Kd + kt * 256 + k0, o); }
        __syncthreads();
    }
    {   float* rt = (float*)(wsp(a) + WS_ROPE);
        for (int i = bidx() * 512 + tid; i < 4100 * 8; i += gdim() * 512) { const int pi = i >> 3, fi = i & 7, pos = pi < 4096 ? pi : 16384 + (pi - 4096);
            const float ang = (float)pos * powf(500000.f, -(float)fi * 0.125f); const double rd = (double)ang * 0.15915494309189535; const float rr = (float)((rd - floor(rd)) * 6.283185307179586);
            rt[pi * 16 + fi] = __cosf(rr); rt[pi * 16 + 8 + fi] = __sinf(rr); } }
    bf16_t* xb = (bf16_t*)(wsp(a) + WS_XB); float* ssq = (float*)(wsp(a) + WS_SSQA);
    for (int r = bidx() * 8 + wid; r < M; r += gdim() * 8) {
        const float* xr = (r < MP) ? inp(a, 0) + (size_t)r * DM : inp(a, 1) + (size_t)(r - MP) * DM; float ss = 0.f;
#pragma unroll
        for (int q = 0; q < 4; ++q) { const f32x4 v = __builtin_nontemporal_load((const f32x4*)(xr + q * 256 + lane * 4)); ss += v[0] * v[0] + v[1] * v[1] + v[2] * v[2] + v[3] * v[3]; st4bf(xb + (size_t)r * DM + q * 256 + lane * 4, v); }
        ss = wave_sum(ss);
        if (lane < 16) ssq[(size_t)r * 16 + lane] = lane == 0 ? ss : 0.f;
    }
}

struct TokRaw { uint2 a0, a1, a2, bc, bh, bb, q, kv, dv, du; f32x4 cs, sn; };
typedef unsigned u32x2 __attribute__((ext_vector_type(2)));
DEVI uint2 ldnt2(const bf16_t* p) { const u32x2 v = __builtin_nontemporal_load((const u32x2*)p); uint2 r; r.x = v[0]; r.y = v[1]; return r; }
DEVI TokRaw ldtok(const bf16_t* pr, const float* rp, int c4, int lane) { TokRaw t; t.cs = *(const f32x4*)(rp + 4 * (lane & 1)); t.sn = *(const f32x4*)(rp + 8 + 4 * (lane & 1)); t.a0 = ldnt2(pr + C_AQ + c4); t.a1 = ldnt2(pr + C_AQ + 256 + c4); t.a2 = ldnt2(pr + C_AQ + 512 + c4);
    t.bc = ldnt2(pr + C_BC + c4); t.bh = ldnt2(pr + C_BH + c4); t.bb = ldnt2(pr + C_BB + c4); t.q = ldnt2(pr + C_CQ + c4); t.kv = ldnt2(pr + C_CK + c4);
    t.dv = ldnt2(pr + C_DV + c4); t.du = *(const uint2*)(pr + C_DU + c4); return t; }
__device__ void phase_tok(const Args& a, const int l, unsigned char* smem) {
    const int lane = tidx() & 63, wid = tidx() >> 6, c4 = lane * 4;
    const bf16_t* proj = (const bf16_t*)(wsp(a) + WS_PROJ);
    bf16_t* qkvn = (bf16_t*)outp(a); bf16_t* mix = (bf16_t*)(wsp(a) + WS_MIX); float* bg = (float*)(wsp(a) + WS_BG);
    bf16_t* qr = (bf16_t*)(wsp(a) + WS_QR); bf16_t* kvr = (bf16_t*)(wsp(a) + WS_KVR); bf16_t* dvn = (bf16_t*)(wsp(a) + WS_DVN);
    float* out = outp(a);
    float* sw = (float*)smem;
    for (int i = tidx(); i < 4352; i += 512) sw[i] = i < 3072 ? inp(a, 10)[(size_t)l * 3072 + i] : (i < 3840 ? inp(a, 14)[(size_t)l * 768 + i - 3072] : (i < 4096 ? inp(a, 16)[l * 256 + i - 3840] : inp(a, 17)[l * 256 + i - 4096]));
    __syncthreads();
    const float* cwp = sw + c4;
    const float* bwp = sw + 3072 + c4; const float* lngp = sw + 3840 + c4; const float* lnbp = sw + 4096 + c4;
    float inv[4];
#pragma unroll
    for (int e = 0; e < 4; ++e) inv[e] = powf(500000.f, -(float)(4 * (lane & 1) + e) * 0.125f);
    const int j16 = lane & 15, gD = lane >> 4;
    const float dtb = inp(a, 12)[l * 4 + (lane & 3)], nega = -__expf(inp(a, 11)[l * 4 + (lane & 3)]);
    const float* Wd = inp(a, 18) + ((size_t)(l * 4 + gD) * 128) * 128; const float* biasd = inp(a, 19) + (size_t)(l * 4 + gD) * 128;
    {
        const float* ck = inp(a, 5) + (size_t)l * 128 * 16384; const float* cv = inp(a, 6) + (size_t)l * 128 * 16384;
        float* ok = out + O_CKS + (size_t)l * 128 * 16384; float* ov = out + O_CVS + (size_t)l * 128 * 16384;
        for (int i = bidx() * 512 + tidx(); i < 128 * 3968; i += gdim() * 512) { const int bb = i / 3968, j = i - bb * 3968; const size_t o = (size_t)bb * 16384 + (size_t)j * 4;
            *(f32x4*)(ok + o) = *(const f32x4*)(ck + o + 512); *(f32x4*)(ov + o) = *(const f32x4*)(cv + o + 512); }
    }
    for (int pass = 0; pass < 2; ++pass) {
        const int B = bidx();
        bool smp; int b, t0, ntok; size_t r0;
        if (pass == 0) { smp = false; b = B >> 5; int off = 16 * wid, len = 16;
            if (B < 128) { off = wid < 4 ? 17 * wid : 68 + 16 * (wid - 4); len = wid < 4 ? 17 : (wid < 7 ? 16 : 12); }
            t0 = (B & 31) * 128 + off; ntok = len; r0 = (size_t)b * 4096 + t0; }
        else { if (!(wid == 7 && B < 128)) break; smp = true; b = B; t0 = 0; ntok = 4; r0 = (size_t)MP + 4 * b; }
        f32x4 ha[3][3], hb[2];
        const f32x4 z4 = {0.f, 0.f, 0.f, 0.f};
        if (smp) {
            const float* st = inp(a, 3) + ((size_t)(l * 128 + b) * 3) * 768;
#pragma unroll
            for (int p = 0; p < 3; ++p)
#pragma unroll
                for (int j = 0; j < 3; ++j) ha[p][j] = *(const f32x4*)(st + j * 768 + p * 256 + c4);
            const float* sb = inp(a, 4) + ((size_t)(l * 128 + b) * 2) * 256; hb[0] = *(const f32x4*)(sb + c4); hb[1] = *(const f32x4*)(sb + 256 + c4);
        } else if (t0 == 0) {
#pragma unroll
            for (int p = 0; p < 3; ++p)
#pragma unroll
                for (int j = 0; j < 3; ++j) ha[p][j] = z4;
            hb[0] = z4; hb[1] = z4;
        } else {
#pragma unroll
            for (int p = 0; p < 3; ++p)
#pragma unroll
                for (int j = 0; j < 3; ++j) ha[p][j] = ld4bf(proj + (r0 - 3 + j) * PS + C_AQ + p * 256 + c4);
#pragma unroll
            for (int j = 0; j < 2; ++j) hb[j] = ld4bf(proj + (r0 - 2 + j) * PS + C_BC + c4) * ld4bf(proj + (r0 - 2 + j) * PS + C_BH + c4);
        }
        f32x4 h0 = z4, h1 = z4, h2 = z4, h3 = z4;
        {
            const int hh = lane & 3;
            for (int ti = lane >> 2; ti < ntok; ti += 16) { const bf16_t* pr = proj + (r0 + ti) * PS;
                const float ab = bf2f(pr[C_AB + hh]), aa = bf2f(pr[C_AA + hh]);
                const float beta = __builtin_amdgcn_rcpf(1.f + __expf(-ab)); const float x = aa + dtb; const float sp = x > 20.f ? x : log1pf(__expf(x));
                bg[(r0 + ti) * 8 + hh] = beta; bg[(r0 + ti) * 8 + 4 + hh] = nega * sp; }
        }
        const float* ropet = (const float*)(wsp(a) + WS_ROPE) + (size_t)(smp ? 4096 : t0) * 16;
        TokRaw nx = ldtok(proj + r0 * PS, ropet, c4, lane);
#pragma unroll 1
        for (int i = 0; i < ntok; ++i) {
            const size_t r = r0 + i; const int t = t0 + i;
            const TokRaw tk = nx;
            const float* cwq = cwp; const float* bwq = bwp;
            nx = ldtok(proj + (r0 + (i + 1 < ntok ? i + 1 : i)) * PS, ropet + (i + 1 < ntok ? i + 1 : i) * 16, c4, lane);
#pragma unroll
            for (int p = 0; p < 3; ++p) {
                const f32x4 cur = cv4bf(p == 0 ? tk.a0 : (p == 1 ? tk.a1 : tk.a2));
                f32x4 s = silu4(*(const f32x4*)(cwq + p * 256) * ha[p][0] + *(const f32x4*)(cwq + 768 + p * 256) * ha[p][1] + *(const f32x4*)(cwq + 1536 + p * 256) * ha[p][2] + *(const f32x4*)(cwq + 2304 + p * 256) * cur);
                ha[p][0] = ha[p][1]; ha[p][1] = ha[p][2]; ha[p][2] = cur;
                if (p < 2) { float ss = red16(s[0] * s[0] + s[1] * s[1] + s[2] * s[2] + s[3] * s[3]); const float sc = rsqrtf(ss + EPS) * (p == 0 ? 0.125f : 1.f); s = s * sc; }
                st4bf(qkvn + r * 768 + p * 256 + c4, s);
                if (!smp) { if (t >= 4093) *(f32x4*)(out + O_SCP + ((size_t)(l * 8 + b) * 3 + (t - 4093)) * 768 + p * 256 + c4) = cur; }
                else if (i >= 1) *(f32x4*)(out + O_SCS + ((size_t)(l * 128 + b) * 3 + (i - 1)) * 768 + p * 256 + c4) = cur;
            }
            {
                const f32x4 s = cv4bf(tk.bc) * cv4bf(tk.bh), bb = cv4bf(tk.bb);
                const f32x4 bx = *(const f32x4*)bwq * hb[0] + *(const f32x4*)(bwq + 256) * hb[1] + *(const f32x4*)(bwq + 512) * s;
                st4bf(mix + r * DM + 256 + c4, bb * bx); hb[0] = hb[1]; hb[1] = s;
                if (!smp) { if (t >= 4094) *(f32x4*)(out + O_SSP + ((size_t)(l * 8 + b) * 2 + (t - 4094)) * 256 + c4) = s; }
                else if (i >= 2) *(f32x4*)(out + O_SSS + ((size_t)(l * 128 + b) * 2 + (i - 2)) * 256 + c4) = s;
            }
            {
                f32x4 q = cv4bf(tk.q), kv = cv4bf(tk.kv), qo, ko;
#pragma unroll
                for (int e = 0; e < 4; ++e) { qo[e] = __shfl_xor(q[e], 2); ko[e] = __shfl_xor(kv[e], 2); }
                if (j16 < 4) {
                    const float sgn = j16 < 2 ? -1.f : 1.f;
#pragma unroll
                    for (int e = 0; e < 4; ++e) {
                        const float cs = tk.cs[e], sn = tk.sn[e];
                        q[e] = q[e] * cs + sgn * qo[e] * sn;
                        if (lane < 32) kv[e] = kv[e] * cs + sgn * ko[e] * sn;
                    }
                }
                st4bf(qr + r * 256 + c4, q); st4bf(kvr + r * 256 + c4, kv);
                if (!smp) { if (t >= 3968) { float* o = (lane < 32 ? out + O_CKP : out + O_CVP) + ((size_t)(l * 8 + b) * 128 + (t - 3968)) * 128 + (c4 & 127); *(f32x4*)o = kv; } }
                else { float* o = (lane < 32 ? out + O_CKS : out + O_CVS) + ((size_t)(l * 128 + b) * 128 + 124 + i) * 128 + (c4 & 127); *(f32x4*)o = kv; }
            }
            {
                const f32x4 x = gelu4(cv4bf(tk.dv));
                const float mean = wave_sum(x[0] + x[1] + x[2] + x[3]) * (1.f / 256.f);
                const f32x4 xc = x - mean;
                const float var = wave_sum(xc[0] * xc[0] + xc[1] * xc[1] + xc[2] * xc[2] + xc[3] * xc[3]) * (1.f / 256.f);
                const f32x4 y = xc * rsqrtf(var + EPS) * *(const f32x4*)lngp + *(const f32x4*)lnbp;
                st4bf(dvn + r * 256 + c4, y);
                if (smp) {
                    *(f32x4*)(out + O_CHV + ((size_t)(l * 128 + b) * 4 + i) * 256 + c4) = y;
                    if (i == 0) h0 = y; else if (i == 1) h1 = y; else if (i == 2) h2 = y; else h3 = y;
                    f32x4 mx = Wd[i * 128 + 0] * h0 + biasd[i];
                    if (i >= 1) mx = mx + Wd[i * 128 + 1] * h1;
                    if (i >= 2) mx = mx + Wd[i * 128 + 2] * h2;
                    if (i >= 3) mx = mx + Wd[i * 128 + 3] * h3;
                    st4bf(mix + r * DM + 768 + c4, gelu4(cv4bf(tk.du)) * mx);
                }
            }
        }
    }
}

constexpr int A2_LDS = 64 * 68 * 4 + 512;
DEVI int fragidx(int row, int col) { return (((row >> 4) * 2 + (col >> 5)) * 64 + ((col >> 2) & 3) * 16 + (row & 15)) * 8 + 4 * ((col >> 4) & 1) + (col & 3); }
__device__ void a2_item(const Args& a, const int it, unsigned char* wl) {
    const int lane = tidx() & 63, fr = lane & 15, fq = lane >> 4;
    float* Aw = (float*)wl; float* gcs = Aw + 64 * 68; float* bts = gcs + 64;
    const int h = it & 3, n = (it >> 2) & 63, b = it >> 8;
    const size_t t0 = (size_t)b * 4096 + n * 64;
    const float* bg = (const float*)(wsp(a) + WS_BG); const bf16_t* qkvn = (const bf16_t*)outp(a);
    float gcv = bg[(t0 + lane) * 8 + 4 + h]; const float bt = bg[(t0 + lane) * 8 + h];
    for (int d = 1; d < 64; d <<= 1) { const float o = __shfl_up(gcv, d); if (lane >= d) gcv += o; }
    const float gl = __shfl(gcv, 63);
    gcs[lane] = gcv; bts[lane] = bt;
    const bf16_t* qb = qkvn + t0 * 768 + h * 64; const bf16_t* kb = qb + 256; const bf16_t* vb = qb + 512;
    bf16x8 kf[4][2], qf[4][2];
#pragma unroll
    for (int m = 0; m < 4; ++m)
#pragma unroll
        for (int kk = 0; kk < 2; ++kk) { kf[m][kk] = *(const bf16x8*)(kb + (size_t)(16 * m + fr) * 768 + 32 * kk + 8 * fq); qf[m][kk] = *(const bf16x8*)(qb + (size_t)(16 * m + fr) * 768 + 32 * kk + 8 * fq); }
    wave_lds_fence();
    unsigned char* cbase = wsp(a) + WS_A2 + (size_t)it * 49152;
    if (lane == 0) ((float*)(wsp(a) + WS_GLS))[it] = gl;
#pragma unroll
    for (int m = 0; m < 4; ++m) {
        const int i = 16 * m + fr; const float gi = gcs[i], bi = bts[i];
#pragma unroll
        for (int k2 = 0; k2 < 2; ++k2) {
            f32x4 ak[2], aq[2];
#pragma unroll
            for (int hh = 0; hh < 2; ++hh) {
                const int nn = 2 * k2 + hh;
                ak[hh] = (f32x4){0.f, 0.f, 0.f, 0.f}; aq[hh] = (f32x4){0.f, 0.f, 0.f, 0.f};
                if (nn <= m) {
#pragma unroll
                    for (int kk = 0; kk < 2; ++kk) { ak[hh] = MFMA16(kf[nn][kk], kf[m][kk], ak[hh]); aq[hh] = MFMA16(kf[nn][kk], qf[m][kk], aq[hh]); }
                    const f32x4 gj = *(const f32x4*)(gcs + 16 * nn + 4 * fq);
#pragma unroll
                    for (int jj = 0; jj < 4; ++jj) { const int j = 16 * nn + 4 * fq + jj; const float e = __expf(fminf(gi - gj[jj], 0.f));
                        ak[hh][jj] = (j < i) ? bi * ak[hh][jj] * e : 0.f; aq[hh][jj] = (j <= i) ? aq[hh][jj] * e : 0.f; }
                }
                *(f32x4*)(Aw + i * 68 + 16 * nn + 4 * fq) = ak[hh];
            }
            *(uint4*)(cbase + ((m * 2 + k2) * 64 + lane) * 16) = pack8u(aq[0], aq[1]);
        }
    }
#pragma unroll
    for (int m = 0; m < 4; ++m)
#pragma unroll
        for (int kk = 0; kk < 2; ++kk) { const int i = 16 * m + fr; const float e = __expf(gcs[i]);
            const f32x4 lo = ld4bf(qb + (size_t)i * 768 + 32 * kk + 4 * fq) * e, hi = ld4bf(qb + (size_t)i * 768 + 32 * kk + 16 + 4 * fq) * e;
            *(uint4*)(cbase + 16384 + ((m * 2 + kk) * 64 + lane) * 16) = pack8u(lo, hi); }
    wave_lds_fence();
    const int c = lane;
    bf16_t* wF = (bf16_t*)(cbase + 8192); bf16_t* kdF = (bf16_t*)(cbase + 24576); float* uS = (float*)(cbase + 32768);
    {
        float U[64];
#pragma unroll
        for (int i = 0; i < 64; ++i) U[i] = bf2f(vb[(size_t)i * 768 + c]);
#pragma unroll
        for (int i = 0; i < 64; ++i) {
            const float vi = U[i];
            float su = bts[i] * vi;
            f32x4 ar[16];
#pragma unroll
            for (int q = 0; q < (i + 3) / 4; ++q) ar[q] = *(const f32x4*)(Aw + i * 68 + 4 * q);
            asm volatile("" : "+v"(su) :: "memory");
#pragma unroll
            for (int q = 0; q < (i + 3) / 4; ++q)
#pragma unroll
                for (int jj = 0; jj < 4; ++jj) if (4 * q + jj < i) su -= ar[q][jj] * U[4 * q + jj];
            U[i] = su;
            uS[(((c >> 4) * 4 + (i >> 4)) * 64 + ((i >> 2) & 3) * 16 + (c & 15)) * 4 + (i & 3)] = su;
            asm volatile("" ::: "memory");
        }
    }
    {
        float W[64];
#pragma unroll
        for (int i = 0; i < 64; ++i) W[i] = bf2f(kb[(size_t)i * 768 + c]);
#pragma unroll
        for (int i = 0; i < 64; ++i) {
            const float ki = W[i];
            const float bi = bts[i], gi = gcs[i];
            float sw = bi * __expf(gi) * ki;
            f32x4 ar[16];
#pragma unroll
            for (int q = 0; q < (i + 3) / 4; ++q) ar[q] = *(const f32x4*)(Aw + i * 68 + 4 * q);
            asm volatile("" : "+v"(sw) :: "memory");
#pragma unroll
            for (int q = 0; q < (i + 3) / 4; ++q)
#pragma unroll
                for (int jj = 0; jj < 4; ++jj) if (4 * q + jj < i) sw -= ar[q][jj] * W[4 * q + jj];
            W[i] = sw;
            kdF[fragidx(c, i)] = f2bf(ki * __expf(gl - gi));
            wF[fragidx(i, c)] = f2bf(sw);
            asm volatile("" ::: "memory");
        }
    }
}

__device__ void sdelta_item(const Args& a, const int l, const int it) {
    const int lane = tidx() & 63, h = it & 3, b = it >> 2;
    const float* S0 = inp(a, 2) + ((size_t)(l * 128 + b) * 4 + h) * 4096;
    const float* bg = (const float*)(wsp(a) + WS_BG); const bf16_t* qkvn = (const bf16_t*)outp(a);
    float S[64];
#pragma unroll
    for (int i = 0; i < 64; ++i) S[i] = S0[i * 64 + lane];
    for (int t = 0; t < 4; ++t) {
        const size_t r = (size_t)MP + 4 * b + t; const bf16_t* p = qkvn + r * 768 + h * 64 + lane;
        const float qv = bf2f(p[0]), kv = bf2f(p[256]), vv = bf2f(p[512]); const float beta = bg[r * 8 + h], eg = __expf(bg[r * 8 + 4 + h]);
        float rr = 0.f;
#pragma unroll
        for (int i = 0; i < 64; ++i) { S[i] *= eg; rr += rdlane(kv, i) * S[i]; }
        const float cc = beta * (vv - rr); float oo = 0.f;
#pragma unroll
        for (int i = 0; i < 64; ++i) { S[i] += rdlane(kv, i) * cc; oo += rdlane(qv, i) * S[i]; }
        {
            const float ss = wave_sum(oo * oo);
            const float y = oo * rsqrtf(ss * (1.f / 64.f) + EPS) * inp(a, 13)[l * 64 + lane];
            const float z = bf2f(((const bf16_t*)(wsp(a) + WS_PROJ))[r * PS + C_AZ + h * 64 + lane]);
            ((bf16_t*)(wsp(a) + WS_MIX))[r * DM + h * 64 + lane] = f2bf(y * silu_f(z));
        }
    }
    float* So = outp(a) + O_SDS + ((size_t)(l * 128 + b) * 4 + h) * 4096;
#pragma unroll
    for (int i = 0; i < 64; ++i) So[i * 64 + lane] = S[i];
}

__device__ void sattn_item(const Args& a, const int l, const int it) {
    const int lane = tidx() & 63, hq = it & 3, b = it >> 2, kvh = hq >> 1;
    const float* ck = inp(a, 5) + (size_t)(l * 128 + b) * 16384 + kvh * 64; const float* cv = inp(a, 6) + (size_t)(l * 128 + b) * 16384 + kvh * 64;
    const bf16_t* qr = (const bf16_t*)(wsp(a) + WS_QR); const bf16_t* kvr = (const bf16_t*)(wsp(a) + WS_KVR); bf16_t* mix = (bf16_t*)(wsp(a) + WS_MIX);
    const size_t r0 = (size_t)MP + 4 * b;
    float qv[4];
#pragma unroll
    for (int i = 0; i < 4; ++i) qv[i] = bf2f(qr[(r0 + i) * 256 + hq * 64 + lane]);
    float s[3][4];
#pragma unroll
    for (int sl = 0; sl < 3; ++sl) {
        float acc0 = 0.f, acc1 = 0.f, acc2 = 0.f, acc3 = 0.f;
        if (sl < 2) { const float* kp = ck + (size_t)(sl * 64 + lane) * 128;
#pragma unroll
            for (int d4 = 0; d4 < 16; ++d4) { const f32x4 kx = *(const f32x4*)(kp + d4 * 4);
#pragma unroll
                for (int e = 0; e < 4; ++e) { const int d = d4 * 4 + e; acc0 += rdlane(qv[0], d) * kx[e]; acc1 += rdlane(qv[1], d) * kx[e]; acc2 += rdlane(qv[2], d) * kx[e]; acc3 += rdlane(qv[3], d) * kx[e]; } }
        } else { const bf16_t* kp = kvr + (r0 + (lane & 3)) * 256 + kvh * 64;
#pragma unroll
            for (int d4 = 0; d4 < 16; ++d4) { const f32x4 kx = ld4bf(kp + d4 * 4);
#pragma unroll
                for (int e = 0; e < 4; ++e) { const int d = d4 * 4 + e; acc0 += rdlane(qv[0], d) * kx[e]; acc1 += rdlane(qv[1], d) * kx[e]; acc2 += rdlane(qv[2], d) * kx[e]; acc3 += rdlane(qv[3], d) * kx[e]; } }
        }
        s[sl][0] = acc0; s[sl][1] = acc1; s[sl][2] = acc2; s[sl][3] = acc3;
    }
    const float sink = inp(a, 15)[l * 4 + hq];
    float inv[4];
#pragma unroll
    for (int i = 0; i < 4; ++i) {
        const bool v0 = lane > i, v1 = true, v2 = lane <= i && lane < 4;
        const float x0 = v0 ? s[0][i] * 0.125f : -1e30f, x1 = v1 ? s[1][i] * 0.125f : -1e30f, x2 = v2 ? s[2][i] * 0.125f : -1e30f;
        float mx = fmaxf(fmaxf(x0, x1), x2);
        for (int d = 1; d < 64; d <<= 1) mx = fmaxf(mx, __shfl_xor(mx, d));
        mx = fmaxf(mx, sink);
        const float p0 = v0 ? __expf(x0 - mx) : 0.f, p1 = __expf(x1 - mx), p2 = v2 ? __expf(x2 - mx) : 0.f;
        const float sum = wave_sum(p0 + p1 + p2) + __expf(sink - mx);
        s[0][i] = p0; s[1][i] = p1; s[2][i] = p2; inv[i] = 1.f / sum;
    }
    float o[4] = {0.f, 0.f, 0.f, 0.f};
#pragma unroll
    for (int sl = 0; sl < 2; ++sl)
#pragma unroll 1
        for (int j0 = 0; j0 < 64; j0 += 16) { float vv[16];
#pragma unroll
            for (int e = 0; e < 16; ++e) vv[e] = cv[(size_t)(sl * 64 + j0 + e) * 128 + lane];
#pragma unroll
            for (int e = 0; e < 16; ++e)
#pragma unroll
                for (int i = 0; i < 4; ++i) o[i] += rdlane(s[sl][i], j0 + e) * vv[e]; }
#pragma unroll
    for (int jj = 0; jj < 4; ++jj) { const float vv = bf2f(kvr[(r0 + jj) * 256 + 128 + kvh * 64 + lane]);
#pragma unroll
        for (int i = 0; i < 4; ++i) o[i] += rdlane(s[2][i], jj) * vv; }
#pragma unroll
    for (int i = 0; i < 4; ++i) mix[(r0 + i) * DM + 512 + hq * 64 + lane] = f2bf(o[i] * inv[i]);
}

__device__ void c_item(const Args& a, const int l, const int it, unsigned char* smem) {
    const int tid = tidx(), lane = tid & 63, w = tid >> 6, fr = lane & 15, fq = lane >> 4;
    const int qb = it & 63, kvh = (it >> 6) & 1, b = it >> 7;
    bf16_t* Ks = (bf16_t*)smem; bf16_t* Vt = Ks + 192 * 72;
    const bf16_t* kvr = (const bf16_t*)(wsp(a) + WS_KVR); const bf16_t* qr = (const bf16_t*)(wsp(a) + WS_QR); bf16_t* mix = (bf16_t*)(wsp(a) + WS_MIX);
    const int kp0 = 64 * qb - 128;
    const int hq = 2 * kvh + (w >> 2), wq = w & 3, qrow0 = 64 * qb + 16 * wq, kb = 16 * wq;
    const bf16_t* qp = qr + ((size_t)b * 4096 + qrow0 + fr) * 256 + hq * 64 + 8 * fq;
    const bf16x8 qf0 = *(const bf16x8*)qp, qf1 = *(const bf16x8*)(qp + 32);
    for (int id = tid; id < 1536; id += 512) { const int row = id >> 3, c8 = id & 7, kp = kp0 + row; uint4 kq = {0u, 0u, 0u, 0u}, vq = {0u, 0u, 0u, 0u};
        if (kp >= 0) { const bf16_t* src = kvr + ((size_t)b * 4096 + kp) * 256 + kvh * 64 + c8 * 8; kq = *(const uint4*)src; vq = *(const uint4*)(src + 128); }
        *(uint4*)(Ks + row * 72 + c8 * 8) = kq; bf16_t* vd = Vt + (c8 * 8) * 200 + row;
        vd[0] = (bf16_t)(vq.x & 0xffffu); vd[200] = (bf16_t)(vq.x >> 16); vd[400] = (bf16_t)(vq.y & 0xffffu); vd[600] = (bf16_t)(vq.y >> 16);
        vd[800] = (bf16_t)(vq.z & 0xffffu); vd[1000] = (bf16_t)(vq.z >> 16); vd[1200] = (bf16_t)(vq.w & 0xffffu); vd[1400] = (bf16_t)(vq.w >> 16); }
    __syncthreads();
    f32x4 s[9];
#pragma unroll
    for (int nn = 0; nn < 9; ++nn) { const bf16_t* kr = Ks + (kb + 16 * nn + fr) * 72 + 8 * fq; s[nn] = (f32x4){0.f, 0.f, 0.f, 0.f};
        s[nn] = MFMA16(*(const bf16x8*)kr, qf0, s[nn]); s[nn] = MFMA16(*(const bf16x8*)(kr + 32), qf1, s[nn]); }
    const int tq = qrow0 + fr; const float sink = inp(a, 15)[l * 4 + hq];
    float mx = sink;
#pragma unroll
    for (int nn = 0; nn < 9; ++nn)
#pragma unroll
        for (int jj = 0; jj < 4; ++jj) { const int tk = kp0 + kb + 16 * nn + 4 * fq + jj; const bool ok = tk >= 0 && tk <= tq && tk > tq - 128;
            const float v = ok ? s[nn][jj] * 0.125f : -1e30f; s[nn][jj] = v; mx = fmaxf(mx, v); }
    mx = fmaxf(mx, __shfl_xor(mx, 16)); mx = fmaxf(mx, __shfl_xor(mx, 32));
    float sum = 0.f;
#pragma unroll
    for (int nn = 0; nn < 9; ++nn)
#pragma unroll
        for (int jj = 0; jj < 4; ++jj) { const float p = s[nn][jj] > -1e29f ? __expf(s[nn][jj] - mx) : 0.f; s[nn][jj] = p; sum += p; }
    sum += __shfl_xor(sum, 16); sum += __shfl_xor(sum, 32); sum += __expf(sink - mx);
    bf16x8 pb[5];
#pragma unroll
    for (int kk = 0; kk < 4; ++kk) pb[kk] = pack8(s[2 * kk], s[2 * kk + 1]);
    pb[4] = pack8(s[8], (f32x4){0.f, 0.f, 0.f, 0.f});
    const float inv = 1.f / sum;
#pragma unroll
    for (int m = 0; m < 4; ++m) { f32x4 o = {0.f, 0.f, 0.f, 0.f};
#pragma unroll
        for (int kk = 0; kk < 5; ++kk) { const bf16_t* vp = Vt + (16 * m + fr) * 200 + kb + 32 * kk + 4 * fq;
            const bf16x4 lo = *(const bf16x4*)vp; bf16x4 hi = {0, 0, 0, 0}; if (kk < 4) hi = *(const bf16x4*)(vp + 16);
            const bf16x8 af = {lo[0], lo[1], lo[2], lo[3], hi[0], hi[1], hi[2], hi[3]};
            o = MFMA16(af, pb[kk], o); }
        st4bf(mix + ((size_t)b * 4096 + tq) * DM + 512 + hq * 64 + 16 * m + 4 * fq, o * inv); }
    __syncthreads();
}

__device__ void d_item(const Args& a, const int l, const int it, unsigned char* smem) {
    const int tid = tidx(), lane = tid & 63, w = tid >> 6, fr = lane & 15, fq = lane >> 4;
    const int g = it & 3, ch = (it >> 2) & 31, b = it >> 7;
    bf16_t* vT = (bf16_t*)smem;
    const bf16_t* dvn = (const bf16_t*)(wsp(a) + WS_DVN); const bf16_t* proj = (const bf16_t*)(wsp(a) + WS_PROJ); bf16_t* mix = (bf16_t*)(wsp(a) + WS_MIX);
    const size_t r0 = (size_t)b * 4096 + 128 * ch;
    const float* Wg = inp(a, 18) + ((size_t)(l * 4 + g) * 128) * 128;
    const int t = 16 * w + fr;
    const size_t r = r0 + t;
    f32x4 wa[4], wb[4]; uint2 duq[4];
#pragma unroll
    for (int kk = 0; kk < 4; ++kk) if (kk <= (w >> 1)) { const float* wp = Wg + (size_t)t * 128 + 32 * kk + 8 * fq; wa[kk] = *(const f32x4*)wp; wb[kk] = *(const f32x4*)(wp + 4); }
#pragma unroll
    for (int n = 0; n < 4; ++n) duq[n] = *(const uint2*)(proj + r * PS + C_DU + g * 64 + 16 * n + 4 * fq);
    const float bias = inp(a, 19)[(size_t)(l * 4 + g) * 128 + t];
    for (int id = tid; id < 1024; id += 512) { const int row = id >> 3, c8 = id & 7; const uint4 vq = *(const uint4*)(dvn + (r0 + row) * 256 + g * 64 + c8 * 8); bf16_t* vd = vT + (c8 * 8) * 136 + row;
        vd[0] = (bf16_t)(vq.x & 0xffffu); vd[136] = (bf16_t)(vq.x >> 16); vd[272] = (bf16_t)(vq.y & 0xffffu); vd[408] = (bf16_t)(vq.y >> 16);
        vd[544] = (bf16_t)(vq.z & 0xffffu); vd[680] = (bf16_t)(vq.z >> 16); vd[816] = (bf16_t)(vq.w & 0xffffu); vd[952] = (bf16_t)(vq.w >> 16); }
    __syncthreads();
    f32x4 acc[4];
#pragma unroll
    for (int n = 0; n < 4; ++n) acc[n] = (f32x4){0.f, 0.f, 0.f, 0.f};
#pragma unroll
    for (int kk = 0; kk < 4; ++kk) if (kk <= (w >> 1)) {
        f32x4 w0 = wa[kk], w1 = wb[kk];
#pragma unroll
        for (int e = 0; e < 4; ++e) { if (32 * kk + 8 * fq + e > t) w0[e] = 0.f; if (32 * kk + 8 * fq + 4 + e > t) w1[e] = 0.f; }
        const bf16x8 bfr = pack8(w0, w1);
#pragma unroll
        for (int n = 0; n < 4; ++n) acc[n] = MFMA16(*(const bf16x8*)(vT + (16 * n + fr) * 136 + 32 * kk + 8 * fq), bfr, acc[n]);
    }
#pragma unroll
    for (int n = 0; n < 4; ++n) { const f32x4 du = gelu4(cv4bf(duq[n])); st4bf(mix + r * DM + 768 + g * 64 + 16 * n + 4 * fq, du * (acc[n] + bias)); }
    __syncthreads();
}

__device__ void phase_chunk(const Args& a, const int l, unsigned char* smem) {
    const int wid = tidx() >> 6, gw = bidx() * 8 + wid, nw = gdim() * 8;
#ifndef CHMASK
#define CHMASK 15
#endif
#ifndef CHDUP
#define CHDUP 0
#endif
    if (CHDUP & 1) { if (l == 0) for (int it = gw; it < 2048; it += nw) a2_item(a, it, smem + wid * A2_LDS); }
    if (CHDUP & 2) { if (l == 0) for (int it = gw; it < 512; it += nw) sattn_item(a, l, it); }
    if (CHDUP & 4) { if (l == 0) { __syncthreads(); for (int it = bidx(); it < 1024; it += gdim()) c_item(a, l, it, smem); } }
    if (CHDUP & 8) { if (l == 0) { __syncthreads(); for (int it = bidx(); it < 1024; it += gdim()) d_item(a, l, it, smem); } }
    if (CHDUP) __syncthreads();
    if (CHMASK & 1) for (int it = gw; it < 2048; it += nw) a2_item(a, it, smem + wid * A2_LDS);
    __syncthreads();

}

__device__ void phase_scan(const Args& a, const int l, unsigned char* smem) {
    const int lane = tidx() & 63, wid = tidx() >> 6, fr = lane & 15, fq = lane >> 4;

    float* oraw = (float*)((unsigned char*)outp(a) + OUT_ORAW);
    if (bidx() >= 32 || gdim() < 64) {
        const int nb = gdim() < 64 ? gdim() : gdim() - 32, bi = gdim() < 64 ? bidx() : bidx() - 32;
        for (int it = bi; it < 1024; it += nb) c_item(a, l, it, smem);
        for (int it = bi; it < 1024; it += nb) d_item(a, l, it, smem);
        { const int w = bi * 8 + wid; const int w3 = w / 3, wr3 = w - 3 * w3;
          if (w3 < 512 && wr3 == 0) sdelta_item(a, l, w3);
          if (w3 < 512 && wr3 == 1) sattn_item(a, l, w3); }
        if (gdim() >= 64) return;
    }
    LAS unsigned char* ring = (LAS unsigned char*)smem;
    for (int bh = bidx(); bh < 32; bh += gdim()) {
        const int b = bh >> 2, h = bh & 3, sl = wid;
        const unsigned char* a2b = wsp(a) + WS_A2;
#define SC_BASE(n_) (a2b + (size_t)((b * 64 + (n_)) * 4 + h) * 49152)
        if (wid >= 4) {
            const int lw = wid - 4;
#define SC_ISSUE(n_) do { const int nn_ = (n_) < 63 ? (n_) : 63; const unsigned char* g_ = SC_BASE(nn_) + lw * 8192 + lane * 16; LAS unsigned char* d_ = ring + ((n_) & 3) * 32768 + lw * 8192; \
            _Pragma("unroll") for (int j_ = 0; j_ < 8; ++j_) __builtin_amdgcn_global_load_lds((const unsigned*)(g_ + j_ * 1024), (LAS unsigned*)(d_ + j_ * 1024), 16, 0, 0); } while (0)
            SC_ISSUE(0); SC_ISSUE(1); SC_ISSUE(2);
#pragma unroll 1
            for (int n = 0; n < 64; ++n) {
                asm volatile("s_waitcnt vmcnt(16)" ::: "memory");
                __builtin_amdgcn_s_barrier();
                asm volatile("" ::: "memory");
                SC_ISSUE(n + 3);
            }
            asm volatile("s_waitcnt vmcnt(0)" ::: "memory");
            __builtin_amdgcn_s_barrier();
#undef SC_ISSUE
        } else {
            f32x4 S[4];
#pragma unroll
            for (int m = 0; m < 4; ++m) S[m] = (f32x4){0.f, 0.f, 0.f, 0.f};
            f32x4 u[4]; float glv;
            const float* glsp = (const float*)(wsp(a) + WS_GLS);
#define SC_LD_U(n_) do { const unsigned char* cb_ = SC_BASE(n_); _Pragma("unroll") for (int m = 0; m < 4; ++m) u[m] = *(const f32x4*)(cb_ + 32768 + (size_t)((sl * 4 + m) * 64 + lane) * 16); glv = glsp[(b * 64 + (n_)) * 4 + h]; } while (0)
#define SC_FR(off_, m_, kk_) (*(const LAS bf16x8*)(slot + (off_) + (((m_) * 2 + (kk_)) * 64 + lane) * 16))
            SC_LD_U(0);
#pragma unroll 1
            for (int n = 0; n < 64; ++n) {
                asm volatile("s_waitcnt lgkmcnt(0)" ::: "memory");
                __builtin_amdgcn_s_barrier();
                asm volatile("" ::: "memory");
                const LAS unsigned char* slot = ring + (n & 3) * 32768;
                const int nn = n < 63 ? n + 1 : 63;
                const float egl = __expf(glv);
                bf16x8 Sb[2], Vb[2];
                Sb[0] = pack8(S[0], S[1]); Sb[1] = pack8(S[2], S[3]);
                f32x4 vn[4];
                const size_t t0 = (size_t)b * 4096 + n * 64;
#pragma unroll
                for (int m = 0; m < 4; ++m) { f32x4 T = {0.f, 0.f, 0.f, 0.f}; T = MFMA16(SC_FR(8192, m, 0), Sb[0], T); T = MFMA16(SC_FR(8192, m, 1), Sb[1], T); vn[m] = u[m] - T; }
                SC_LD_U(nn);
                Vb[0] = pack8(vn[0], vn[1]); Vb[1] = pack8(vn[2], vn[3]);
#pragma unroll
                for (int m = 0; m < 4; ++m) { f32x4 o = {0.f, 0.f, 0.f, 0.f}; o = MFMA16(SC_FR(16384, m, 0), Sb[0], o); o = MFMA16(SC_FR(16384, m, 1), Sb[1], o); o = MFMA16(SC_FR(0, m, 0), Vb[0], o); o = MFMA16(SC_FR(0, m, 1), Vb[1], o);
#pragma unroll
                    for (int jj = 0; jj < 4; ++jj) oraw[(t0 + 16 * m + 4 * fq + jj) * 256 + h * 64 + 16 * sl + fr] = o[jj]; }
#pragma unroll
                for (int m = 0; m < 4; ++m) { f32x4 s2 = S[m] * egl; s2 = MFMA16(SC_FR(24576, m, 0), Vb[0], s2); s2 = MFMA16(SC_FR(24576, m, 1), Vb[1], s2); S[m] = s2; }
            }
            asm volatile("s_waitcnt lgkmcnt(0)" ::: "memory");
            __builtin_amdgcn_s_barrier();
#undef SC_LD_U
#undef SC_FR
            float* So = outp(a) + O_SDP + ((size_t)(l * 8 + b) * 4 + h) * 4096;
#pragma unroll
            for (int m = 0; m < 4; ++m)
#pragma unroll
                for (int jj = 0; jj < 4; ++jj) So[(16 * m + 4 * fq + jj) * 64 + 16 * sl + fr] = S[m][jj];
        }
#undef SC_BASE
        __syncthreads();
    }
}

__device__ void phase_aout(const Args& a, const int l) {
    const int lane = tidx() & 63, wid = tidx() >> 6, c4 = lane * 4;
    const float* oraw = (const float*)((unsigned char*)outp(a) + OUT_ORAW); const bf16_t* proj = (const bf16_t*)(wsp(a) + WS_PROJ); bf16_t* mix = (bf16_t*)(wsp(a) + WS_MIX);
    const f32x4 g = *(const f32x4*)(inp(a, 13) + l * 64 + (c4 & 63));
    for (int r = bidx() * 8 + wid; r < MP; r += gdim() * 8) {
        const f32x4 o = *(const f32x4*)(oraw + (size_t)r * 256 + c4);
        const float ss = red16(o[0] * o[0] + o[1] * o[1] + o[2] * o[2] + o[3] * o[3]);
        const f32x4 y = o * rsqrtf(ss * (1.f / 64.f) + EPS) * g;
        st4bf(mix + (size_t)r * DM + c4, y * silu4(ld4bf(proj + (size_t)r * PS + C_AZ + c4)));
    }
}

__device__ void phase_fix(const Args& a, const int l) {
    const float* sg = (const float*)(wsp(a) + WS_SG); const float* su = (const float*)(wsp(a) + WS_SU); bf16_t* act = (bf16_t*)(wsp(a) + WS_PROJ);
    const float* cw = inp(a, 24) + (size_t)l * 3 * FF;
    const int idx0 = bidx() * 512 + tidx(), idxs = gdim() * 512;
#pragma unroll 3
    for (int idx = idx0; idx < 512 * 2 * 704; idx += idxs) {
        const int f = (idx % 704) * 4, q = (idx / 704) & 1, blk = idx / 1408; const bool prev = (blk & 63) != 0;
        const f32x4 z4 = {0.f, 0.f, 0.f, 0.f};
        const f32x4 g0 = *(const f32x4*)(sg + ((size_t)blk * 4 + q) * FF + f), up = *(const f32x4*)(su + ((size_t)blk * 2 + q) * FF + f);
        f32x4 gm2, gm1;
        if (q == 0) { gm2 = prev ? *(const f32x4*)(sg + ((size_t)(blk - 1) * 4 + 2) * FF + f) : z4; gm1 = prev ? *(const f32x4*)(sg + ((size_t)(blk - 1) * 4 + 3) * FF + f) : z4; }
        else { gm2 = prev ? *(const f32x4*)(sg + ((size_t)(blk - 1) * 4 + 3) * FF + f) : z4; gm1 = *(const f32x4*)(sg + ((size_t)blk * 4 + 0) * FF + f); }
        const f32x4 gc = *(const f32x4*)(cw + f) * gm2 + *(const f32x4*)(cw + FF + f) * gm1 + *(const f32x4*)(cw + 2 * FF + f) * g0;
        st4bf(act + ((size_t)blk * 64 + q) * FF + f, silu4(gc) * up);
    }
    const float* P = (const float*)(wsp(a) + WS_SACC); const float* st = inp(a, 7) + (size_t)l * 128 * 2 * FF; float* osfs = outp(a) + O_SFS + (size_t)l * 128 * 2 * FF;
    const float* ssq = (const float*)(wsp(a) + WS_SSQB);
    for (int idx = idx0; idx < 128 * FF; idx += idxs) {
        const int b = idx / FF, ff = idx - b * FF, gcol = 256 * (ff >> 7) + (ff & 127);
        float x2 = st[((size_t)b * 2) * FF + ff], x1 = st[((size_t)b * 2 + 1) * FF + ff];
        const float w0 = cw[ff], w1 = cw[FF + ff], w2 = cw[2 * FF + ff];
#pragma unroll
        for (int t = 0; t < 4; ++t) {
            const int rs = 4 * b + t; const float sc = rowscale(ssq, MP + rs);
            float g = 0.f, u = 0.f;
#pragma unroll
            for (int sl = 0; sl < 4; ++sl) { const float* pp = P + ((size_t)sl * MS + rs) * 5632 + gcol; g += pp[0]; u += pp[128]; }
            g *= sc; u *= sc;
            const float y = w0 * x2 + w1 * x1 + w2 * g;
            act[((size_t)MP + rs) * FF + ff] = f2bf(silu_f(y) * u);
            if (t >= 2) osfs[((size_t)b * 2 + (t - 2)) * FF + ff] = g;
            x2 = x1; x1 = g;
        }
    }
}

__device__ void phase_sfin(const Args& a) {
    const int lane = tidx() & 63, wid = tidx() >> 6;
    const float* sacc = (const float*)(wsp(a) + WS_SACC); bf16_t* xb = (bf16_t*)(wsp(a) + WS_XB); float* ssq = (float*)(wsp(a) + WS_SSQA);
    for (int rs = bidx() * 8 + wid; rs < MS; rs += gdim() * 8) {
        const size_t r = (size_t)MP + rs; float ss = 0.f;
#pragma unroll
        for (int q = 0; q < 4; ++q) { const int c = q * 256 + lane * 4; f32x4 v = ld4bf(xb + r * DM + c);
#pragma unroll
            for (int ks = 0; ks < 11; ++ks) v = v + *(const f32x4*)(sacc + (size_t)ks * ((size_t)MS * DM) + (size_t)rs * DM + c);
            ss += v[0] * v[0] + v[1] * v[1] + v[2] * v[2] + v[3] * v[3]; st4bf(xb + r * DM + c, v); }
        ss = wave_sum(ss);
        if (lane < 16) ssq[r * 16 + lane] = lane == 0 ? ss : 0.f;
    }
}

__device__ void phase_final(const Args& a) {
    const int lane = tidx() & 63, wid = tidx() >> 6;
    const float* ssq = (const float*)(wsp(a) + WS_SSQA); const float* g = inp(a, 26); const bf16_t* xb = (const bf16_t*)(wsp(a) + WS_XB);
    for (int r = bidx() * 8 + wid; r < M; r += gdim() * 8) {
        const float sc = rowscale(ssq, r); float* yr = outp(a) + (size_t)r * DM; const bf16_t* xr = xb + (size_t)r * DM;
#pragma unroll
        for (int q = 0; q < 4; ++q) { const int c = q * 256 + lane * 4; __builtin_nontemporal_store(ld4bf(xr + c) * sc * *(const f32x4*)(g + c), (f32x4*)(yr + c)); }
    }
}

#define XB_TMO      128
#define XB_XCNT(j)  (256  + 64 * (j))
#define XB_XSUB(j)  (1280 + 64 * (j))
#define XB_XGEN(j)  (2304 + 64 * (j))
#define XB_TOP      3328
#define XB_TOPGEN   3392
#define XCD_BAR_WORDS 3456
#define XB_SPIN_CAP (1u << 20)
DEVI unsigned xb_ld(unsigned* p)              { return __hip_atomic_load(p, __ATOMIC_RELAXED, __HIP_MEMORY_SCOPE_AGENT); }
DEVI unsigned xb_add(unsigned* p, unsigned v) { return __hip_atomic_fetch_add(p, v, __ATOMIC_RELAXED, __HIP_MEMORY_SCOPE_AGENT); }
DEVI unsigned xb_xcc_id() { return (unsigned)__builtin_amdgcn_s_getreg((3 << 11) | 20) & 0xFu; }
#define XB_SPIN(cond, bar) do { unsigned _sp = 0; while (cond) { __builtin_amdgcn_s_sleep(1); \
    if ((++_sp & 255u) == 0u) { if (xb_ld(&(bar)[XB_TMO])) break; if (_sp > XB_SPIN_CAP) { atomicAdd(&(bar)[XB_TMO], 1u); break; } } } } while (0)
DEVI void xcd_barrier_complete(unsigned* bar, unsigned x, unsigned& nloc, unsigned& nx) {
    const unsigned G = gridDim.x * gridDim.y * gridDim.z;
    unsigned sum, cnt, mine, sp = 0u;
    for (;;) {
        sum = 0u; cnt = 0u; mine = 0u;
#pragma unroll
        for (unsigned j = 0; j < 16; ++j) { const unsigned c = xb_ld(&bar[XB_XCNT(j)]); sum += c; cnt += (c > 0u) ? 1u : 0u; mine = (j == x) ? c : mine; }
        if (sum == G) break;
        __builtin_amdgcn_s_sleep(1);
        if ((++sp & 255u) == 0u) { if (xb_ld(&bar[XB_TMO])) break; if (sp > XB_SPIN_CAP) { atomicAdd(&bar[XB_TMO], 1u); break; } }
    }
    nloc = mine > 0u ? mine : 1u; nx = cnt > 0u ? cnt : 1u;
}
DEVI void xcd_barrier(unsigned* const b_bar, volatile LAS unsigned* const b_st) {
    const unsigned b_x = xb_xcc_id();
    asm volatile("s_waitcnt vmcnt(0)" ::: "memory");
    __syncthreads();
    if (threadIdx.x == 0) {
        unsigned* bar = b_bar;
        __builtin_amdgcn_s_waitcnt(0);
        unsigned nloc = b_st[0], nx = b_st[1];
        if (nloc == 0u) { (void)xb_add(&bar[XB_XCNT(b_x)], 1u); xcd_barrier_complete(bar, b_x, nloc, nx); b_st[0] = nloc; b_st[1] = nx; }
        const unsigned old = xb_add(&bar[XB_XSUB(b_x)], 1u);
        const unsigned gen = old / nloc;
        if (old + 1u == (gen + 1u) * nloc) {
            __builtin_amdgcn_fence(__ATOMIC_RELEASE, "agent");
            asm volatile("s_waitcnt vmcnt(0)" ::: "memory");
            const unsigned og = xb_add(&bar[XB_TOP], 1u);
            const unsigned tg = og / nx;
            if (og + 1u == (tg + 1u) * nx) xb_add(&bar[XB_TOPGEN], 1u);
            else XB_SPIN(xb_ld(&bar[XB_TOPGEN]) == tg, bar);
            __builtin_amdgcn_fence(__ATOMIC_ACQUIRE, "agent");
            xb_add(&bar[XB_XGEN(b_x)], 1u);
            asm volatile("s_waitcnt vmcnt(0)" ::: "memory");
        } else {
            XB_SPIN(xb_ld(&bar[XB_XGEN(b_x)]) == gen, bar);
            __builtin_amdgcn_fence(__ATOMIC_ACQUIRE, "agent");
            asm volatile("s_waitcnt vmcnt(0)" ::: "memory");
        }
    }
    __syncthreads();
}

constexpr int NPH = 22, LDS_BYTES = 147456;
__global__ void __launch_bounds__(512) fwd_kernel(Args a0) {
    extern __shared__ __attribute__((aligned(16))) unsigned char smem[];
    LAS unsigned char* lds = (LAS unsigned char*)smem;
#ifndef DUPMASK
#define DUPMASK 0
#endif
    int dup = 0;
#pragma unroll 1
    for (int ph = a0.ph_lo; ph < a0.ph_hi; ++ph) {
        if (ph == a0.ph_lo && threadIdx.x == 0) { volatile LAS unsigned* st0 = (volatile LAS unsigned*)(lds + (LDS_BYTES - 16)); st0[0] = 0u; st0[1] = 0u; }
        if (ph > a0.ph_lo && a0.coop && !(ph >= 1 && ph < NPH - 1 && (ph - 1) % 10 == 2)) { if (a0.coop == 2) cg::this_grid().sync();                         xcd_barrier((unsigned*)wsp(a0) + WS_BAR / 4, (volatile LAS unsigned*)(lds + (LDS_BYTES - 16))); }
        const Args& a = a0;
#ifndef PHMASK
#define PHMASK 0xFFFFF
#endif
        if (ph == 0) { if (PHMASK & 1) phase_prep(a, smem);
#ifdef DUP_PREP
            __syncthreads(); phase_prep(a, smem);
#endif
            continue; }
        if (ph == NPH - 1) {
#ifdef EXTRA_SYNCS
#pragma unroll 1
            for (int i = 0; i < EXTRA_SYNCS; ++i) cg::this_grid().sync();
#endif
            if (PHMASK & 2) phase_final(a); continue; }
        const int l = (ph - 1) / 10, sp = (ph - 1) % 10;
        pg8::StaticOrder S;
        if (!((PHMASK >> (2 + sp)) & 1)) continue;
        switch (sp) {
        case 0: { pg8::Gemm g{(const bf16_t*)(wsp(a) + WS_XB), (const bf16_t*)(wsp(a) + WS_WIN) + (size_t)l * NPAD * 1024, M, NPAD, 1024}; S.init(M, NPAD, 1024, gdim(), bidx());
            EpiProj E{(bf16_t*)(wsp(a) + WS_PROJ), (const float*)(wsp(a) + WS_SSQA)}; pg8::gemm_phase(lds, g, S, E); } break;
        case 1: phase_tok(a, l, smem);
            __syncthreads();
            phase_chunk(a, l, smem); break;
        case 2: break;
        case 3: phase_scan(a, l, smem); break;
        case 4: phase_aout(a, l); break;
        case 5: { pg8::Gemm g{(const bf16_t*)(wsp(a) + WS_MIX), (const bf16_t*)(wsp(a) + WS_WOUT) + (size_t)l * 1024 * 1024, M, 1024, 1024}; S.init(M, 1024, 1024, gdim(), bidx());
            EpiRes E{(bf16_t*)(wsp(a) + WS_XB), (float*)(wsp(a) + WS_SSQB), nullptr}; pg8::gemm_phase(lds, g, S, E); } break;
        case 6: { pg8::Gemm g{(const bf16_t*)(wsp(a) + WS_XB), (const bf16_t*)(wsp(a) + WS_WGU) + (size_t)l * 5632 * 1024, M, 5632, 1024};
            pg8::SplitOrder S2; S2.init(MP, 5632, 1024, gdim(), bidx()); S2.nks = 4;
            EpiGU E{(bf16_t*)(wsp(a) + WS_PROJ), (const float*)(wsp(a) + WS_SSQB), inp(a, 24) + (size_t)l * 3 * FF, (float*)(wsp(a) + WS_SG), (float*)(wsp(a) + WS_SU),
                    outp(a) + O_SFP + (size_t)l * 8 * 2 * FF, (float*)(wsp(a) + WS_SACC)}; pg8::gemm_phase(lds, g, S2, E); } break;
        case 7: phase_fix(a, l); break;
        case 8: { pg8::Gemm g{(const bf16_t*)(wsp(a) + WS_PROJ), (const bf16_t*)(wsp(a) + WS_WDN) + (size_t)l * 1024 * FF, M, 1024, FF};
            pg8::SplitOrder S2; S2.init(MP, 1024, FF, gdim(), bidx()); S2.nks = 11;
            EpiRes E{(bf16_t*)(wsp(a) + WS_XB), (float*)(wsp(a) + WS_SSQA), (float*)(wsp(a) + WS_SACC)}; pg8::gemm_phase(lds, g, S2, E); } break;
        default: phase_sfin(a); break;
        }
        if (DUPMASK && !dup && ph >= 1 && ph <= 9 && ((DUPMASK >> (ph - 1)) & 1)) { dup = 1; --ph; } else dup = 0;
    }
}

extern "C" void kernel_launch(void* const* d_in, const int* in_sizes, int n_in, void* d_out, int out_size, void* d_ws, size_t ws_size, hipStream_t stream) {
    static int grid = 0;
    if (grid == 0) {
        if (n_in != 27 || (size_t)out_size != O_END || ws_size < WS_END) { fprintf(stderr, "kernel_launch: unexpected sizes n_in %d out %d ws %zu (need %zu)\n", n_in, out_size, ws_size, (size_t)WS_END); grid = -1; return; }
        int dev = 0, cus = 0, per_cu = 0;
        hipGetDevice(&dev); hipDeviceGetAttribute(&cus, hipDeviceAttributeMultiprocessorCount, dev);
        if (hipFuncSetAttribute((const void*)fwd_kernel, hipFuncAttributeMaxDynamicSharedMemorySize, LDS_BYTES) != hipSuccess) { fprintf(stderr, "kernel_launch: hipFuncSetAttribute failed\n"); grid = -1; return; }
        hipOccupancyMaxActiveBlocksPerMultiprocessor(&per_cu, (const void*)fwd_kernel, 512, LDS_BYTES);
        (void)hipGetLastError();
        if (per_cu < 1) per_cu = 1;
        if (cus != 256) { fprintf(stderr, "kernel_launch: built for a 256-CU device (one workgroup per CU), found %d CUs\n", cus); grid = -1; return; }
        grid = 256;
    }
    if (grid < 0) return;
    Args a{};
    for (int i = 0; i < 27; ++i) a.in[i] = (const float*)d_in[i];
    a.out = (float*)d_out; a.ws = (unsigned char*)d_ws;
#if ONE_LAUNCH
    a.coop = 1; a.ph_lo = 0; a.ph_hi = NPH;
    if (hipMemsetAsync((unsigned char*)d_ws + WS_BAR, 0, 16384, stream) != hipSuccess) { fprintf(stderr, "kernel_launch: memset of the barrier words failed\n"); return; }
    void* args[] = {&a};
    hipError_t e = hipLaunchCooperativeKernel((const void*)fwd_kernel, dim3(grid), dim3(512), args, LDS_BYTES, stream);
    if (e != hipSuccess) fprintf(stderr, "cooperative launch failed: %s (grid %d)\n", hipGetErrorString(e), grid);
#else
    a.coop = 0;
    for (int ph = 0; ph < NPH; ++ph) { a.ph_lo = ph; a.ph_hi = ph + 1; hipLaunchKernelGGL(fwd_kernel, dim3(grid), dim3(512), LDS_BYTES, stream, a); }
#endif
}
```

```cpp
#include <hip/hip_runtime.h>
#include <hip/hip_cooperative_groups.h>
#include <cstdio>
namespace cg = cooperative_groups;

#define DEVI __device__ __forceinline__
#define LAS __attribute__((address_space(3)))
typedef unsigned short bf16_t;
typedef short bf16x8 __attribute__((ext_vector_type(8)));
typedef short bf16x4 __attribute__((ext_vector_type(4)));
typedef float f32x4 __attribute__((ext_vector_type(4)));

#ifndef ONE_LAUNCH
#define ONE_LAUNCH 1
#endif

constexpr int MP = 32768, MS = 512, M = MP + MS, DM = 1024, FF = 2816, PS = 2824  , NPAD = 3072;
constexpr int C_AQ = 0, C_AZ = 768, C_BB = 1024, C_BC = 1280, C_BH = 1536, C_CQ = 1792, C_CK = 2048, C_DU = 2304, C_DV = 2560, C_AB = 2816, C_AA = 2820;
constexpr float EPS = 1e-6f;

constexpr size_t O_YP = 0, O_YS = O_YP + (size_t)MP * DM, O_SDP = O_YS + (size_t)MS * DM, O_SDS = O_SDP + 2 * 8 * 4 * 4096, O_SCP = O_SDS + 2 * 128 * 4 * 4096,
                 O_SCS = O_SCP + 2 * 8 * 3 * 768, O_SSP = O_SCS + 2 * 128 * 3 * 768, O_SSS = O_SSP + 2 * 8 * 2 * 256, O_CKP = O_SSS + 2 * 128 * 2 * 256,
                 O_CKS = O_CKP + 2 * 8 * 128 * 128, O_CVP = O_CKS + 2 * 128 * 128 * 128, O_CVS = O_CVP + 2 * 8 * 128 * 128, O_SFP = O_CVS + 2 * 128 * 128 * 128,
                 O_SFS = O_SFP + 2 * 8 * 2 * 2816, O_CHV = O_SFS + 2 * 128 * 2 * 2816, O_END = O_CHV + 2 * 128 * 4 * 256;
static_assert(O_END == 50008064, "output size");

constexpr size_t WS_WIN = 0, WS_WOUT = WS_WIN + (size_t)2 * NPAD * 1024 * 2, WS_WGU = WS_WOUT + (size_t)2 * 1024 * 1024 * 2, WS_WDN = WS_WGU + (size_t)2 * 5632 * 1024 * 2,
                 WS_XB = WS_WDN + (size_t)2 * 1024 * 2816 * 2,
                 WS_PROJ = WS_XB + (size_t)M * 1024 * 2,
                 WS_MIX = WS_PROJ + (size_t)M * PS * 2,
                 WS_SSQA = WS_MIX + (size_t)M * 1024 * 2, WS_SSQB = WS_SSQA + (size_t)M * 16 * 4, WS_BG = WS_SSQB + (size_t)M * 16 * 4,
                 WS_GLS = WS_BG + (size_t)M * 8 * 4,
                 WS_BAR = WS_GLS + 2048 * 4,
                 WS_ROPE = WS_BAR + 16384,
                 WS_QR = WS_ROPE + (size_t)4100 * 16 * 4 + 64,
                 WS_KVR = WS_QR + (size_t)M * 256 * 2, WS_DVN = WS_KVR + (size_t)M * 256 * 2, WS_ORAW = WS_QR,
                 WS_A2 = WS_DVN + (size_t)M * 256 * 2,
                 WS_SG = WS_A2, WS_SU = WS_SG + (size_t)512 * 4 * 2816 * 4,
                 WS_SACC = WS_SU + (size_t)512 * 2 * 2816 * 4,
                 WS_END = WS_A2 + (size_t)2048 * 49152;
static_assert(WS_SACC + (size_t)11 * MS * DM * 4 <= WS_END && WS_SACC + (size_t)4 * MS * 5632 * 4 <= WS_END, "split-K partials");
static_assert(WS_END <= (size_t)536870912, "workspace too large");
static_assert(WS_SU + (size_t)512 * 2 * 2816 * 4 <= WS_END, "side buffers");
static_assert((size_t)M * 256 * 4 <= (size_t)3 * M * 256 * 2, "oraw alias");

constexpr size_t OUT_ORAW = (size_t)M * 768 * 2;
static_assert(OUT_ORAW + (size_t)M * 256 * 4 <= (size_t)MP * DM * 4, "scratch in y region");
struct Args { const float* in[27]; float* out; unsigned char* ws; int coop; int ph_lo; int ph_hi; int pad; };

DEVI int tidx() { int t = threadIdx.x; asm volatile("" : "+v"(t)); return t; }
DEVI int bidx() { int t = blockIdx.x; asm volatile("" : "+s"(t)); return t; }
DEVI int gdim() { int t = gridDim.x; asm volatile("" : "+s"(t)); return t; }
DEVI float bf2f(bf16_t v) { return __uint_as_float(((unsigned)v) << 16); }
DEVI bf16_t f2bf(float f) { unsigned u = __float_as_uint(f); u += 0x7FFFu + ((u >> 16) & 1u); return (bf16_t)(u >> 16); }
DEVI unsigned pk2(float lo, float hi) { unsigned r; asm("v_cvt_pk_bf16_f32 %0, %1, %2" : "=v"(r) : "v"(lo), "v"(hi)); return r; }
DEVI f32x4 ld4bf(const bf16_t* p) { const uint2 u = *(const uint2*)p; f32x4 o; o[0] = __uint_as_float(u.x << 16); o[1] = __uint_as_float(u.x & 0xffff0000u); o[2] = __uint_as_float(u.y << 16); o[3] = __uint_as_float(u.y & 0xffff0000u); return o; }
DEVI f32x4 cv4bf(const uint2 u) { f32x4 o; o[0] = __uint_as_float(u.x << 16); o[1] = __uint_as_float(u.x & 0xffff0000u); o[2] = __uint_as_float(u.y << 16); o[3] = __uint_as_float(u.y & 0xffff0000u); return o; }
DEVI void st4bf(bf16_t* p, f32x4 v) { uint2 u; u.x = pk2(v[0], v[1]); u.y = pk2(v[2], v[3]); *(uint2*)p = u; }
DEVI bf16x8 pack8(f32x4 a, f32x4 b) { union { uint4 u; bf16x8 v; } x; x.u.x = pk2(a[0], a[1]); x.u.y = pk2(a[2], a[3]); x.u.z = pk2(b[0], b[1]); x.u.w = pk2(b[2], b[3]); return x.v; }
typedef unsigned u32x4 __attribute__((ext_vector_type(4)));
DEVI u32x4 pack8e(f32x4 a, f32x4 b) { u32x4 u; u[0] = pk2(a[0], a[1]); u[1] = pk2(a[2], a[3]); u[2] = pk2(b[0], b[1]); u[3] = pk2(b[2], b[3]); return u; }
DEVI uint4 pack8u(f32x4 a, f32x4 b) { uint4 u; u.x = pk2(a[0], a[1]); u.y = pk2(a[2], a[3]); u.z = pk2(b[0], b[1]); u.w = pk2(b[2], b[3]); return u; }

DEVI float silu_f(float y) { return y * __builtin_amdgcn_rcpf(1.f + __expf(-y)); }
DEVI float gelu_f(float x) { const float z = 0.7978845608028654f * (x + 0.044715f * x * x * x); return x * __builtin_amdgcn_rcpf(1.f + __expf(-2.f * z)); }
DEVI f32x4 silu4(f32x4 v) { f32x4 o; for (int i = 0; i < 4; ++i) o[i] = silu_f(v[i]); return o; }
DEVI f32x4 gelu4(f32x4 v) { f32x4 o; for (int i = 0; i < 4; ++i) o[i] = gelu_f(v[i]); return o; }
DEVI float rdlane(float v, int l) { return __builtin_bit_cast(float, __builtin_amdgcn_readlane(__builtin_bit_cast(int, v), l)); }
DEVI void wave_lds_fence() { asm volatile("s_waitcnt lgkmcnt(0)" ::: "memory"); }
template <int CTRL> DEVI float dppf(float x) { return __builtin_bit_cast(float, __builtin_amdgcn_update_dpp(0, __builtin_bit_cast(int, x), CTRL, 0xf, 0xf, true)); }
template <int CTRL> DEVI float dppo(float old, float x) { return __builtin_bit_cast(float, __builtin_amdgcn_update_dpp(__builtin_bit_cast(int, old), __builtin_bit_cast(int, x), CTRL, 0xf, 0xf, false)); }
DEVI float red16(float v) { v += dppf<0x121>(v); v += dppf<0x122>(v); v += dppf<0x124>(v); v += dppf<0x128>(v); return v; }
DEVI float wave_sum(float v) { v = red16(v); v += __shfl_xor(v, 16); v += __shfl_xor(v, 32); return v; }
DEVI float rowscale(const float* ssq, int r) { const f32x4* p = (const f32x4*)(ssq + (size_t)r * 16); const f32x4 a = p[0], b = p[1], c = p[2], d = p[3];
    const float s = (a[0] + a[1] + a[2] + a[3]) + (b[0] + b[1] + b[2] + b[3]) + (c[0] + c[1] + c[2] + c[3]) + (d[0] + d[1] + d[2] + d[3]); return rsqrtf(s * (1.f / 1024.f) + EPS); }
#define GLB __attribute__((address_space(1)))
typedef const __attribute__((address_space(4))) Args* KArgs;
DEVI KArgs kargs() { KArgs p = (KArgs)__builtin_amdgcn_kernarg_segment_ptr(); asm volatile("" : "+s"(p)); return p; }
DEVI unsigned char* wsp(const Args&) { return (unsigned char*)(GLB unsigned char*)kargs()->ws; }
DEVI float* outp(const Args&) { return (float*)(GLB float*)kargs()->out; }
DEVI const float* inp(const Args&, int k) { return (const float*)(GLB const float*)kargs()->in[k]; }
#define MFMA16(a, b, c) __builtin_amdgcn_mfma_f32_16x16x32_bf16((a), (b), (c), 0, 0, 0)

namespace pg8 {
constexpr int BM = 256, BK = 64, HALF = 128, HTB = HALF * BK * 2, STAGE_BYTES = 8 * HTB, NXCD = 8, WGM = 8;
DEVI int lds_byte(int r, int c) { const int st = (r >> 4) * 2 + (c >> 5), rr = r & 15, cc = c & 31, ob = rr * 64 + cc * 2; return st * 1024 + (ob ^ (((ob >> 9) & 1) << 5)); }
DEVI void stage_rc(int b, int& R, int& C) { const int st = b / 1024, sb = b % 1024, swz = sb ^ (((sb >> 9) & 1) << 5); R = (st >> 1) * 16 + swz / 64; C = (st & 1) * 32 + (swz % 64) / 2; }
DEVI int perm32(int rho) { const int n = rho >> 4, i = rho & 15; return 8 * (i >> 2) + 4 * n + (i & 3); }
struct Unit { int pm, pn, k0, nt; };
struct Gemm { const bf16_t* A; const bf16_t* Bt; int M, N, K; };
struct StaticOrder {
    int nM, nN, nwg, G, c, ntf;
    DEVI void init(int M_, int N_, int K_, int G_, int c_) { nM = M_ / BM; nN = N_ / BM; nwg = nM * nN; G = G_; c = c_; ntf = K_ / BK; }
    DEVI bool next(int i, Unit& u) const {
        const long L = (long)i * G + c; if (L >= nwg) return false;
        int wgid = (int)L; { const int q = nwg / NXCD, r = nwg % NXCD, xcd = wgid % NXCD, off = wgid / NXCD; wgid = (xcd < r ? xcd * (q + 1) : r * (q + 1) + (xcd - r) * q) + off; }
        const int nig = WGM * nN, gid = wgid / nig, fm = gid * WGM, gsz = (nM - fm) < WGM ? (nM - fm) : WGM;
        u.pm = fm + ((wgid % nig) % gsz); u.pn = (wgid % nig) / gsz; u.k0 = 0; u.nt = ntf; return true;
    }
    DEVI void a_ready(const Unit&) const {}
    DEVI void done(const Unit&) const {}
};
struct SplitOrder : StaticOrder {
    int nks;
    DEVI bool next(int i, Unit& u) const {
        if (StaticOrder::next(i, u)) return true;
        const long j = (long)i * G + c - nwg; if (j >= 2L * nN * nks) return false;
        const int un = (int)j / nks, ks = (int)j % nks; u.pm = nM + un / nN; u.pn = un % nN; u.k0 = ks * 256; u.nt = 4; return true;
    }
};
template <class Epi, class Sched>
DEVI void gemm_phase(LAS unsigned char* lds, const Gemm g, const Sched& S, const Epi& E) {
    const int tid = tidx(), wid = __builtin_amdgcn_readfirstlane(tid >> 6), lane = tid & 63, wr = wid >> 2, wc = wid & 3, fr = lane & 15, fq = lane >> 4;
    const int K = g.K;
    unsigned voffA[2], voffB[2];
#pragma unroll
    for (int i = 0; i < 2; ++i) { int R, C; stage_rc(tid * 16 + i * 8192, R, C); const int Rb = Epi::PERM ? ((R & ~31) + perm32(R & 31)) : R;
        voffA[i] = (unsigned)(R * K + C) * 2u; voffB[i] = (unsigned)(Rb * K + C) * 2u; }
    const size_t kstep = (size_t)(BK * 2);
    const size_t hstep = (size_t)HALF * K * 2;
    const size_t tstep = 2 * hstep;
    const unsigned ldsw = (unsigned)wid * 1024u;
    const int aoff = lds_byte(wr * 64 + fr, fq * 8), boff = lds_byte(wc * 32 + fr, fq * 8);
#define PG8_SA(b, h) (((b) * 2 + (h)) * HTB)
#define PG8_SB(b, h) ((4 + (b) * 2 + (h)) * HTB)
#define PG8_STAGE(bufoff, gbase, voff) do { _Pragma("unroll") for (int _i = 0; _i < 2; ++_i) \
        __builtin_amdgcn_global_load_lds((const unsigned*)((const char*)(gbase) + (voff)[_i]), (LAS unsigned*)(lds + (bufoff) + ldsw + _i * 8192), 16, 0, 0); } while (0)
#define PG8_LDA(dst, b, h) do { _Pragma("unroll") for (int m = 0; m < 4; ++m) _Pragma("unroll") for (int k = 0; k < 2; ++k) dst[m][k] = *(const LAS bf16x8*)(lds + PG8_SA(b, h) + aoff + m * 2048 + k * 1024); } while (0)
#define PG8_LDB(dst, b, h) do { _Pragma("unroll") for (int n = 0; n < 2; ++n) _Pragma("unroll") for (int k = 0; k < 2; ++k) dst[n][k] = *(const LAS bf16x8*)(lds + PG8_SB(b, h) + boff + n * 2048 + k * 1024); } while (0)
#define PG8_MMA(ai, bj, At, Bt) do { __builtin_amdgcn_s_setprio(1); _Pragma("unroll") for (int m = 0; m < 4; ++m) _Pragma("unroll") for (int n = 0; n < 2; ++n) _Pragma("unroll") for (int k = 0; k < 2; ++k) \
        acc[ai][bj][m][n] = __builtin_amdgcn_mfma_f32_16x16x32_bf16(Bt[n][k], At[m][k], acc[ai][bj][m][n], 0, 0, 0); __builtin_amdgcn_s_setprio(0); } while (0)
#define PG8_WAIT_V(n) asm volatile("s_waitcnt vmcnt(" #n ")" ::: "memory")
#define PG8_WAIT_L(n) asm volatile("s_waitcnt lgkmcnt(" #n ")" ::: "memory")
#define PG8_BAR __builtin_amdgcn_s_barrier()
#define PG8_SCHED __builtin_amdgcn_sched_barrier(0)
    Unit cur, nxt; int ui = 0;
    if (!S.next(0, cur)) return;
#ifndef STAG_TICKS
#define STAG_TICKS 0
#endif
    if (STAG_TICKS) {
        const unsigned long long t0 = __builtin_amdgcn_s_memrealtime(), dl = (unsigned long long)((S.c >> 3) & 7) * STAG_TICKS;
        while (__builtin_amdgcn_s_memrealtime() - t0 < dl) __builtin_amdgcn_s_sleep(8);
    }
    f32x4 acc[2][2][4][2];
#pragma unroll
    for (int a = 0; a < 2; ++a)
#pragma unroll
        for (int b = 0; b < 2; ++b)
#pragma unroll
            for (int m = 0; m < 4; ++m)
#pragma unroll
                for (int n = 0; n < 2; ++n) acc[a][b][m][n] = (f32x4){0.f, 0.f, 0.f, 0.f};
    bf16x8 At[4][2], B0[2][2], B1[2][2];
    const char* cA = (const char*)g.A + (size_t)cur.pm * tstep + (size_t)cur.k0 * 2; const char* cB = (const char*)g.Bt + (size_t)cur.pn * tstep + (size_t)cur.k0 * 2;
    S.a_ready(cur);
    PG8_STAGE(PG8_SB(0, 0), cB, voffB); PG8_STAGE(PG8_SA(0, 0), cA, voffA); PG8_STAGE(PG8_SB(0, 1), cB + hstep, voffB); PG8_STAGE(PG8_SA(0, 1), cA + hstep, voffA);
    if (wr == 1) PG8_BAR;
    PG8_WAIT_V(4); PG8_BAR;
    PG8_STAGE(PG8_SB(1, 0), cB + kstep, voffB); PG8_STAGE(PG8_SA(1, 0), cA + kstep, voffA); PG8_STAGE(PG8_SB(1, 1), cB + hstep + kstep, voffB);
    PG8_WAIT_V(6); PG8_BAR;
    for (;;) {
        const bool has_next = S.next(ui + 1, nxt);
        const char* nA = has_next ? (const char*)g.A + (size_t)nxt.pm * tstep + (size_t)nxt.k0 * 2 : cA; const char* nB = has_next ? (const char*)g.Bt + (size_t)nxt.pn * tstep + (size_t)nxt.k0 * 2 : cB;
        const int nt = cur.nt;
        for (int t = 0; t < nt; t += 2) {
            const bool last = (t == nt - 2);
            const char* a1 = cA + (size_t)(t + 1) * kstep;
            const char* a2 = last ? nA : cA + (size_t)(t + 2) * kstep; const char* b2 = last ? nB : cB + (size_t)(t + 2) * kstep;
            const char* a3 = a2 + kstep; const char* b3 = b2 + kstep;
            if (last && has_next) S.a_ready(nxt);
            PG8_LDB(B0, 0, 0); PG8_SCHED; PG8_LDA(At, 0, 0); PG8_STAGE(PG8_SA(1, 1), a1 + hstep, voffA);
            PG8_WAIT_L(8); PG8_BAR; PG8_WAIT_L(0); PG8_MMA(0, 0, At, B0); PG8_BAR; PG8_SCHED;
            PG8_LDB(B1, 0, 1); PG8_STAGE(PG8_SB(0, 0), b2, voffB);
            PG8_BAR; PG8_WAIT_L(0); PG8_MMA(0, 1, At, B1); PG8_BAR;
            PG8_LDA(At, 0, 1); PG8_STAGE(PG8_SA(0, 0), a2, voffA);
            PG8_BAR; PG8_WAIT_L(0); PG8_MMA(1, 0, At, B0); PG8_BAR; PG8_SCHED;
            PG8_STAGE(PG8_SB(0, 1), b2 + hstep, voffB);
            PG8_WAIT_V(6); PG8_BAR; PG8_MMA(1, 1, At, B1); PG8_BAR;
            PG8_LDB(B0, 1, 0); PG8_SCHED; PG8_LDA(At, 1, 0); PG8_STAGE(PG8_SA(0, 1), a2 + hstep, voffA);
            PG8_WAIT_L(8); PG8_BAR; PG8_WAIT_L(0); PG8_MMA(0, 0, At, B0); PG8_BAR; PG8_SCHED;
            PG8_LDB(B1, 1, 1); PG8_STAGE(PG8_SB(1, 0), b3, voffB);
            PG8_BAR; PG8_WAIT_L(0); PG8_MMA(0, 1, At, B1); PG8_BAR;
            PG8_LDA(At, 1, 1); PG8_STAGE(PG8_SA(1, 0), a3, voffA);
            PG8_BAR; PG8_WAIT_L(0); PG8_MMA(1, 0, At, B0); PG8_BAR; PG8_SCHED;
            PG8_STAGE(PG8_SB(1, 1), b3 + hstep, voffB);
            PG8_WAIT_V(6); PG8_BAR; PG8_MMA(1, 1, At, B1); PG8_BAR;
        }
        E(acc, cur, wr, wc, fr, fq); S.done(cur);
#ifdef EPI_TWICE
        if (Epi::TWICE) E(acc, cur, wr, wc, fr, fq);
#endif
        if (!has_next) break;
#pragma unroll
        for (int a = 0; a < 2; ++a)
#pragma unroll
            for (int b = 0; b < 2; ++b)
#pragma unroll
                for (int m = 0; m < 4; ++m)
#pragma unroll
                    for (int n = 0; n < 2; ++n) acc[a][b][m][n] = (f32x4){0.f, 0.f, 0.f, 0.f};
        cur = nxt; cA = nA; cB = nB; ++ui;
    }
    PG8_WAIT_V(0);
    if (wr == 0) PG8_BAR;
    PG8_BAR;
#undef PG8_SA
#undef PG8_SB
#undef PG8_STAGE
#undef PG8_LDA
#undef PG8_LDB
#undef PG8_MMA
#undef PG8_WAIT_V
#undef PG8_WAIT_L
#undef PG8_BAR
#undef PG8_SCHED
}
}
using pg8::Unit;

struct EpiProj {
    static constexpr bool PERM = true, TWICE = true;
    bf16_t* P; const float* ssq;
    DEVI void operator()(const f32x4 (&acc)[2][2][4][2], const Unit& u, int wr, int wc, int fr, int fq) const {
        const int row0 = u.pm * 256 + wr * 64 + fr, colb = u.pn * 256 + wc * 32 + 8 * fq;
#pragma unroll
        for (int ai = 0; ai < 2; ++ai)
#pragma unroll
            for (int m = 0; m < 4; ++m) { const int r = row0 + ai * 128 + m * 16; const float sc = rowscale(ssq, r);
#pragma unroll
                for (int bj = 0; bj < 2; ++bj) { const int c = colb + bj * 128;
                    if (c < PS) *(uint4*)(P + (size_t)r * PS + c) = pack8u(acc[ai][bj][m][0] * sc, acc[ai][bj][m][1] * sc); } }
    }
};
struct EpiRes {
    static constexpr bool PERM = true, TWICE = false;
    bf16_t* xb; float* ssq; float* sacc;
    DEVI void operator()(const f32x4 (&acc)[2][2][4][2], const Unit& u, int wr, int wc, int fr, int fq) const {
        const int row0 = u.pm * 256 + wr * 64 + fr, colb = u.pn * 256 + wc * 32 + 8 * fq;
        if (sacc != nullptr && u.pm >= 128) {
#pragma unroll
            for (int ai = 0; ai < 2; ++ai)
#pragma unroll
                for (int m = 0; m < 4; ++m) { float* dp = sacc + (size_t)(u.k0 >> 8) * ((size_t)MS * DM) + (size_t)(row0 + ai * 128 + m * 16 - MP) * DM + colb;
#pragma unroll
                    for (int bj = 0; bj < 2; ++bj) { *(f32x4*)(dp + bj * 128) = acc[ai][bj][m][0]; *(f32x4*)(dp + bj * 128 + 4) = acc[ai][bj][m][1]; } }
            return;
        }
#pragma unroll
        for (int ai = 0; ai < 2; ++ai)
#pragma unroll
            for (int m = 0; m < 4; ++m) { const int r = row0 + ai * 128 + m * 16; float part = 0.f;
#pragma unroll
                for (int bj = 0; bj < 2; ++bj) { const int c = colb + bj * 128; bf16_t* xp = xb + (size_t)r * DM + c;
                    const uint4 rv = *(const uint4*)xp;
                    const f32x4 v0 = acc[ai][bj][m][0] + cv4bf((uint2){rv.x, rv.y}), v1 = acc[ai][bj][m][1] + cv4bf((uint2){rv.z, rv.w});
                    *(uint4*)xp = pack8u(v0, v1);
                    part += v0[0] * v0[0] + v0[1] * v0[1] + v0[2] * v0[2] + v0[3] * v0[3] + v1[0] * v1[0] + v1[1] * v1[1] + v1[2] * v1[2] + v1[3] * v1[3]; }
                part += __shfl_xor(part, 16); part += __shfl_xor(part, 32);
                if (fq == 0) ssq[(size_t)r * 16 + u.pn * 4 + wc] = part; }
    }
};
struct EpiGU {
    static constexpr bool PERM = true, TWICE = false;
    bf16_t* act; const float* ssq; const float* cw; float* sg; float* su; float* osfp; float* sacc;
    DEVI void operator()(const f32x4 (&acc)[2][2][4][2], const Unit& u, int wr, int wc, int fr, int fq) const {
        if (u.pm >= 128) {
            const int row0 = u.pm * 256 + wr * 64 + fr - MP, colb = u.pn * 256 + wc * 32 + 8 * fq;
#pragma unroll
            for (int ai = 0; ai < 2; ++ai)
#pragma unroll
                for (int m = 0; m < 4; ++m) { float* dp = sacc + (size_t)(u.k0 >> 8) * ((size_t)MS * 5632) + (size_t)(row0 + ai * 128 + m * 16) * 5632 + colb;
#pragma unroll
                    for (int bj = 0; bj < 2; ++bj) { *(f32x4*)(dp + bj * 128) = acc[ai][bj][m][0]; *(f32x4*)(dp + bj * 128 + 4) = acc[ai][bj][m][1]; } }
            return;
        }
        const int f0 = u.pn * 128 + wc * 32 + 8 * fq;
        const f32x4 w0a = *(const f32x4*)(cw + f0), w0b = *(const f32x4*)(cw + f0 + 4), w1a = *(const f32x4*)(cw + FF + f0), w1b = *(const f32x4*)(cw + FF + f0 + 4),
                    w2a = *(const f32x4*)(cw + 2 * FF + f0), w2b = *(const f32x4*)(cw + 2 * FF + f0 + 4);
#pragma unroll
        for (int ai = 0; ai < 2; ++ai) {
            const int rb = u.pm * 256 + ai * 128 + wr * 64;
            f32x4 pva = {0.f, 0.f, 0.f, 0.f}, pvb = {0.f, 0.f, 0.f, 0.f};
#pragma unroll
            for (int m = 0; m < 4; ++m) {
                const int r = rb + 16 * m + fr;
                const float scm = rowscale(ssq, r);
                const f32x4 ga0 = acc[ai][0][m][0] * scm, gb0 = acc[ai][0][m][1] * scm;
                const f32x4 ua = acc[ai][1][m][0] * scm, ub = acc[ai][1][m][1] * scm;
                f32x4 p1a, p1b, p2a, p2b;
#pragma unroll
                for (int jj = 0; jj < 4; ++jj) {
                    const float ca = ga0[jj], cb = gb0[jj], pa = pva[jj], pb = pvb[jj];
                    p1a[jj] = dppo<0x111>(dppf<0x10F>(pa), ca); p2a[jj] = dppo<0x112>(dppf<0x10E>(pa), ca);
                    p1b[jj] = dppo<0x111>(dppf<0x10F>(pb), cb); p2b[jj] = dppo<0x112>(dppf<0x10E>(pb), cb);
                }
                const bool head = m == 0 && fr < 2;
                if (!head) {
                    const f32x4 ga = w0a * p2a + w1a * p1a + w2a * ga0, gb = w0b * p2b + w1b * p1b + w2b * gb0;
                    *(uint4*)(act + (size_t)r * FF + f0) = pack8u(silu4(ga) * ua, silu4(gb) * ub);
                }
                const int blk = rb >> 6;
                if (m == 0 && fr < 2) { float* o = sg + ((size_t)blk * 4 + fr) * FF + f0; *(f32x4*)o = ga0; *(f32x4*)(o + 4) = gb0;
                    float* o2 = su + ((size_t)blk * 2 + fr) * FF + f0; *(f32x4*)o2 = ua; *(f32x4*)(o2 + 4) = ub; }
                if (m == 3 && fr >= 14) { float* o = sg + ((size_t)blk * 4 + 2 + (fr - 14)) * FF + f0; *(f32x4*)o = ga0; *(f32x4*)(o + 4) = gb0;
                    const int t = r & 4095; if (t >= 4094) { float* o3 = osfp + ((size_t)(r >> 12) * 2 + (t - 4094)) * FF + f0; *(f32x4*)o3 = ga0; *(f32x4*)(o3 + 4) = gb0; } }
                pva = ga0; pvb = gb0;
            }
        }
    }
};

__device__ void phase_prep(const Args& a, unsigned char* smem) {
    float* tile = (float*)smem;
    const int tid = tidx(), tx = tid & 63, ty = tid >> 6, lane = tid & 63, wid = tid >> 6;
    constexpr int T_IN = 48 * 4, T_OUT = 16 * 4, T_GU = 88 * 4, T_DN = 16 * 11, T_L = T_IN + T_OUT + T_GU + T_DN;
    for (int it = bidx(); it < 2 * T_L; it += gdim()) {
        const int l = it / T_L; int r = it % T_L;
        const float* src; int ld, col, kt, nt, Kd; const float* gk = nullptr; bf16_t* dst;
        if (r < T_IN) { nt = r / 4; kt = r % 4; Kd = 1024; ld = PS; src = inp(a, 9) + (size_t)l * 1024 * PS; gk = inp(a, 8) + l * 1024; dst = (bf16_t*)(wsp(a) + WS_WIN) + (size_t)l * NPAD * 1024;
            const int n = nt * 64 + tx; col = n < 1024 ? n : (n < 2816 ? n + 8 : (n < 2824 ? 1024 + (n - 2816) : -1)); }
        else if ((r -= T_IN) < T_OUT) { nt = r / 4; kt = r % 4; Kd = 1024; ld = 1024; src = inp(a, 20) + (size_t)l * 1024 * 1024; dst = (bf16_t*)(wsp(a) + WS_WOUT) + (size_t)l * 1024 * 1024; col = nt * 64 + tx; }
        else if ((r -= T_OUT) < T_GU) { nt = r / 4; kt = r % 4; Kd = 1024; ld = FF; gk = inp(a, 21) + l * 1024; dst = (bf16_t*)(wsp(a) + WS_WGU) + (size_t)l * 5632 * 1024;
            const int n = nt * 64, pn = n >> 8, cc = n & 255; src = (cc < 128 ? inp(a, 22) : inp(a, 23)) + (size_t)l * 1024 * FF; col = pn * 128 + (cc & 127) + tx; }
        else { r -= T_GU; nt = r / 11; kt = r % 11; Kd = FF; ld = 1024; src = inp(a, 25) + (size_t)l * FF * 1024; dst = (bf16_t*)(wsp(a) + WS_WDN) + (size_t)l * 1024 * FF; col = nt * 64 + tx; }
        float v[32];
#pragma unroll
        for (int i = 0; i < 32; ++i) { const int k = kt * 256 + ty + 8 * i; v[i] = col >= 0 ? __builtin_nontemporal_load(src + (size_t)k * ld + col) : 0.f; }
        if (gk) {
#pragma unroll
            for (int i = 0; i < 32; ++i) v[i] *= gk[kt * 256 + ty + 8 * i]; }
#pragma unroll
        for (int i = 0; i < 32; ++i) tile[(ty + 8 * i) * 65 + tx] = v[i];
        __syncthreads();
#pragma unroll
        for (int i = 0; i < 8; ++i) { const int n = wid * 8 + i; const int k0 = lane * 4;
            f32x4 o = {tile[(k0 + 0) * 65 + n], tile[(k0 + 1) * 65 + n], tile[(k0 + 2) * 65 + n], tile[(k0 + 3) * 65 + n]};
            st4bf(dst + (size_t)(nt * 64 + n) * Kd + kt * 256 + k0, o); }
        __syncthreads();
    }
    {   float* rt = (float*)(wsp(a) + WS_ROPE);
        for (int i = bidx() * 512 + tid; i < 4100 * 8; i += gdim() * 512) { const int pi = i >> 3, fi = i & 7, pos = pi < 4096 ? pi : 16384 + (pi - 4096);
            const float ang = (float)pos * powf(500000.f, -(float)fi * 0.125f); const double rd = (double)ang * 0.15915494309189535; const float rr = (float)((rd - floor(rd)) * 6.283185307179586);
            rt[pi * 16 + fi] = __cosf(rr); rt[pi * 16 + 8 + fi] = __sinf(rr); } }
    bf16_t* xb = (bf16_t*)(wsp(a) + WS_XB); float* ssq = (float*)(wsp(a) + WS_SSQA);
    for (int r = bidx() * 8 + wid; r < M; r += gdim() * 8) {
        const float* xr = (r < MP) ? inp(a, 0) + (size_t)r * DM : inp(a, 1) + (size_t)(r - MP) * DM; float ss = 0.f;
#pragma unroll
        for (int q = 0; q < 4; ++q) { const f32x4 v = __builtin_nontemporal_load((const f32x4*)(xr + q * 256 + lane * 4)); ss += v[0] * v[0] + v[1] * v[1] + v[2] * v[2] + v[3] * v[3]; st4bf(xb + (size_t)r * DM + q * 256 + lane * 4, v); }
        ss = wave_sum(ss);
        if (lane < 16) ssq[(size_t)r * 16 + lane] = lane == 0 ? ss : 0.f;
    }
}

struct TokRaw { uint2 a0, a1, a2, bc, bh, bb, q, kv, dv, du; f32x4 cs, sn; };
DEVI TokRaw ldtok(const bf16_t* pr, const float* rp, int c4, int lane) { TokRaw t; t.cs = *(const f32x4*)(rp + 4 * (lane & 1)); t.sn = *(const f32x4*)(rp + 8 + 4 * (lane & 1)); t.a0 = *(const uint2*)(pr + C_AQ + c4); t.a1 = *(const uint2*)(pr + C_AQ + 256 + c4); t.a2 = *(const uint2*)(pr + C_AQ + 512 + c4);
    t.bc = *(const uint2*)(pr + C_BC + c4); t.bh = *(const uint2*)(pr + C_BH + c4); t.bb = *(const uint2*)(pr + C_BB + c4); t.q = *(const uint2*)(pr + C_CQ + c4); t.kv = *(const uint2*)(pr + C_CK + c4);
    t.dv = *(const uint2*)(pr + C_DV + c4); t.du = *(const uint2*)(pr + C_DU + c4); return t; }
__device__ void phase_tok(const Args& a, const int l, unsigned char* smem) {
    const int lane = tidx() & 63, wid = tidx() >> 6, c4 = lane * 4;
    const bf16_t* proj = (const bf16_t*)(wsp(a) + WS_PROJ);
    bf16_t* qkvn = (bf16_t*)outp(a); bf16_t* mix = (bf16_t*)(wsp(a) + WS_MIX); float* bg = (float*)(wsp(a) + WS_BG);
    bf16_t* qr = (bf16_t*)(wsp(a) + WS_QR); bf16_t* kvr = (bf16_t*)(wsp(a) + WS_KVR); bf16_t* dvn = (bf16_t*)(wsp(a) + WS_DVN);
    float* out = outp(a);
    float* sw = (float*)smem;
    for (int i = tidx(); i < 4352; i += 512) sw[i] = i < 3072 ? inp(a, 10)[(size_t)l * 3072 + i] : (i < 3840 ? inp(a, 14)[(size_t)l * 768 + i - 3072] : (i < 4096 ? inp(a, 16)[l * 256 + i - 3840] : inp(a, 17)[l * 256 + i - 4096]));
    __syncthreads();
    const float* cwp = sw + c4;
    const float* bwp = sw + 3072 + c4; const float* lngp = sw + 3840 + c4; const float* lnbp = sw + 4096 + c4;
    float inv[4];
#pragma unroll
    for (int e = 0; e < 4; ++e) inv[e] = powf(500000.f, -(float)(4 * (lane & 1) + e) * 0.125f);
    const int j16 = lane & 15, gD = lane >> 4;
    const float dtb = inp(a, 12)[l * 4 + (lane & 3)], nega = -__expf(inp(a, 11)[l * 4 + (lane & 3)]);
    const float* Wd = inp(a, 18) + ((size_t)(l * 4 + gD) * 128) * 128; const float* biasd = inp(a, 19) + (size_t)(l * 4 + gD) * 128;
    {
        const float* ck = inp(a, 5) + (size_t)l * 128 * 16384; const float* cv = inp(a, 6) + (size_t)l * 128 * 16384;
        float* ok = out + O_CKS + (size_t)l * 128 * 16384; float* ov = out + O_CVS + (size_t)l * 128 * 16384;
        for (int i = bidx() * 512 + tidx(); i < 128 * 3968; i += gdim() * 512) { const int bb = i / 3968, j = i - bb * 3968; const size_t o = (size_t)bb * 16384 + (size_t)j * 4;
            *(f32x4*)(ok + o) = *(const f32x4*)(ck + o + 512); *(f32x4*)(ov + o) = *(const f32x4*)(cv + o + 512); }
    }
    for (int pass = 0; pass < 2; ++pass) {
        const int B = bidx();
        bool smp; int b, t0, ntok; size_t r0;
        if (pass == 0) { smp = false; b = B >> 5; int off = 16 * wid, len = 16;
            if (B < 128) { off = wid < 4 ? 17 * wid : 68 + 16 * (wid - 4); len = wid < 4 ? 17 : (wid < 7 ? 16 : 12); }
            t0 = (B & 31) * 128 + off; ntok = len; r0 = (size_t)b * 4096 + t0; }
        else { if (!(wid == 7 && B < 128)) break; smp = true; b = B; t0 = 0; ntok = 4; r0 = (size_t)MP + 4 * b; }
        f32x4 ha[3][3], hb[2];
        const f32x4 z4 = {0.f, 0.f, 0.f, 0.f};
        if (smp) {
            const float* st = inp(a, 3) + ((size_t)(l * 128 + b) * 3) * 768;
#pragma unroll
            for (int p = 0; p < 3; ++p)
#pragma unroll
                for (int j = 0; j < 3; ++j) ha[p][j] = *(const f32x4*)(st + j * 768 + p * 256 + c4);
            const float* sb = inp(a, 4) + ((size_t)(l * 128 + b) * 2) * 256; hb[0] = *(const f32x4*)(sb + c4); hb[1] = *(const f32x4*)(sb + 256 + c4);
        } else if (t0 == 0) {
#pragma unroll
            for (int p = 0; p < 3; ++p)
#pragma unroll
                for (int j = 0; j < 3; ++j) ha[p][j] = z4;
            hb[0] = z4; hb[1] = z4;
        } else {
#pragma unroll
            for (int p = 0; p < 3; ++p)
#pragma unroll
                for (int j = 0; j < 3; ++j) ha[p][j] = ld4bf(proj + (r0 - 3 + j) * PS + C_AQ + p * 256 + c4);
#pragma unroll
            for (int j = 0; j < 2; ++j) hb[j] = ld4bf(proj + (r0 - 2 + j) * PS + C_BC + c4) * ld4bf(proj + (r0 - 2 + j) * PS + C_BH + c4);
        }
        f32x4 h0 = z4, h1 = z4, h2 = z4, h3 = z4;
        {
            const int hh = lane & 3;
            for (int ti = lane >> 2; ti < ntok; ti += 16) { const bf16_t* pr = proj + (r0 + ti) * PS;
                const float ab = bf2f(pr[C_AB + hh]), aa = bf2f(pr[C_AA + hh]);
                const float beta = __builtin_amdgcn_rcpf(1.f + __expf(-ab)); const float x = aa + dtb; const float sp = x > 20.f ? x : log1pf(__expf(x));
                bg[(r0 + ti) * 8 + hh] = beta; bg[(r0 + ti) * 8 + 4 + hh] = nega * sp; }
        }
        const float* ropet = (const float*)(wsp(a) + WS_ROPE) + (size_t)(smp ? 4096 : t0) * 16;
        TokRaw nx = ldtok(proj + r0 * PS, ropet, c4, lane);
#pragma unroll 1
        for (int i = 0; i < ntok; ++i) {
            const size_t r = r0 + i; const int t = t0 + i;
            const TokRaw tk = nx;
            const float* cwq = cwp; const float* bwq = bwp;
            nx = ldtok(proj + (r0 + (i + 1 < ntok ? i + 1 : i)) * PS, ropet + (i + 1 < ntok ? i + 1 : i) * 16, c4, lane);
#pragma unroll
            for (int p = 0; p < 3; ++p) {
                const f32x4 cur = cv4bf(p == 0 ? tk.a0 : (p == 1 ? tk.a1 : tk.a2));
                f32x4 s = silu4(*(const f32x4*)(cwq + p * 256) * ha[p][0] + *(const f32x4*)(cwq + 768 + p * 256) * ha[p][1] + *(const f32x4*)(cwq + 1536 + p * 256) * ha[p][2] + *(const f32x4*)(cwq + 2304 + p * 256) * cur);
                ha[p][0] = ha[p][1]; ha[p][1] = ha[p][2]; ha[p][2] = cur;
                if (p < 2) { float ss = red16(s[0] * s[0] + s[1] * s[1] + s[2] * s[2] + s[3] * s[3]); const float sc = rsqrtf(ss + EPS) * (p == 0 ? 0.125f : 1.f); s = s * sc; }
                st4bf(qkvn + r * 768 + p * 256 + c4, s);
                if (!smp) { if (t >= 4093) *(f32x4*)(out + O_SCP + ((size_t)(l * 8 + b) * 3 + (t - 4093)) * 768 + p * 256 + c4) = cur; }
                else if (i >= 1) *(f32x4*)(out + O_SCS + ((size_t)(l * 128 + b) * 3 + (i - 1)) * 768 + p * 256 + c4) = cur;
            }
            {
                const f32x4 s = cv4bf(tk.bc) * cv4bf(tk.bh), bb = cv4bf(tk.bb);
                const f32x4 bx = *(const f32x4*)bwq * hb[0] + *(const f32x4*)(bwq + 256) * hb[1] + *(const f32x4*)(bwq + 512) * s;
                st4bf(mix + r * DM + 256 + c4, bb * bx); hb[0] = hb[1]; hb[1] = s;
                if (!smp) { if (t >= 4094) *(f32x4*)(out + O_SSP + ((size_t)(l * 8 + b) * 2 + (t - 4094)) * 256 + c4) = s; }
                else if (i >= 2) *(f32x4*)(out + O_SSS + ((size_t)(l * 128 + b) * 2 + (i - 2)) * 256 + c4) = s;
            }
            {
                f32x4 q = cv4bf(tk.q), kv = cv4bf(tk.kv), qo, ko;
#pragma unroll
                for (int e = 0; e < 4; ++e) { qo[e] = dppf<0x4E>(q[e]); ko[e] = dppf<0x4E>(kv[e]); }
                if (j16 < 4) {
                    const float sgn = j16 < 2 ? -1.f : 1.f;
#pragma unroll
                    for (int e = 0; e < 4; ++e) {
                        const float cs = tk.cs[e], sn = tk.sn[e];
                        q[e] = q[e] * cs + sgn * qo[e] * sn;
                        if (lane < 32) kv[e] = kv[e] * cs + sgn * ko[e] * sn;
                    }
                }
                st4bf(qr + r * 256 + c4, q); st4bf(kvr + r * 256 + c4, kv);
                if (!smp) { if (t >= 3968) { float* o = (lane < 32 ? out + O_CKP : out + O_CVP) + ((size_t)(l * 8 + b) * 128 + (t - 3968)) * 128 + (c4 & 127); *(f32x4*)o = kv; } }
                else { float* o = (lane < 32 ? out + O_CKS : out + O_CVS) + ((size_t)(l * 128 + b) * 128 + 124 + i) * 128 + (c4 & 127); *(f32x4*)o = kv; }
            }
            {
                const f32x4 x = gelu4(cv4bf(tk.dv));
                const float mean = wave_sum(x[0] + x[1] + x[2] + x[3]) * (1.f / 256.f);
                const f32x4 xc = x - mean;
                const float var = wave_sum(xc[0] * xc[0] + xc[1] * xc[1] + xc[2] * xc[2] + xc[3] * xc[3]) * (1.f / 256.f);
                const f32x4 y = xc * rsqrtf(var + EPS) * *(const f32x4*)lngp + *(const f32x4*)lnbp;
                st4bf(dvn + r * 256 + c4, y);
                if (smp) {
                    *(f32x4*)(out + O_CHV + ((size_t)(l * 128 + b) * 4 + i) * 256 + c4) = y;
                    if (i == 0) h0 = y; else if (i == 1) h1 = y; else if (i == 2) h2 = y; else h3 = y;
                    f32x4 mx = Wd[i * 128 + 0] * h0 + biasd[i];
                    if (i >= 1) mx = mx + Wd[i * 128 + 1] * h1;
                    if (i >= 2) mx = mx + Wd[i * 128 + 2] * h2;
                    if (i >= 3) mx = mx + Wd[i * 128 + 3] * h3;
                    st4bf(mix + r * DM + 768 + c4, gelu4(cv4bf(tk.du)) * mx);
                }
            }
        }
    }
}

constexpr int A2_LDS = 64 * 68 * 4 + 512;
DEVI int fragidx(int row, int col) { return (((row >> 4) * 2 + (col >> 5)) * 64 + ((col >> 2) & 3) * 16 + (row & 15)) * 8 + 4 * ((col >> 4) & 1) + (col & 3); }
__device__ void a2_item(const Args& a, const int it, unsigned char* wl) {
    const int lane = tidx() & 63, fr = lane & 15, fq = lane >> 4;
    float* Aw = (float*)wl; float* gcs = Aw + 64 * 68; float* bts = gcs + 64;
    const int h = it & 3, n = (it >> 2) & 63, b = it >> 8;
    const size_t t0 = (size_t)b * 4096 + n * 64;
    const float* bg = (const float*)(wsp(a) + WS_BG); const bf16_t* qkvn = (const bf16_t*)outp(a);
    float gcv = bg[(t0 + lane) * 8 + 4 + h]; const float bt = bg[(t0 + lane) * 8 + h];
    for (int d = 1; d < 64; d <<= 1) { const float o = __shfl_up(gcv, d); if (lane >= d) gcv += o; }
    const float gl = __shfl(gcv, 63);
    gcs[lane] = gcv; bts[lane] = bt;
    const bf16_t* qb = qkvn + t0 * 768 + h * 64; const bf16_t* kb = qb + 256; const bf16_t* vb = qb + 512;
    bf16x8 kf[4][2], qf[4][2];
#pragma unroll
    for (int m = 0; m < 4; ++m)
#pragma unroll
        for (int kk = 0; kk < 2; ++kk) { kf[m][kk] = *(const bf16x8*)(kb + (size_t)(16 * m + fr) * 768 + 32 * kk + 8 * fq); qf[m][kk] = *(const bf16x8*)(qb + (size_t)(16 * m + fr) * 768 + 32 * kk + 8 * fq); }
    wave_lds_fence();
    unsigned char* cbase = wsp(a) + WS_A2 + (size_t)it * 49152;
    if (lane == 0) ((float*)(wsp(a) + WS_GLS))[it] = gl;
#pragma unroll
    for (int m = 0; m < 4; ++m) {
        const int i = 16 * m + fr; const float gi = gcs[i], bi = bts[i];
#pragma unroll
        for (int k2 = 0; k2 < 2; ++k2) {
            f32x4 ak[2], aq[2];
#pragma unroll
            for (int hh = 0; hh < 2; ++hh) {
                const int nn = 2 * k2 + hh;
                ak[hh] = (f32x4){0.f, 0.f, 0.f, 0.f}; aq[hh] = (f32x4){0.f, 0.f, 0.f, 0.f};
                if (nn <= m) {
#pragma unroll
                    for (int kk = 0; kk < 2; ++kk) { ak[hh] = MFMA16(kf[nn][kk], kf[m][kk], ak[hh]); aq[hh] = MFMA16(kf[nn][kk], qf[m][kk], aq[hh]); }
                    const f32x4 gj = *(const f32x4*)(gcs + 16 * nn + 4 * fq);
#pragma unroll
                    for (int jj = 0; jj < 4; ++jj) { const int j = 16 * nn + 4 * fq + jj; const float e = __expf(fminf(gi - gj[jj], 0.f));
                        ak[hh][jj] = (j < i) ? bi * ak[hh][jj] * e : 0.f; aq[hh][jj] = (j <= i) ? aq[hh][jj] * e : 0.f; }
                }
                *(f32x4*)(Aw + i * 68 + 16 * nn + 4 * fq) = ak[hh];
            }
            *(uint4*)(cbase + ((m * 2 + k2) * 64 + lane) * 16) = pack8u(aq[0], aq[1]);
        }
    }
#pragma unroll
    for (int m = 0; m < 4; ++m)
#pragma unroll
        for (int kk = 0; kk < 2; ++kk) { const int i = 16 * m + fr; const float e = __expf(gcs[i]);
            const f32x4 lo = ld4bf(qb + (size_t)i * 768 + 32 * kk + 4 * fq) * e, hi = ld4bf(qb + (size_t)i * 768 + 32 * kk + 16 + 4 * fq) * e;
            *(uint4*)(cbase + 16384 + ((m * 2 + kk) * 64 + lane) * 16) = pack8u(lo, hi); }
    wave_lds_fence();
    const int c = lane;
    bf16_t* wF = (bf16_t*)(cbase + 8192); bf16_t* kdF = (bf16_t*)(cbase + 24576); float* uS = (float*)(cbase + 32768);
    {
        float U[64];
#pragma unroll
        for (int i = 0; i < 64; ++i) U[i] = bf2f(vb[(size_t)i * 768 + c]);
#pragma unroll
        for (int i = 0; i < 64; ++i) {
            const float vi = U[i];
            float su = bts[i] * vi;
            f32x4 ar[16];
#pragma unroll
            for (int q = 0; q < (i + 3) / 4; ++q) ar[q] = *(const f32x4*)(Aw + i * 68 + 4 * q);
            asm volatile("" : "+v"(su) :: "memory");
#pragma unroll
            for (int q = 0; q < (i + 3) / 4; ++q)
#pragma unroll
                for (int jj = 0; jj < 4; ++jj) if (4 * q + jj < i) su -= ar[q][jj] * U[4 * q + jj];
            U[i] = su;
            uS[(((c >> 4) * 4 + (i >> 4)) * 64 + ((i >> 2) & 3) * 16 + (c & 15)) * 4 + (i & 3)] = su;
            asm volatile("" ::: "memory");
        }
    }
    {
        float W[64];
#pragma unroll
        for (int i = 0; i < 64; ++i) W[i] = bf2f(kb[(size_t)i * 768 + c]);
#pragma unroll
        for (int i = 0; i < 64; ++i) {
            const float ki = W[i];
            const float bi = bts[i], gi = gcs[i];
            float sw = bi * __expf(gi) * ki;
            f32x4 ar[16];
#pragma unroll
            for (int q = 0; q < (i + 3) / 4; ++q) ar[q] = *(const f32x4*)(Aw + i * 68 + 4 * q);
            asm volatile("" : "+v"(sw) :: "memory");
#pragma unroll
            for (int q = 0; q < (i + 3) / 4; ++q)
#pragma unroll
                for (int jj = 0; jj < 4; ++jj) if (4 * q + jj < i) sw -= ar[q][jj] * W[4 * q + jj];
            W[i] = sw;
            kdF[fragidx(c, i)] = f2bf(ki * __expf(gl - gi));
            wF[fragidx(i, c)] = f2bf(sw);
            asm volatile("" ::: "memory");
        }
    }
}

__device__ void sdelta_item(const Args& a, const int l, const int it) {
    const int lane = tidx() & 63, h = it & 3, b = it >> 2;
    const float* S0 = inp(a, 2) + ((size_t)(l * 128 + b) * 4 + h) * 4096;
    const float* bg = (const float*)(wsp(a) + WS_BG); const bf16_t* qkvn = (const bf16_t*)outp(a);
    float S[64];
#pragma unroll
    for (int i = 0; i < 64; ++i) S[i] = S0[i * 64 + lane];
    for (int t = 0; t < 4; ++t) {
        const size_t r = (size_t)MP + 4 * b + t; const bf16_t* p = qkvn + r * 768 + h * 64 + lane;
        const float qv = bf2f(p[0]), kv = bf2f(p[256]), vv = bf2f(p[512]); const float beta = bg[r * 8 + h], eg = __expf(bg[r * 8 + 4 + h]);
        float rr = 0.f;
#pragma unroll
        for (int i = 0; i < 64; ++i) { S[i] *= eg; rr += rdlane(kv, i) * S[i]; }
        const float cc = beta * (vv - rr); float oo = 0.f;
#pragma unroll
        for (int i = 0; i < 64; ++i) { S[i] += rdlane(kv, i) * cc; oo += rdlane(qv, i) * S[i]; }
        {
            const float ss = wave_sum(oo * oo);
            const float y = oo * rsqrtf(ss * (1.f / 64.f) + EPS) * inp(a, 13)[l * 64 + lane];
            const float z = bf2f(((const bf16_t*)(wsp(a) + WS_PROJ))[r * PS + C_AZ + h * 64 + lane]);
            ((bf16_t*)(wsp(a) + WS_MIX))[r * DM + h * 64 + lane] = f2bf(y * silu_f(z));
        }
    }
    float* So = outp(a) + O_SDS + ((size_t)(l * 128 + b) * 4 + h) * 4096;
#pragma unroll
    for (int i = 0; i < 64; ++i) So[i * 64 + lane] = S[i];
}

__device__ void sattn_item(const Args& a, const int l, const int it) {
    const int lane = tidx() & 63, hq = it & 3, b = it >> 2, kvh = hq >> 1;
    const float* ck = inp(a, 5) + (size_t)(l * 128 + b) * 16384 + kvh * 64; const float* cv = inp(a, 6) + (size_t)(l * 128 + b) * 16384 + kvh * 64;
    const bf16_t* qr = (const bf16_t*)(wsp(a) + WS_QR); const bf16_t* kvr = (const bf16_t*)(wsp(a) + WS_KVR); bf16_t* mix = (bf16_t*)(wsp(a) + WS_MIX);
    const size_t r0 = (size_t)MP + 4 * b;
    float qv[4];
#pragma unroll
    for (int i = 0; i < 4; ++i) qv[i] = bf2f(qr[(r0 + i) * 256 + hq * 64 + lane]);
    float s[3][4];
#pragma unroll
    for (int sl = 0; sl < 3; ++sl) {
        float acc0 = 0.f, acc1 = 0.f, acc2 = 0.f, acc3 = 0.f;
        if (sl < 2) { const float* kp = ck + (size_t)(sl * 64 + lane) * 128;
#pragma unroll
            for (int d4 = 0; d4 < 16; ++d4) { const f32x4 kx = *(const f32x4*)(kp + d4 * 4);
#pragma unroll
                for (int e = 0; e < 4; ++e) { const int d = d4 * 4 + e; acc0 += rdlane(qv[0], d) * kx[e]; acc1 += rdlane(qv[1], d) * kx[e]; acc2 += rdlane(qv[2], d) * kx[e]; acc3 += rdlane(qv[3], d) * kx[e]; } }
        } else { const bf16_t* kp = kvr + (r0 + (lane & 3)) * 256 + kvh * 64;
#pragma unroll
            for (int d4 = 0; d4 < 16; ++d4) { const f32x4 kx = ld4bf(kp + d4 * 4);
#pragma unroll
                for (int e = 0; e < 4; ++e) { const int d = d4 * 4 + e; acc0 += rdlane(qv[0], d) * kx[e]; acc1 += rdlane(qv[1], d) * kx[e]; acc2 += rdlane(qv[2], d) * kx[e]; acc3 += rdlane(qv[3], d) * kx[e]; } }
        }
        s[sl][0] = acc0; s[sl][1] = acc1; s[sl][2] = acc2; s[sl][3] = acc3;
    }
    const float sink = inp(a, 15)[l * 4 + hq];
    float inv[4];
#pragma unroll
    for (int i = 0; i < 4; ++i) {
        const bool v0 = lane > i, v1 = true, v2 = lane <= i && lane < 4;
        const float x0 = v0 ? s[0][i] * 0.125f : -1e30f, x1 = v1 ? s[1][i] * 0.125f : -1e30f, x2 = v2 ? s[2][i] * 0.125f : -1e30f;
        float mx = fmaxf(fmaxf(x0, x1), x2);
        for (int d = 1; d < 64; d <<= 1) mx = fmaxf(mx, __shfl_xor(mx, d));
        mx = fmaxf(mx, sink);
        const float p0 = v0 ? __expf(x0 - mx) : 0.f, p1 = __expf(x1 - mx), p2 = v2 ? __expf(x2 - mx) : 0.f;
        const float sum = wave_sum(p0 + p1 + p2) + __expf(sink - mx);
        s[0][i] = p0; s[1][i] = p1; s[2][i] = p2; inv[i] = 1.f / sum;
    }
    float o[4] = {0.f, 0.f, 0.f, 0.f};
#pragma unroll
    for (int sl = 0; sl < 2; ++sl)
#pragma unroll 1
        for (int j0 = 0; j0 < 64; j0 += 16) { float vv[16];
#pragma unroll
            for (int e = 0; e < 16; ++e) vv[e] = cv[(size_t)(sl * 64 + j0 + e) * 128 + lane];
#pragma unroll
            for (int e = 0; e < 16; ++e)
#pragma unroll
                for (int i = 0; i < 4; ++i) o[i] += rdlane(s[sl][i], j0 + e) * vv[e]; }
#pragma unroll
    for (int jj = 0; jj < 4; ++jj) { const float vv = bf2f(kvr[(r0 + jj) * 256 + 128 + kvh * 64 + lane]);
#pragma unroll
        for (int i = 0; i < 4; ++i) o[i] += rdlane(s[2][i], jj) * vv; }
#pragma unroll
    for (int i = 0; i < 4; ++i) mix[(r0 + i) * DM + 512 + hq * 64 + lane] = f2bf(o[i] * inv[i]);
}

__device__ void c_item(const Args& a, const int l, const int it, unsigned char* smem) {
    const int tid = tidx(), lane = tid & 63, w = tid >> 6, fr = lane & 15, fq = lane >> 4;
    const int qb = it & 63, kvh = (it >> 6) & 1, b = it >> 7;
    bf16_t* Ks = (bf16_t*)smem; bf16_t* Vt = Ks + 192 * 72;
    const bf16_t* kvr = (const bf16_t*)(wsp(a) + WS_KVR); const bf16_t* qr = (const bf16_t*)(wsp(a) + WS_QR); bf16_t* mix = (bf16_t*)(wsp(a) + WS_MIX);
    const int kp0 = 64 * qb - 128;
    const int hq = 2 * kvh + (w >> 2), wq = w & 3, qrow0 = 64 * qb + 16 * wq, kb = 16 * wq;
    const bf16_t* qp = qr + ((size_t)b * 4096 + qrow0 + fr) * 256 + hq * 64 + 8 * fq;
    const bf16x8 qf0 = *(const bf16x8*)qp, qf1 = *(const bf16x8*)(qp + 32);
    for (int id = tid; id < 1536; id += 512) { const int row = id >> 3, c8 = id & 7, kp = kp0 + row; uint4 kq = {0u, 0u, 0u, 0u}, vq = {0u, 0u, 0u, 0u};
        if (kp >= 0) { const bf16_t* src = kvr + ((size_t)b * 4096 + kp) * 256 + kvh * 64 + c8 * 8; kq = *(const uint4*)src; vq = *(const uint4*)(src + 128); }
        *(uint4*)(Ks + row * 72 + c8 * 8) = kq; bf16_t* vd = Vt + (c8 * 8) * 200 + row;
        vd[0] = (bf16_t)(vq.x & 0xffffu); vd[200] = (bf16_t)(vq.x >> 16); vd[400] = (bf16_t)(vq.y & 0xffffu); vd[600] = (bf16_t)(vq.y >> 16);
        vd[800] = (bf16_t)(vq.z & 0xffffu); vd[1000] = (bf16_t)(vq.z >> 16); vd[1200] = (bf16_t)(vq.w & 0xffffu); vd[1400] = (bf16_t)(vq.w >> 16); }
    __syncthreads();
    f32x4 s[9];
#pragma unroll
    for (int nn = 0; nn < 9; ++nn) { const bf16_t* kr = Ks + (kb + 16 * nn + fr) * 72 + 8 * fq; s[nn] = (f32x4){0.f, 0.f, 0.f, 0.f};
        s[nn] = MFMA16(*(const bf16x8*)kr, qf0, s[nn]); s[nn] = MFMA16(*(const bf16x8*)(kr + 32), qf1, s[nn]); }
    const int tq = qrow0 + fr; const float sink = inp(a, 15)[l * 4 + hq];
    float mx = sink;
#pragma unroll
    for (int nn = 0; nn < 9; ++nn)
#pragma unroll
        for (int jj = 0; jj < 4; ++jj) { const int tk = kp0 + kb + 16 * nn + 4 * fq + jj; const bool ok = tk >= 0 && tk <= tq && tk > tq - 128;
            const float v = ok ? s[nn][jj] * 0.125f : -1e30f; s[nn][jj] = v; mx = fmaxf(mx, v); }
    mx = fmaxf(mx, __shfl_xor(mx, 16)); mx = fmaxf(mx, __shfl_xor(mx, 32));
    float sum = 0.f;
#pragma unroll
    for (int nn = 0; nn < 9; ++nn)
#pragma unroll
        for (int jj = 0; jj < 4; ++jj) { const float p = s[nn][jj] > -1e29f ? __expf(s[nn][jj] - mx) : 0.f; s[nn][jj] = p; sum += p; }
    sum += __shfl_xor(sum, 16); sum += __shfl_xor(sum, 32); sum += __expf(sink - mx);
    bf16x8 pb[5];
#pragma unroll
    for (int kk = 0; kk < 4; ++kk) pb[kk] = pack8(s[2 * kk], s[2 * kk + 1]);
    pb[4] = pack8(s[8], (f32x4){0.f, 0.f, 0.f, 0.f});
    const float inv = 1.f / sum;
#pragma unroll
    for (int m = 0; m < 4; ++m) { f32x4 o = {0.f, 0.f, 0.f, 0.f};
#pragma unroll
        for (int kk = 0; kk < 5; ++kk) { const bf16_t* vp = Vt + (16 * m + fr) * 200 + kb + 32 * kk + 4 * fq;
            const bf16x4 lo = *(const bf16x4*)vp; bf16x4 hi = {0, 0, 0, 0}; if (kk < 4) hi = *(const bf16x4*)(vp + 16);
            const bf16x8 af = {lo[0], lo[1], lo[2], lo[3], hi[0], hi[1], hi[2], hi[3]};
            o = MFMA16(af, pb[kk], o); }
        st4bf(mix + ((size_t)b * 4096 + tq) * DM + 512 + hq * 64 + 16 * m + 4 * fq, o * inv); }
    __syncthreads();
}

__device__ void d_item(const Args& a, const int l, const int it, unsigned char* smem) {
    const int tid = tidx(), lane = tid & 63, w = tid >> 6, fr = lane & 15, fq = lane >> 4;
    const int g = it & 3, ch = (it >> 2) & 31, b = it >> 7;
    bf16_t* vT = (bf16_t*)smem;
    const bf16_t* dvn = (const bf16_t*)(wsp(a) + WS_DVN); const bf16_t* proj = (const bf16_t*)(wsp(a) + WS_PROJ); bf16_t* mix = (bf16_t*)(wsp(a) + WS_MIX);
    const size_t r0 = (size_t)b * 4096 + 128 * ch;
    const float* Wg = inp(a, 18) + ((size_t)(l * 4 + g) * 128) * 128;
    const int t = 16 * w + fr;
    const size_t r = r0 + t;
    f32x4 wa[4], wb[4]; uint2 duq[4];
#pragma unroll
    for (int kk = 0; kk < 4; ++kk) if (kk <= (w >> 1)) { const float* wp = Wg + (size_t)t * 128 + 32 * kk + 8 * fq; wa[kk] = *(const f32x4*)wp; wb[kk] = *(const f32x4*)(wp + 4); }
#pragma unroll
    for (int n = 0; n < 4; ++n) duq[n] = *(const uint2*)(proj + r * PS + C_DU + g * 64 + 16 * n + 4 * fq);
    const float bias = inp(a, 19)[(size_t)(l * 4 + g) * 128 + t];
    for (int id = tid; id < 1024; id += 512) { const int row = id >> 3, c8 = id & 7; const uint4 vq = *(const uint4*)(dvn + (r0 + row) * 256 + g * 64 + c8 * 8); bf16_t* vd = vT + (c8 * 8) * 136 + row;
        vd[0] = (bf16_t)(vq.x & 0xffffu); vd[136] = (bf16_t)(vq.x >> 16); vd[272] = (bf16_t)(vq.y & 0xffffu); vd[408] = (bf16_t)(vq.y >> 16);
        vd[544] = (bf16_t)(vq.z & 0xffffu); vd[680] = (bf16_t)(vq.z >> 16); vd[816] = (bf16_t)(vq.w & 0xffffu); vd[952] = (bf16_t)(vq.w >> 16); }
    __syncthreads();
    f32x4 acc[4];
#pragma unroll
    for (int n = 0; n < 4; ++n) acc[n] = (f32x4){0.f, 0.f, 0.f, 0.f};
#pragma unroll
    for (int kk = 0; kk < 4; ++kk) if (kk <= (w >> 1)) {
        f32x4 w0 = wa[kk], w1 = wb[kk];
#pragma unroll
        for (int e = 0; e < 4; ++e) { if (32 * kk + 8 * fq + e > t) w0[e] = 0.f; if (32 * kk + 8 * fq + 4 + e > t) w1[e] = 0.f; }
        const bf16x8 bfr = pack8(w0, w1);
#pragma unroll
        for (int n = 0; n < 4; ++n) acc[n] = MFMA16(*(const bf16x8*)(vT + (16 * n + fr) * 136 + 32 * kk + 8 * fq), bfr, acc[n]);
    }
#pragma unroll
    for (int n = 0; n < 4; ++n) { const f32x4 du = gelu4(cv4bf(duq[n])); st4bf(mix + r * DM + 768 + g * 64 + 16 * n + 4 * fq, du * (acc[n] + bias)); }
    __syncthreads();
}

__device__ void phase_chunk(const Args& a, const int l, unsigned char* smem) {
    const int wid = tidx() >> 6, gw = bidx() * 8 + wid, nw = gdim() * 8;
#ifndef CHMASK
#define CHMASK 15
#endif
#ifndef CHDUP
#define CHDUP 0
#endif
    if (CHDUP & 1) { if (l == 0) for (int it = gw; it < 2048; it += nw) a2_item(a, it, smem + wid * A2_LDS); }
    if (CHDUP & 2) { if (l == 0) for (int it = gw; it < 512; it += nw) sattn_item(a, l, it); }
    if (CHDUP & 4) { if (l == 0) { __syncthreads(); for (int it = bidx(); it < 1024; it += gdim()) c_item(a, l, it, smem); } }
    if (CHDUP & 8) { if (l == 0) { __syncthreads(); for (int it = bidx(); it < 1024; it += gdim()) d_item(a, l, it, smem); } }
    if (CHDUP) __syncthreads();
    if (CHMASK & 1) for (int it = gw; it < 2048; it += nw) a2_item(a, it, smem + wid * A2_LDS);
    __syncthreads();

}

__device__ void phase_scan(const Args& a, const int l, unsigned char* smem) {
    const int lane = tidx() & 63, wid = tidx() >> 6, fr = lane & 15, fq = lane >> 4;

    float* oraw = (float*)((unsigned char*)outp(a) + OUT_ORAW);
    if (bidx() >= 32 || gdim() < 64) {
        const int nb = gdim() < 64 ? gdim() : gdim() - 32, bi = gdim() < 64 ? bidx() : bidx() - 32;
        for (int it = bi; it < 1024; it += nb) c_item(a, l, it, smem);
        for (int it = bi; it < 1024; it += nb) d_item(a, l, it, smem);
        { const int w = bi * 8 + wid; const int w3 = w / 3, wr3 = w - 3 * w3;
          if (w3 < 512 && wr3 == 0) sdelta_item(a, l, w3);
          if (w3 < 512 && wr3 == 1) sattn_item(a, l, w3); }
        if (gdim() >= 64) return;
    }
    LAS unsigned char* ring = (LAS unsigned char*)smem;
    for (int bh = bidx(); bh < 32; bh += gdim()) {
        const int b = bh >> 2, h = bh & 3, sl = wid;
        const unsigned char* a2b = wsp(a) + WS_A2;
#define SC_BASE(n_) (a2b + (size_t)((b * 64 + (n_)) * 4 + h) * 49152)
        if (wid >= 4) {
            const int lw = wid - 4;
#define SC_ISSUE(n_) do { const int nn_ = (n_) < 63 ? (n_) : 63; const unsigned char* g_ = SC_BASE(nn_) + lw * 8192 + lane * 16; LAS unsigned char* d_ = ring + ((n_) & 3) * 32768 + lw * 8192; \
            _Pragma("unroll") for (int j_ = 0; j_ < 8; ++j_) __builtin_amdgcn_global_load_lds((const unsigned*)(g_ + j_ * 1024), (LAS unsigned*)(d_ + j_ * 1024), 16, 0, 0); } while (0)
            SC_ISSUE(0); SC_ISSUE(1); SC_ISSUE(2);
#pragma unroll 1
            for (int n = 0; n < 64; ++n) {
                asm volatile("s_waitcnt vmcnt(16)" ::: "memory");
                __builtin_amdgcn_s_barrier();
                asm volatile("" ::: "memory");
                SC_ISSUE(n + 3);
            }
            asm volatile("s_waitcnt vmcnt(0)" ::: "memory");
            __builtin_amdgcn_s_barrier();
#undef SC_ISSUE
        } else {
            f32x4 S[4];
#pragma unroll
            for (int m = 0; m < 4; ++m) S[m] = (f32x4){0.f, 0.f, 0.f, 0.f};
            f32x4 u[4]; float glv;
            const float* glsp = (const float*)(wsp(a) + WS_GLS);
#define SC_LD_U(n_) do { const unsigned char* cb_ = SC_BASE(n_); _Pragma("unroll") for (int m = 0; m < 4; ++m) u[m] = *(const f32x4*)(cb_ + 32768 + (size_t)((sl * 4 + m) * 64 + lane) * 16); glv = glsp[(b * 64 + (n_)) * 4 + h]; } while (0)
#define SC_FR(off_, m_, kk_) (*(const LAS bf16x8*)(slot + (off_) + (((m_) * 2 + (kk_)) * 64 + lane) * 16))
            SC_LD_U(0);
#pragma unroll 1
            for (int n = 0; n < 64; ++n) {
                asm volatile("s_waitcnt lgkmcnt(0)" ::: "memory");
                __builtin_amdgcn_s_barrier();
                asm volatile("" ::: "memory");
                const LAS unsigned char* slot = ring + (n & 3) * 32768;
                const int nn = n < 63 ? n + 1 : 63;
                const float egl = __expf(glv);
                bf16x8 Sb[2], Vb[2];
                Sb[0] = pack8(S[0], S[1]); Sb[1] = pack8(S[2], S[3]);
                f32x4 vn[4];
                const size_t t0 = (size_t)b * 4096 + n * 64;
#pragma unroll
                for (int m = 0; m < 4; ++m) { f32x4 T = {0.f, 0.f, 0.f, 0.f}; T = MFMA16(SC_FR(8192, m, 0), Sb[0], T); T = MFMA16(SC_FR(8192, m, 1), Sb[1], T); vn[m] = u[m] - T; }
                SC_LD_U(nn);
                Vb[0] = pack8(vn[0], vn[1]); Vb[1] = pack8(vn[2], vn[3]);
#pragma unroll
                for (int m = 0; m < 4; ++m) { f32x4 o = {0.f, 0.f, 0.f, 0.f}; o = MFMA16(SC_FR(16384, m, 0), Sb[0], o); o = MFMA16(SC_FR(16384, m, 1), Sb[1], o); o = MFMA16(SC_FR(0, m, 0), Vb[0], o); o = MFMA16(SC_FR(0, m, 1), Vb[1], o);
#pragma unroll
                    for (int jj = 0; jj < 4; ++jj) oraw[(t0 + 16 * m + 4 * fq + jj) * 256 + h * 64 + 16 * sl + fr] = o[jj]; }
#pragma unroll
                for (int m = 0; m < 4; ++m) { f32x4 s2 = S[m] * egl; s2 = MFMA16(SC_FR(24576, m, 0), Vb[0], s2); s2 = MFMA16(SC_FR(24576, m, 1), Vb[1], s2); S[m] = s2; }
            }
            asm volatile("s_waitcnt lgkmcnt(0)" ::: "memory");
            __builtin_amdgcn_s_barrier();
#undef SC_LD_U
#undef SC_FR
            float* So = outp(a) + O_SDP + ((size_t)(l * 8 + b) * 4 + h) * 4096;
#pragma unroll
            for (int m = 0; m < 4; ++m)
#pragma unroll
                for (int jj = 0; jj < 4; ++jj) So[(16 * m + 4 * fq + jj) * 64 + 16 * sl + fr] = S[m][jj];
        }
#undef SC_BASE
        __syncthreads();
    }
}

__device__ void phase_aout(const Args& a, const int l) {
    const int lane = tidx() & 63, wid = tidx() >> 6, c4 = lane * 4;
    const float* oraw = (const float*)((unsigned char*)outp(a) + OUT_ORAW); const bf16_t* proj = (const bf16_t*)(wsp(a) + WS_PROJ); bf16_t* mix = (bf16_t*)(wsp(a) + WS_MIX);
    const f32x4 g = *(const f32x4*)(inp(a, 13) + l * 64 + (c4 & 63));
    for (int r = bidx() * 8 + wid; r < MP; r += gdim() * 8) {
        const f32x4 o = *(const f32x4*)(oraw + (size_t)r * 256 + c4);
        const float ss = red16(o[0] * o[0] + o[1] * o[1] + o[2] * o[2] + o[3] * o[3]);
        const f32x4 y = o * rsqrtf(ss * (1.f / 64.f) + EPS) * g;
        st4bf(mix + (size_t)r * DM + c4, y * silu4(ld4bf(proj + (size_t)r * PS + C_AZ + c4)));
    }
}

__device__ void phase_fix(const Args& a, const int l) {
    const float* sg = (const float*)(wsp(a) + WS_SG); const float* su = (const float*)(wsp(a) + WS_SU); bf16_t* act = (bf16_t*)(wsp(a) + WS_PROJ);
    const float* cw = inp(a, 24) + (size_t)l * 3 * FF;
    const int idx0 = bidx() * 512 + tidx(), idxs = gdim() * 512;
#pragma unroll 3
    for (int idx = idx0; idx < 512 * 2 * 704; idx += idxs) {
        const int f = (idx % 704) * 4, q = (idx / 704) & 1, blk = idx / 1408; const bool prev = (blk & 63) != 0;
        const f32x4 z4 = {0.f, 0.f, 0.f, 0.f};
        const f32x4 g0 = *(const f32x4*)(sg + ((size_t)blk * 4 + q) * FF + f), up = *(const f32x4*)(su + ((size_t)blk * 2 + q) * FF + f);
        f32x4 gm2, gm1;
        if (q == 0) { gm2 = prev ? *(const f32x4*)(sg + ((size_t)(blk - 1) * 4 + 2) * FF + f) : z4; gm1 = prev ? *(const f32x4*)(sg + ((size_t)(blk - 1) * 4 + 3) * FF + f) : z4; }
        else { gm2 = prev ? *(const f32x4*)(sg + ((size_t)(blk - 1) * 4 + 3) * FF + f) : z4; gm1 = *(const f32x4*)(sg + ((size_t)blk * 4 + 0) * FF + f); }
        const f32x4 gc = *(const f32x4*)(cw + f) * gm2 + *(const f32x4*)(cw + FF + f) * gm1 + *(const f32x4*)(cw + 2 * FF + f) * g0;
        st4bf(act + ((size_t)blk * 64 + q) * FF + f, silu4(gc) * up);
    }
    const float* P = (const float*)(wsp(a) + WS_SACC); const float* st = inp(a, 7) + (size_t)l * 128 * 2 * FF; float* osfs = outp(a) + O_SFS + (size_t)l * 128 * 2 * FF;
    const float* ssq = (const float*)(wsp(a) + WS_SSQB);
    for (int idx = idx0; idx < 128 * FF; idx += idxs) {
        const int b = idx / FF, ff = idx - b * FF, gcol = 256 * (ff >> 7) + (ff & 127);
        float x2 = st[((size_t)b * 2) * FF + ff], x1 = st[((size_t)b * 2 + 1) * FF + ff];
        const float w0 = cw[ff], w1 = cw[FF + ff], w2 = cw[2 * FF + ff];
#pragma unroll
        for (int t = 0; t < 4; ++t) {
            const int rs = 4 * b + t; const float sc = rowscale(ssq, MP + rs);
            float g = 0.f, u = 0.f;
#pragma unroll
            for (int sl = 0; sl < 4; ++sl) { const float* pp = P + ((size_t)sl * MS + rs) * 5632 + gcol; g += pp[0]; u += pp[128]; }
            g *= sc; u *= sc;
            const float y = w0 * x2 + w1 * x1 + w2 * g;
            act[((size_t)MP + rs) * FF + ff] = f2bf(silu_f(y) * u);
            if (t >= 2) osfs[((size_t)b * 2 + (t - 2)) * FF + ff] = g;
            x2 = x1; x1 = g;
        }
    }
}

__device__ void phase_sfin(const Args& a) {
    const int lane = tidx() & 63, wid = tidx() >> 6;
    const float* sacc = (const float*)(wsp(a) + WS_SACC); bf16_t* xb = (bf16_t*)(wsp(a) + WS_XB); float* ssq = (float*)(wsp(a) + WS_SSQA);
    for (int rs = bidx() * 8 + wid; rs < MS; rs += gdim() * 8) {
        const size_t r = (size_t)MP + rs; float ss = 0.f;
#pragma unroll
        for (int q = 0; q < 4; ++q) { const int c = q * 256 + lane * 4; f32x4 v = ld4bf(xb + r * DM + c);
#pragma unroll
            for (int ks = 0; ks < 11; ++ks) v = v + *(const f32x4*)(sacc + (size_t)ks * ((size_t)MS * DM) + (size_t)rs * DM + c);
            ss += v[0] * v[0] + v[1] * v[1] + v[2] * v[2] + v[3] * v[3]; st4bf(xb + r * DM + c, v); }
        ss = wave_sum(ss);
        if (lane < 16) ssq[r * 16 + lane] = lane == 0 ? ss : 0.f;
    }
}

__device__ void phase_final(const Args& a) {
    const int lane = tidx() & 63, wid = tidx() >> 6;
    const float* ssq = (const float*)(wsp(a) + WS_SSQA); const float* g = inp(a, 26); const bf16_t* xb = (const bf16_t*)(wsp(a) + WS_XB);
    for (int r = bidx() * 8 + wid; r < M; r += gdim() * 8) {
        const float sc = rowscale(ssq, r); float* yr = outp(a) + (size_t)r * DM; const bf16_t* xr = xb + (size_t)r * DM;
#pragma unroll
        for (int q = 0; q < 4; ++q) { const int c = q * 256 + lane * 4; __builtin_nontemporal_store(ld4bf(xr + c) * sc * *(const f32x4*)(g + c), (f32x4*)(yr + c)); }
    }
}

#define XB_TMO      128
#define XB_XCNT(j)  (256  + 64 * (j))
#define XB_XSUB(j)  (1280 + 64 * (j))
#define XB_XGEN(j)  (2304 + 64 * (j))
#define XB_TOP      3328
#define XB_TOPGEN   3392
#define XCD_BAR_WORDS 3456
#define XB_SPIN_CAP (1u << 20)
DEVI unsigned xb_ld(unsigned* p)              { return __hip_atomic_load(p, __ATOMIC_RELAXED, __HIP_MEMORY_SCOPE_AGENT); }
DEVI unsigned xb_add(unsigned* p, unsigned v) { return __hip_atomic_fetch_add(p, v, __ATOMIC_RELAXED, __HIP_MEMORY_SCOPE_AGENT); }
DEVI unsigned xb_xcc_id() { return (unsigned)__builtin_amdgcn_s_getreg((3 << 11) | 20) & 0xFu; }
#define XB_SPIN(cond, bar) do { unsigned _sp = 0; while (cond) { __builtin_amdgcn_s_sleep(1); \
    if ((++_sp & 255u) == 0u) { if (xb_ld(&(bar)[XB_TMO])) break; if (_sp > XB_SPIN_CAP) { atomicAdd(&(bar)[XB_TMO], 1u); break; } } } } while (0)
DEVI void xcd_barrier_complete(unsigned* bar, unsigned x, unsigned& nloc, unsigned& nx) {
    const unsigned G = gridDim.x * gridDim.y * gridDim.z;
    unsigned sum, cnt, mine, sp = 0u;
    for (;;) {
        sum = 0u; cnt = 0u; mine = 0u;
#pragma unroll
        for (unsigned j = 0; j < 16; ++j) { const unsigned c = xb_ld(&bar[XB_XCNT(j)]); sum += c; cnt += (c > 0u) ? 1u : 0u; mine = (j == x) ? c : mine; }
        if (sum == G) break;
        __builtin_amdgcn_s_sleep(1);
        if ((++sp & 255u) == 0u) { if (xb_ld(&bar[XB_TMO])) break; if (sp > XB_SPIN_CAP) { atomicAdd(&bar[XB_TMO], 1u); break; } }
    }
    nloc = mine > 0u ? mine : 1u; nx = cnt > 0u ? cnt : 1u;
}
DEVI void xcd_barrier(unsigned* const b_bar, volatile LAS unsigned* const b_st) {
    const unsigned b_x = xb_xcc_id();
    asm volatile("s_waitcnt vmcnt(0)" ::: "memory");
    __syncthreads();
    if (threadIdx.x == 0) {
        unsigned* bar = b_bar;
        __builtin_amdgcn_s_waitcnt(0);
        unsigned nloc = b_st[0], nx = b_st[1];
        if (nloc == 0u) { (void)xb_add(&bar[XB_XCNT(b_x)], 1u); xcd_barrier_complete(bar, b_x, nloc, nx); b_st[0] = nloc; b_st[1] = nx; }
        const unsigned old = xb_add(&bar[XB_XSUB(b_x)], 1u);
        const unsigned gen = old / nloc;
        if (old + 1u == (gen + 1u) * nloc) {
            __builtin_amdgcn_fence(__ATOMIC_RELEASE, "agent");
            asm volatile("s_waitcnt vmcnt(0)" ::: "memory");
            const unsigned og = xb_add(&bar[XB_TOP], 1u);
            const unsigned tg = og / nx;
            if (og + 1u == (tg + 1u) * nx) xb_add(&bar[XB_TOPGEN], 1u);
            else XB_SPIN(xb_ld(&bar[XB_TOPGEN]) == tg, bar);
            __builtin_amdgcn_fence(__ATOMIC_ACQUIRE, "agent");
            xb_add(&bar[XB_XGEN(b_x)], 1u);
            asm volatile("s_waitcnt vmcnt(0)" ::: "memory");
        } else {
            XB_SPIN(xb_ld(&bar[XB_XGEN(b_x)]) == gen, bar);
            __builtin_amdgcn_fence(__ATOMIC_ACQUIRE, "agent");
            asm volatile("s_waitcnt vmcnt(0)" ::: "memory");
        }
    }
    __syncthreads();
}

constexpr int NPH = 22, LDS_BYTES = 147456;
__global__ void __launch_bounds__(512) fwd_kernel(Args a0) {
    extern __shared__ __attribute__((aligned(16))) unsigned char smem[];
    LAS unsigned char* lds = (LAS unsigned char*)smem;
#ifndef DUPMASK
#define DUPMASK 0
#endif
    int dup = 0;
#pragma unroll 1
    for (int ph = a0.ph_lo; ph < a0.ph_hi; ++ph) {
        if (ph == a0.ph_lo && threadIdx.x == 0) { volatile LAS unsigned* st0 = (volatile LAS unsigned*)(lds + (LDS_BYTES - 16)); st0[0] = 0u; st0[1] = 0u; }
        if (ph > a0.ph_lo && a0.coop && !(ph >= 1 && ph < NPH - 1 && (ph - 1) % 10 == 2)) { if (a0.coop == 2) cg::this_grid().sync();                         xcd_barrier((unsigned*)wsp(a0) + WS_BAR / 4, (volatile LAS unsigned*)(lds + (LDS_BYTES - 16))); }
        const Args& a = a0;
#ifndef PHMASK
#define PHMASK 0xFFFFF
#endif
        if (ph == 0) { if (PHMASK & 1) phase_prep(a, smem);
#ifdef DUP_PREP
            __syncthreads(); phase_prep(a, smem);
#endif
            continue; }
        if (ph == NPH - 1) {
#ifdef EXTRA_SYNCS
#pragma unroll 1
            for (int i = 0; i < EXTRA_SYNCS; ++i) cg::this_grid().sync();
#endif
            if (PHMASK & 2) phase_final(a); continue; }
        const int l = (ph - 1) / 10, sp = (ph - 1) % 10;
        pg8::StaticOrder S;
        if (!((PHMASK >> (2 + sp)) & 1)) continue;
        switch (sp) {
        case 0: { pg8::Gemm g{(const bf16_t*)(wsp(a) + WS_XB), (const bf16_t*)(wsp(a) + WS_WIN) + (size_t)l * NPAD * 1024, M, NPAD, 1024}; S.init(M, NPAD, 1024, gdim(), bidx());
            EpiProj E{(bf16_t*)(wsp(a) + WS_PROJ), (const float*)(wsp(a) + WS_SSQA)}; pg8::gemm_phase(lds, g, S, E); } break;
        case 1: phase_tok(a, l, smem);
            __syncthreads();
            phase_chunk(a, l, smem); break;
        case 2: break;
        case 3: phase_scan(a, l, smem); break;
        case 4: phase_aout(a, l); break;
        case 5: { pg8::Gemm g{(const bf16_t*)(wsp(a) + WS_MIX), (const bf16_t*)(wsp(a) + WS_WOUT) + (size_t)l * 1024 * 1024, M, 1024, 1024}; S.init(M, 1024, 1024, gdim(), bidx());
            EpiRes E{(bf16_t*)(wsp(a) + WS_XB), (float*)(wsp(a) + WS_SSQB), nullptr}; pg8::gemm_phase(lds, g, S, E); } break;
        case 6: { pg8::Gemm g{(const bf16_t*)(wsp(a) + WS_XB), (const bf16_t*)(wsp(a) + WS_WGU) + (size_t)l * 5632 * 1024, M, 5632, 1024};
            pg8::SplitOrder S2; S2.init(MP, 5632, 1024, gdim(), bidx()); S2.nks = 4;
            EpiGU E{(bf16_t*)(wsp(a) + WS_PROJ), (const float*)(wsp(a) + WS_SSQB), inp(a, 24) + (size_t)l * 3 * FF, (float*)(wsp(a) + WS_SG), (float*)(wsp(a) + WS_SU),
                    outp(a) + O_SFP + (size_t)l * 8 * 2 * FF, (float*)(wsp(a) + WS_SACC)}; pg8::gemm_phase(lds, g, S2, E); } break;
        case 7: phase_fix(a, l); break;
        case 8: { pg8::Gemm g{(const bf16_t*)(wsp(a) + WS_PROJ), (const bf16_t*)(wsp(a) + WS_WDN) + (size_t)l * 1024 * FF, M, 1024, FF};
            pg8::SplitOrder S2; S2.init(MP, 1024, FF, gdim(), bidx()); S2.nks = 11;
            EpiRes E{(bf16_t*)(wsp(a) + WS_XB), (float*)(wsp(a) + WS_SSQA), (float*)(wsp(a) + WS_SACC)}; pg8::gemm_phase(lds, g, S2, E); } break;
        default: phase_sfin(a); break;
        }
        if (DUPMASK && !dup && ph >= 1 && ph <= 9 && ((DUPMASK >> (ph - 1)) & 1)) { dup = 1; --ph; } else dup = 0;
    }
}

extern "C" void kernel_launch(void* const* d_in, const int* in_sizes, int n_in, void* d_out, int out_size, void* d_ws, size_t ws_size, hipStream_t stream) {
    static int grid = 0;
    if (grid == 0) {
        if (n_in != 27 || (size_t)out_size != O_END || ws_size < WS_END) { fprintf(stderr, "kernel_launch: unexpected sizes n_in %d out %d ws %zu (need %zu)\n", n_in, out_size, ws_size, (size_t)WS_END); grid = -1; return; }
        int dev = 0, cus = 0, per_cu = 0;
        hipGetDevice(&dev); hipDeviceGetAttribute(&cus, hipDeviceAttributeMultiprocessorCount, dev);
        if (hipFuncSetAttribute((const void*)fwd_kernel, hipFuncAttributeMaxDynamicSharedMemorySize, LDS_BYTES) != hipSuccess) { fprintf(stderr, "kernel_launch: hipFuncSetAttribute failed\n"); grid = -1; return; }
        hipOccupancyMaxActiveBlocksPerMultiprocessor(&per_cu, (const void*)fwd_kernel, 512, LDS_BYTES);
        (void)hipGetLastError();
        if (per_cu < 1) per_cu = 1;
        if (cus != 256) { fprintf(stderr, "kernel_launch: built for a 256-CU device (one workgroup per CU), found %d CUs\n", cus); grid = -1; return; }
        grid = 256;
    }
    if (grid < 0) return;
    Args a{};
    for (int i = 0; i < 27; ++i) a.in[i] = (const float*)d_in[i];
    a.out = (float*)d_out; a.ws = (unsigned char*)d_ws;
#if ONE_LAUNCH
    a.coop = 1; a.ph_lo = 0; a.ph_hi = NPH;
    if (hipMemsetAsync((unsigned char*)d_ws + WS_BAR, 0, 16384, stream) != hipSuccess) { fprintf(stderr, "kernel_launch: memset of the barrier words failed\n"); return; }
    void* args[] = {&a};
    hipError_t e = hipLaunchCooperativeKernel((const void*)fwd_kernel, dim3(grid), dim3(512), args, LDS_BYTES, stream);
    if (e != hipSuccess) fprintf(stderr, "cooperative launch failed: %s (grid %d)\n", hipGetErrorString(e), grid);
#else
    a.coop = 0;
    for (int ph = 0; ph < NPH; ++ph) { a.ph_lo = ph; a.ph_hi = ph + 1; hipLaunchKernelGGL(fwd_kernel, dim3(grid), dim3(512), LDS_BYTES, stream, a); }
#endif
}
```

```cpp
#include <hip/hip_runtime.h>
#include <hip/hip_cooperative_groups.h>
#include <cstdio>
namespace cg = cooperative_groups;

#define DEVI __device__ __forceinline__
#define LAS __attribute__((address_space(3)))
typedef unsigned short bf16_t;
typedef short bf16x8 __attribute__((ext_vector_type(8)));
typedef short bf16x4 __attribute__((ext_vector_type(4)));
typedef float f32x4 __attribute__((ext_vector_type(4)));

#ifndef ONE_LAUNCH
#define ONE_LAUNCH 1
#endif

constexpr int MP = 32768, MS = 512, M = MP + MS, DM = 1024, FF = 2816, PS = 2824  , NPAD = 3072;
constexpr int C_AQ = 0, C_AZ = 768, C_BB = 1024, C_BC = 1280, C_BH = 1536, C_CQ = 1792, C_CK = 2048, C_DU = 2304, C_DV = 2560, C_AB = 2816, C_AA = 2820;
constexpr float EPS = 1e-6f;

constexpr size_t O_YP = 0, O_YS = O_YP + (size_t)MP * DM, O_SDP = O_YS + (size_t)MS * DM, O_SDS = O_SDP + 2 * 8 * 4 * 4096, O_SCP = O_SDS + 2 * 128 * 4 * 4096,
                 O_SCS = O_SCP + 2 * 8 * 3 * 768, O_SSP = O_SCS + 2 * 128 * 3 * 768, O_SSS = O_SSP + 2 * 8 * 2 * 256, O_CKP = O_SSS + 2 * 128 * 2 * 256,
                 O_CKS = O_CKP + 2 * 8 * 128 * 128, O_CVP = O_CKS + 2 * 128 * 128 * 128, O_CVS = O_CVP + 2 * 8 * 128 * 128, O_SFP = O_CVS + 2 * 128 * 128 * 128,
                 O_SFS = O_SFP + 2 * 8 * 2 * 2816, O_CHV = O_SFS + 2 * 128 * 2 * 2816, O_END = O_CHV + 2 * 128 * 4 * 256;
static_assert(O_END == 50008064, "output size");

constexpr size_t WS_WIN = 0, WS_WOUT = WS_WIN + (size_t)2 * NPAD * 1024 * 2, WS_WGU = WS_WOUT + (size_t)2 * 1024 * 1024 * 2, WS_WDN = WS_WGU + (size_t)2 * 5632 * 1024 * 2,
                 WS_XB = WS_WDN + (size_t)2 * 1024 * 2816 * 2,
                 WS_PROJ = WS_XB + (size_t)M * 1024 * 2,
                 WS_MIX = WS_PROJ + (size_t)M * PS * 2,
                 WS_SSQA = WS_MIX + (size_t)M * 1024 * 2, WS_SSQB = WS_SSQA + (size_t)M * 16 * 4, WS_BG = WS_SSQB + (size_t)M * 16 * 4,
                 WS_GLS = WS_BG + (size_t)M * 8 * 4,
                 WS_BAR = WS_GLS + 2048 * 4,
                 WS_ROPE = WS_BAR + 16384,
                 WS_QR = WS_ROPE + (size_t)4100 * 16 * 4 + 64,
                 WS_KVR = WS_QR + (size_t)M * 256 * 2, WS_DVN = WS_KVR + (size_t)M * 256 * 2, WS_ORAW = WS_QR,
                 WS_A2 = WS_DVN + (size_t)M * 256 * 2,
                 WS_SG = WS_A2, WS_SU = WS_SG + (size_t)512 * 4 * 2816 * 4,
                 WS_SACC = WS_SU + (size_t)512 * 2 * 2816 * 4,
                 WS_END = WS_A2 + (size_t)2048 * 49152;
static_assert(WS_SACC + (size_t)11 * MS * DM * 4 <= WS_END && WS_SACC + (size_t)4 * MS * 5632 * 4 <= WS_END, "split-K partials");
static_assert(WS_END <= (size_t)536870912, "workspace too large");
static_assert(WS_SU + (size_t)512 * 2 * 2816 * 4 <= WS_END, "side buffers");
static_assert((size_t)M * 256 * 4 <= (size_t)3 * M * 256 * 2, "oraw alias");

constexpr size_t OUT_ORAW = (size_t)M * 768 * 2;
static_assert(OUT_ORAW + (size_t)M * 256 * 4 <= (size_t)MP * DM * 4, "scratch in y region");
struct Args { const float* in[27]; float* out; unsigned char* ws; int coop; int ph_lo; int ph_hi; int pad; };

DEVI int tidx() { int t = threadIdx.x; asm volatile("" : "+v"(t)); return t; }
DEVI int bidx() { int t = blockIdx.x; asm volatile("" : "+s"(t)); return t; }
DEVI int gdim() { int t = gridDim.x; asm volatile("" : "+s"(t)); return t; }
DEVI float bf2f(bf16_t v) { return __uint_as_float(((unsigned)v) << 16); }
DEVI bf16_t f2bf(float f) { unsigned u = __float_as_uint(f); u += 0x7FFFu + ((u >> 16) & 1u); return (bf16_t)(u >> 16); }
DEVI unsigned pk2(float lo, float hi) { unsigned r; asm("v_cvt_pk_bf16_f32 %0, %1, %2" : "=v"(r) : "v"(lo), "v"(hi)); return r; }
DEVI f32x4 ld4bf(const bf16_t* p) { const uint2 u = *(const uint2*)p; f32x4 o; o[0] = __uint_as_float(u.x << 16); o[1] = __uint_as_float(u.x & 0xffff0000u); o[2] = __uint_as_float(u.y << 16); o[3] = __uint_as_float(u.y & 0xffff0000u); return o; }
DEVI f32x4 cv4bf(const uint2 u) { f32x4 o; o[0] = __uint_as_float(u.x << 16); o[1] = __uint_as_float(u.x & 0xffff0000u); o[2] = __uint_as_float(u.y << 16); o[3] = __uint_as_float(u.y & 0xffff0000u); return o; }
DEVI void st4bf(bf16_t* p, f32x4 v) { uint2 u; u.x = pk2(v[0], v[1]); u.y = pk2(v[2], v[3]); *(uint2*)p = u; }
DEVI bf16x8 pack8(f32x4 a, f32x4 b) { union { uint4 u; bf16x8 v; } x; x.u.x = pk2(a[0], a[1]); x.u.y = pk2(a[2], a[3]); x.u.z = pk2(b[0], b[1]); x.u.w = pk2(b[2], b[3]); return x.v; }
typedef unsigned u32x4 __attribute__((ext_vector_type(4)));
DEVI u32x4 pack8e(f32x4 a, f32x4 b) { u32x4 u; u[0] = pk2(a[0], a[1]); u[1] = pk2(a[2], a[3]); u[2] = pk2(b[0], b[1]); u[3] = pk2(b[2], b[3]); return u; }
DEVI uint4 pack8u(f32x4 a, f32x4 b) { uint4 u; u.x = pk2(a[0], a[1]); u.y = pk2(a[2], a[3]); u.z = pk2(b[0], b[1]); u.w = pk2(b[2], b[3]); return u; }

DEVI float silu_f(float y) { return y * __builtin_amdgcn_rcpf(1.f + __expf(-y)); }
DEVI float gelu_f(float x) { const float z = 0.7978845608028654f * (x + 0.044715f * x * x * x); return x * __builtin_amdgcn_rcpf(1.f + __expf(-2.f * z)); }
DEVI f32x4 silu4(f32x4 v) { f32x4 o; for (int i = 0; i < 4; ++i) o[i] = silu_f(v[i]); return o; }
DEVI f32x4 gelu4(f32x4 v) { f32x4 o; for (int i = 0; i < 4; ++i) o[i] = gelu_f(v[i]); return o; }
DEVI float rdlane(float v, int l) { return __builtin_bit_cast(float, __builtin_amdgcn_readlane(__builtin_bit_cast(int, v), l)); }
DEVI void wave_lds_fence() { asm volatile("s_waitcnt lgkmcnt(0)" ::: "memory"); }
template <int CTRL> DEVI float dppf(float x) { return __builtin_bit_cast(float, __builtin_amdgcn_update_dpp(0, __builtin_bit_cast(int, x), CTRL, 0xf, 0xf, true)); }
template <int CTRL> DEVI float dppo(float old, float x) { return __builtin_bit_cast(float, __builtin_amdgcn_update_dpp(__builtin_bit_cast(int, old), __builtin_bit_cast(int, x), CTRL, 0xf, 0xf, false)); }
DEVI float red16(float v) { v += dppf<0x121>(v); v += dppf<0x122>(v); v += dppf<0x124>(v); v += dppf<0x128>(v); return v; }
DEVI float wave_sum(float v) { v = red16(v); v += __shfl_xor(v, 16); v += __shfl_xor(v, 32); return v; }
DEVI float rowscale(const float* ssq, int r) { const f32x4* p = (const f32x4*)(ssq + (size_t)r * 16); const f32x4 a = p[0], b = p[1], c = p[2], d = p[3];
    const float s = (a[0] + a[1] + a[2] + a[3]) + (b[0] + b[1] + b[2] + b[3]) + (c[0] + c[1] + c[2] + c[3]) + (d[0] + d[1] + d[2] + d[3]); return rsqrtf(s * (1.f / 1024.f) + EPS); }
#define GLB __attribute__((address_space(1)))
typedef const __attribute__((address_space(4))) Args* KArgs;
DEVI KArgs kargs() { KArgs p = (KArgs)__builtin_amdgcn_kernarg_segment_ptr(); asm volatile("" : "+s"(p)); return p; }
DEVI unsigned char* wsp(const Args&) { return (unsigned char*)(GLB unsigned char*)kargs()->ws; }
DEVI float* outp(const Args&) { return (float*)(GLB float*)kargs()->out; }
DEVI const float* inp(const Args&, int k) { return (const float*)(GLB const float*)kargs()->in[k]; }
#define MFMA16(a, b, c) __builtin_amdgcn_mfma_f32_16x16x32_bf16((a), (b), (c), 0, 0, 0)

namespace pg8 {
constexpr int BM = 256, BK = 64, HALF = 128, HTB = HALF * BK * 2, STAGE_BYTES = 8 * HTB, NXCD = 8, WGM = 8;
DEVI int lds_byte(int r, int c) { const int st = (r >> 4) * 2 + (c >> 5), rr = r & 15, cc = c & 31, ob = rr * 64 + cc * 2; return st * 1024 + (ob ^ (((ob >> 9) & 1) << 5)); }
DEVI void stage_rc(int b, int& R, int& C) { const int st = b / 1024, sb = b % 1024, swz = sb ^ (((sb >> 9) & 1) << 5); R = (st >> 1) * 16 + swz / 64; C = (st & 1) * 32 + (swz % 64) / 2; }
DEVI int perm32(int rho) { const int n = rho >> 4, i = rho & 15; return 8 * (i >> 2) + 4 * n + (i & 3); }
struct Unit { int pm, pn, k0, nt; };
struct Gemm { const bf16_t* A; const bf16_t* Bt; int M, N, K; };
struct StaticOrder {
    int nM, nN, nwg, G, c, ntf;
    DEVI void init(int M_, int N_, int K_, int G_, int c_) { nM = M_ / BM; nN = N_ / BM; nwg = nM * nN; G = G_; c = c_; ntf = K_ / BK; }
    DEVI bool next(int i, Unit& u) const {
        const long L = (long)i * G + c; if (L >= nwg) return false;
        int wgid = (int)L; { const int q = nwg / NXCD, r = nwg % NXCD, xcd = wgid % NXCD, off = wgid / NXCD; wgid = (xcd < r ? xcd * (q + 1) : r * (q + 1) + (xcd - r) * q) + off; }
        const int nig = WGM * nN, gid = wgid / nig, fm = gid * WGM, gsz = (nM - fm) < WGM ? (nM - fm) : WGM;
        u.pm = fm + ((wgid % nig) % gsz); u.pn = (wgid % nig) / gsz; u.k0 = 0; u.nt = ntf; return true;
    }
    DEVI void a_ready(const Unit&) const {}
    DEVI void done(const Unit&) const {}
};
struct SplitOrder : StaticOrder {
    int nks;
    DEVI bool next(int i, Unit& u) const {
        if (StaticOrder::next(i, u)) return true;
        const long j = (long)i * G + c - nwg; if (j >= 2L * nN * nks) return false;
        const int un = (int)j / nks, ks = (int)j % nks; u.pm = nM + un / nN; u.pn = un % nN; u.k0 = ks * 256; u.nt = 4; return true;
    }
};
template <class Epi, class Sched>
DEVI void gemm_phase(LAS unsigned char* lds, const Gemm g, const Sched& S, const Epi& E) {
    const int tid = tidx(), wid = __builtin_amdgcn_readfirstlane(tid >> 6), lane = tid & 63, wr = wid >> 2, wc = wid & 3, fr = lane & 15, fq = lane >> 4;
    const int K = g.K;
    unsigned voffA[2], voffB[2];
#pragma unroll
    for (int i = 0; i < 2; ++i) { int R, C; stage_rc(tid * 16 + i * 8192, R, C); const int Rb = Epi::PERM ? ((R & ~31) + perm32(R & 31)) : R;
        voffA[i] = (unsigned)(R * K + C) * 2u; voffB[i] = (unsigned)(Rb * K + C) * 2u; }
    const size_t kstep = (size_t)(BK * 2);
    const size_t hstep = (size_t)HALF * K * 2;
    const size_t tstep = 2 * hstep;
    const unsigned ldsw = (unsigned)wid * 1024u;
    const int aoff = lds_byte(wr * 64 + fr, fq * 8), boff = lds_byte(wc * 32 + fr, fq * 8);
#define PG8_SA(b, h) (((b) * 2 + (h)) * HTB)
#define PG8_SB(b, h) ((4 + (b) * 2 + (h)) * HTB)
#define PG8_STAGE(bufoff, gbase, voff) do { _Pragma("unroll") for (int _i = 0; _i < 2; ++_i) \
        __builtin_amdgcn_global_load_lds((const unsigned*)((const char*)(gbase) + (voff)[_i]), (LAS unsigned*)(lds + (bufoff) + ldsw + _i * 8192), 16, 0, 0); } while (0)
#define PG8_LDA(dst, b, h) do { _Pragma("unroll") for (int m = 0; m < 4; ++m) _Pragma("unroll") for (int k = 0; k < 2; ++k) dst[m][k] = *(const LAS bf16x8*)(lds + PG8_SA(b, h) + aoff + m * 2048 + k * 1024); } while (0)
#define PG8_LDB(dst, b, h) do { _Pragma("unroll") for (int n = 0; n < 2; ++n) _Pragma("unroll") for (int k = 0; k < 2; ++k) dst[n][k] = *(const LAS bf16x8*)(lds + PG8_SB(b, h) + boff + n * 2048 + k * 1024); } while (0)
#define PG8_MMA(ai, bj, At, Bt) do { __builtin_amdgcn_s_setprio(1); _Pragma("unroll") for (int m = 0; m < 4; ++m) _Pragma("unroll") for (int n = 0; n < 2; ++n) _Pragma("unroll") for (int k = 0; k < 2; ++k) \
        acc[ai][bj][m][n] = __builtin_amdgcn_mfma_f32_16x16x32_bf16(Bt[n][k], At[m][k], acc[ai][bj][m][n], 0, 0, 0); __builtin_amdgcn_s_setprio(0); } while (0)
#define PG8_WAIT_V(n) asm volatile("s_waitcnt vmcnt(" #n ")" ::: "memory")
#define PG8_WAIT_L(n) asm volatile("s_waitcnt lgkmcnt(" #n ")" ::: "memory")
#define PG8_BAR __builtin_amdgcn_s_barrier()
#define PG8_SCHED __builtin_amdgcn_sched_barrier(0)
    Unit cur, nxt; int ui = 0;
    if (!S.next(0, cur)) return;
#ifndef STAG_TICKS
#define STAG_TICKS 0
#endif
    if (STAG_TICKS) {
        const unsigned long long t0 = __builtin_amdgcn_s_memrealtime(), dl = (unsigned long long)((S.c >> 3) & 7) * STAG_TICKS;
        while (__builtin_amdgcn_s_memrealtime() - t0 < dl) __builtin_amdgcn_s_sleep(8);
    }
    f32x4 acc[2][2][4][2];
#pragma unroll
    for (int a = 0; a < 2; ++a)
#pragma unroll
        for (int b = 0; b < 2; ++b)
#pragma unroll
            for (int m = 0; m < 4; ++m)
#pragma unroll
                for (int n = 0; n < 2; ++n) acc[a][b][m][n] = (f32x4){0.f, 0.f, 0.f, 0.f};
    bf16x8 At[4][2], B0[2][2], B1[2][2];
    const char* cA = (const char*)g.A + (size_t)cur.pm * tstep + (size_t)cur.k0 * 2; const char* cB = (const char*)g.Bt + (size_t)cur.pn * tstep + (size_t)cur.k0 * 2;
    S.a_ready(cur);
    PG8_STAGE(PG8_SB(0, 0), cB, voffB); PG8_STAGE(PG8_SA(0, 0), cA, voffA); PG8_STAGE(PG8_SB(0, 1), cB + hstep, voffB); PG8_STAGE(PG8_SA(0, 1), cA + hstep, voffA);
    if (wr == 1) PG8_BAR;
    PG8_WAIT_V(4); PG8_BAR;
    PG8_STAGE(PG8_SB(1, 0), cB + kstep, voffB); PG8_STAGE(PG8_SA(1, 0), cA + kstep, voffA); PG8_STAGE(PG8_SB(1, 1), cB + hstep + kstep, voffB);
    PG8_WAIT_V(6); PG8_BAR;
    for (;;) {
        const bool has_next = S.next(ui + 1, nxt);
        const char* nA = has_next ? (const char*)g.A + (size_t)nxt.pm * tstep + (size_t)nxt.k0 * 2 : cA; const char* nB = has_next ? (const char*)g.Bt + (size_t)nxt.pn * tstep + (size_t)nxt.k0 * 2 : cB;
        const int nt = cur.nt;
        for (int t = 0; t < nt; t += 2) {
            const bool last = (t == nt - 2);
            const char* a1 = cA + (size_t)(t + 1) * kstep;
            const char* a2 = last ? nA : cA + (size_t)(t + 2) * kstep; const char* b2 = last ? nB : cB + (size_t)(t + 2) * kstep;
            const char* a3 = a2 + kstep; const char* b3 = b2 + kstep;
            if (last && has_next) S.a_ready(nxt);
            PG8_LDB(B0, 0, 0); PG8_SCHED; PG8_LDA(At, 0, 0); PG8_STAGE(PG8_SA(1, 1), a1 + hstep, voffA);
            PG8_WAIT_L(8); PG8_BAR; PG8_WAIT_L(0); PG8_MMA(0, 0, At, B0); PG8_BAR; PG8_SCHED;
            PG8_LDB(B1, 0, 1); PG8_STAGE(PG8_SB(0, 0), b2, voffB);
            PG8_BAR; PG8_WAIT_L(0); PG8_MMA(0, 1, At, B1); PG8_BAR;
            PG8_LDA(At, 0, 1); PG8_STAGE(PG8_SA(0, 0), a2, voffA);
            PG8_BAR; PG8_WAIT_L(0); PG8_MMA(1, 0, At, B0); PG8_BAR; PG8_SCHED;
            PG8_STAGE(PG8_SB(0, 1), b2 + hstep, voffB);
            PG8_WAIT_V(6); PG8_BAR; PG8_MMA(1, 1, At, B1); PG8_BAR;
            PG8_LDB(B0, 1, 0); PG8_SCHED; PG8_LDA(At, 1, 0); PG8_STAGE(PG8_SA(0, 1), a2 + hstep, voffA);
            PG8_WAIT_L(8); PG8_BAR; PG8_WAIT_L(0); PG8_MMA(0, 0, At, B0); PG8_BAR; PG8_SCHED;
            PG8_LDB(B1, 1, 1); PG8_STAGE(PG8_SB(1, 0), b3, voffB);
            PG8_BAR; PG8_WAIT_L(0); PG8_MMA(0, 1, At, B1); PG8_BAR;
            PG8_LDA(At, 1, 1); PG8_STAGE(PG8_SA(1, 0), a3, voffA);
            PG8_BAR; PG8_WAIT_L(0); PG8_MMA(1, 0, At, B0); PG8_BAR; PG8_SCHED;
            PG8_STAGE(PG8_SB(1, 1), b3 + hstep, voffB);
            PG8_WAIT_V(6); PG8_BAR; PG8_MMA(1, 1, At, B1); PG8_BAR;
        }
        E(acc, cur, wr, wc, fr, fq); S.done(cur);
#ifdef EPI_TWICE
        if (Epi::TWICE) E(acc, cur, wr, wc, fr, fq);
#endif
        if (!has_next) break;
#pragma unroll
        for (int a = 0; a < 2; ++a)
#pragma unroll
            for (int b = 0; b < 2; ++b)
#pragma unroll
                for (int m = 0; m < 4; ++m)
#pragma unroll
                    for (int n = 0; n < 2; ++n) acc[a][b][m][n] = (f32x4){0.f, 0.f, 0.f, 0.f};
        cur = nxt; cA = nA; cB = nB; ++ui;
    }
    PG8_WAIT_V(0);
    if (wr == 0) PG8_BAR;
    PG8_BAR;
#undef PG8_SA
#undef PG8_SB
#undef PG8_STAGE
#undef PG8_LDA
#undef PG8_LDB
#undef PG8_MMA
#undef PG8_WAIT_V
#undef PG8_WAIT_L
#undef PG8_BAR
#undef PG8_SCHED
}
}
using pg8::Unit;

struct EpiProj {
    static constexpr bool PERM = true, TWICE = true;
    bf16_t* P; const float* ssq;
    DEVI void operator()(const f32x4 (&acc)[2][2][4][2], const Unit& u, int wr, int wc, int fr, int fq) const {
        const int row0 = u.pm * 256 + wr * 64 + fr, colb = u.pn * 256 + wc * 32 + 8 * fq;
#pragma unroll
        for (int ai = 0; ai < 2; ++ai)
#pragma unroll
            for (int m = 0; m < 4; ++m) { const int r = row0 + ai * 128 + m * 16; const float sc = rowscale(ssq, r);
#pragma unroll
                for (int bj = 0; bj < 2; ++bj) { const int c = colb + bj * 128;
                    if (c < PS) *(uint4*)(P + (size_t)r * PS + c) = pack8u(acc[ai][bj][m][0] * sc, acc[ai][bj][m][1] * sc); } }
    }
};
struct EpiRes {
    static constexpr bool PERM = true, TWICE = false;
    bf16_t* xb; float* ssq; float* sacc;
    DEVI void operator()(const f32x4 (&acc)[2][2][4][2], const Unit& u, int wr, int wc, int fr, int fq) const {
        const int row0 = u.pm * 256 + wr * 64 + fr, colb = u.pn * 256 + wc * 32 + 8 * fq;
        if (sacc != nullptr && u.pm >= 128) {
#pragma unroll
            for (int ai = 0; ai < 2; ++ai)
#pragma unroll
                for (int m = 0; m < 4; ++m) { float* dp = sacc + (size_t)(u.k0 >> 8) * ((size_t)MS * DM) + (size_t)(row0 + ai * 128 + m * 16 - MP) * DM + colb;
#pragma unroll
                    for (int bj = 0; bj < 2; ++bj) { *(f32x4*)(dp + bj * 128) = acc[ai][bj][m][0]; *(f32x4*)(dp + bj * 128 + 4) = acc[ai][bj][m][1]; } }
            return;
        }
#pragma unroll
        for (int ai = 0; ai < 2; ++ai)
#pragma unroll
            for (int m = 0; m < 4; ++m) { const int r = row0 + ai * 128 + m * 16; float part = 0.f;
#pragma unroll
                for (int bj = 0; bj < 2; ++bj) { const int c = colb + bj * 128; bf16_t* xp = xb + (size_t)r * DM + c;
                    const uint4 rv = *(const uint4*)xp;
                    const f32x4 v0 = acc[ai][bj][m][0] + cv4bf((uint2){rv.x, rv.y}), v1 = acc[ai][bj][m][1] + cv4bf((uint2){rv.z, rv.w});
                    *(uint4*)xp = pack8u(v0, v1);
                    part += v0[0] * v0[0] + v0[1] * v0[1] + v0[2] * v0[2] + v0[3] * v0[3] + v1[0] * v1[0] + v1[1] * v1[1] + v1[2] * v1[2] + v1[3] * v1[3]; }
                part += __shfl_xor(part, 16); part += __shfl_xor(part, 32);
                if (fq == 0) ssq[(size_t)r * 16 + u.pn * 4 + wc] = part; }
    }
};
struct EpiGU {
    static constexpr bool PERM = true, TWICE = false;
    bf16_t* act; const float* ssq; const float* cw; float* sg; float* su; float* osfp; float* sacc;
    DEVI void operator()(const f32x4 (&acc)[2][2][4][2], const Unit& u, int wr, int wc, int fr, int fq) const {
        if (u.pm >= 128) {
            const int row0 = u.pm * 256 + wr * 64 + fr - MP, colb = u.pn * 256 + wc * 32 + 8 * fq;
#pragma unroll
            for (int ai = 0; ai < 2; ++ai)
#pragma unroll
                for (int m = 0; m < 4; ++m) { float* dp = sacc + (size_t)(u.k0 >> 8) * ((size_t)MS * 5632) + (size_t)(row0 + ai * 128 + m * 16) * 5632 + colb;
#pragma unroll
                    for (int bj = 0; bj < 2; ++bj) { *(f32x4*)(dp + bj * 128) = acc[ai][bj][m][0]; *(f32x4*)(dp + bj * 128 + 4) = acc[ai][bj][m][1]; } }
            return;
        }
        const int f0 = u.pn * 128 + wc * 32 + 8 * fq;
        const f32x4 w0a = *(const f32x4*)(cw + f0), w0b = *(const f32x4*)(cw + f0 + 4), w1a = *(const f32x4*)(cw + FF + f0), w1b = *(const f32x4*)(cw + FF + f0 + 4),
                    w2a = *(const f32x4*)(cw + 2 * FF + f0), w2b = *(const f32x4*)(cw + 2 * FF + f0 + 4);
#pragma unroll
        for (int ai = 0; ai < 2; ++ai) {
            const int rb = u.pm * 256 + ai * 128 + wr * 64;
            f32x4 pva = {0.f, 0.f, 0.f, 0.f}, pvb = {0.f, 0.f, 0.f, 0.f};
#pragma unroll
            for (int m = 0; m < 4; ++m) {
                const int r = rb + 16 * m + fr;
                const float scm = rowscale(ssq, r);
                const f32x4 ga0 = acc[ai][0][m][0] * scm, gb0 = acc[ai][0][m][1] * scm;
                const f32x4 ua = acc[ai][1][m][0] * scm, ub = acc[ai][1][m][1] * scm;
                f32x4 p1a, p1b, p2a, p2b;
#pragma unroll
                for (int jj = 0; jj < 4; ++jj) {
                    const float ca = ga0[jj], cb = gb0[jj], pa = pva[jj], pb = pvb[jj];
                    p1a[jj] = dppo<0x111>(dppf<0x10F>(pa), ca); p2a[jj] = dppo<0x112>(dppf<0x10E>(pa), ca);
                    p1b[jj] = dppo<0x111>(dppf<0x10F>(pb), cb); p2b[jj] = dppo<0x112>(dppf<0x10E>(pb), cb);
                }
                const bool head = m == 0 && fr < 2;
                if (!head) {
                    const f32x4 ga = w0a * p2a + w1a * p1a + w2a * ga0, gb = w0b * p2b + w1b * p1b + w2b * gb0;
                    *(uint4*)(act + (size_t)r * FF + f0) = pack8u(silu4(ga) * ua, silu4(gb) * ub);
                }
                const int blk = rb >> 6;
                if (m == 0 && fr < 2) { float* o = sg + ((size_t)blk * 4 + fr) * FF + f0; *(f32x4*)o = ga0; *(f32x4*)(o + 4) = gb0;
                    float* o2 = su + ((size_t)blk * 2 + fr) * FF + f0; *(f32x4*)o2 = ua; *(f32x4*)(o2 + 4) = ub; }
                if (m == 3 && fr >= 14) { float* o = sg + ((size_t)blk * 4 + 2 + (fr - 14)) * FF + f0; *(f32x4*)o = ga0; *(f32x4*)(o + 4) = gb0;
                    const int t = r & 4095; if (t >= 4094) { float* o3 = osfp + ((size_t)(r >> 12) * 2 + (t - 4094)) * FF + f0; *(f32x4*)o3 = ga0; *(f32x4*)(o3 + 4) = gb0; } }
                pva = ga0; pvb = gb0;
            }
        }
    }
};

__device__ void phase_prep(const Args& a, unsigned char* smem) {
    float* tile = (float*)smem;
    const int tid = tidx(), tx = tid & 63, ty = tid >> 6, lane = tid & 63, wid = tid >> 6;
    constexpr int T_IN = 48 * 4, T_OUT = 16 * 4, T_GU = 88 * 4, T_DN = 16 * 11, T_L = T_IN + T_OUT + T_GU + T_DN;
    for (int it = bidx(); it < 2 * T_L; it += gdim()) {
        const int l = it / T_L; int r = it % T_L;
        const float* src; int ld, col, kt, nt, Kd; const float* gk = nullptr; bf16_t* dst;
        if (r < T_IN) { nt = r / 4; kt = r % 4; Kd = 1024; ld = PS; src = inp(a, 9) + (size_t)l * 1024 * PS; gk = inp(a, 8) + l * 1024; dst = (bf16_t*)(wsp(a) + WS_WIN) + (size_t)l * NPAD * 1024;
            const int n = nt * 64 + tx; col = n < 1024 ? n : (n < 2816 ? n + 8 : (n < 2824 ? 1024 + (n - 2816) : -1)); }
        else if ((r -= T_IN) < T_OUT) { nt = r / 4; kt = r % 4; Kd = 1024; ld = 1024; src = inp(a, 20) + (size_t)l * 1024 * 1024; dst = (bf16_t*)(wsp(a) + WS_WOUT) + (size_t)l * 1024 * 1024; col = nt * 64 + tx; }
        else if ((r -= T_OUT) < T_GU) { nt = r / 4; kt = r % 4; Kd = 1024; ld = FF; gk = inp(a, 21) + l * 1024; dst = (bf16_t*)(wsp(a) + WS_WGU) + (size_t)l * 5632 * 1024;
            const int n = nt * 64, pn = n >> 8, cc = n & 255; src = (cc < 128 ? inp(a, 22) : inp(a, 23)) + (size_t)l * 1024 * FF; col = pn * 128 + (cc & 127) + tx; }
        else { r -= T_GU; nt = r / 11; kt = r % 11; Kd = FF; ld = 1024; src = inp(a, 25) + (size_t)l * FF * 1024; dst = (bf16_t*)(wsp(a) + WS_WDN) + (size_t)l * 1024 * FF; col = nt * 64 + tx; }
        float v[32];
#pragma unroll
        for (int i = 0; i < 32; ++i) { const int k = kt * 256 + ty + 8 * i; v[i] = col >= 0 ? __builtin_nontemporal_load(src + (size_t)k * ld + col) : 0.f; }
        if (gk) {
#pragma unroll
            for (int i = 0; i < 32; ++i) v[i] *= gk[kt * 256 + ty + 8 * i]; }
#pragma unroll
        for (int i = 0; i < 32; ++i) tile[(ty + 8 * i) * 65 + tx] = v[i];
        __syncthreads();
#pragma unroll
        for (int i = 0; i < 8; ++i) { const int n = wid * 8 + i; const int k0 = lane * 4;
            f32x4 o = {tile[(k0 + 0) * 65 + n], tile[(k0 + 1) * 65 + n], tile[(k0 + 2) * 65 + n], tile[(k0 + 3) * 65 + n]};
            st4bf(dst + (size_t)(nt * 64 + n) * Kd + kt * 256 + k0, o); }
        __syncthreads();
    }
    {   float* rt = (float*)(wsp(a) + WS_ROPE);
        for (int i = bidx() * 512 + tid; i < 4100 * 8; i += gdim() * 512) { const int pi = i >> 3, fi = i & 7, pos = pi < 4096 ? pi : 16384 + (pi - 4096);
            const float ang = (float)pos * powf(500000.f, -(float)fi * 0.125f); const double rd = (double)ang * 0.15915494309189535; const float rr = (float)((rd - floor(rd)) * 6.283185307179586);
            rt[pi * 16 + fi] = __cosf(rr); rt[pi * 16 + 8 + fi] = __sinf(rr); } }
    bf16_t* xb = (bf16_t*)(wsp(a) + WS_XB); float* ssq = (float*)(wsp(a) + WS_SSQA);
    for (int r = bidx() * 8 + wid; r < M; r += gdim() * 8) {
        const float* xr = (r < MP) ? inp(a, 0) + (size_t)r * DM : inp(a, 1) + (size_t)(r - MP) * DM; float ss = 0.f;
#pragma unroll
        for (int q = 0; q < 4; ++q) { const f32x4 v = __builtin_nontemporal_load((const f32x4*)(xr + q * 256 + lane * 4)); ss += v[0] * v[0] + v[1] * v[1] + v[2] * v[2] + v[3] * v[3]; st4bf(xb + (size_t)r * DM + q * 256 + lane * 4, v); }
        ss = wave_sum(ss);
        if (lane < 16) ssq[(size_t)r * 16 + lane] = lane == 0 ? ss : 0.f;
    }
}

struct TokRaw { uint2 a0, a1, a2, bc, bh, bb, q, kv, dv, du; f32x4 cs, sn; };
DEVI TokRaw ldtok(const bf16_t* pr, const float* rp, int c4, int lane) { TokRaw t; t.cs = *(const f32x4*)(rp + 4 * (lane & 1)); t.sn = *(const f32x4*)(rp + 8 + 4 * (lane & 1)); t.a0 = *(const uint2*)(pr + C_AQ + c4); t.a1 = *(const uint2*)(pr + C_AQ + 256 + c4); t.a2 = *(const uint2*)(pr + C_AQ + 512 + c4);
    t.bc = *(const uint2*)(pr + C_BC + c4); t.bh = *(const uint2*)(pr + C_BH + c4); t.bb = *(const uint2*)(pr + C_BB + c4); t.q = *(const uint2*)(pr + C_CQ + c4); t.kv = *(const uint2*)(pr + C_CK + c4);
    t.dv = *(const uint2*)(pr + C_DV + c4); t.du = *(const uint2*)(pr + C_DU + c4); return t; }
__device__ void phase_tok(const Args& a, const int l, unsigned char* smem) {
    const int lane = tidx() & 63, wid = tidx() >> 6, c4 = lane * 4;
    const bf16_t* proj = (const bf16_t*)(wsp(a) + WS_PROJ);
    bf16_t* qkvn = (bf16_t*)outp(a); bf16_t* mix = (bf16_t*)(wsp(a) + WS_MIX); float* bg = (float*)(wsp(a) + WS_BG);
    bf16_t* qr = (bf16_t*)(wsp(a) + WS_QR); bf16_t* kvr = (bf16_t*)(wsp(a) + WS_KVR); bf16_t* dvn = (bf16_t*)(wsp(a) + WS_DVN);
    float* out = outp(a);
    float* sw = (float*)smem;
    for (int i = tidx(); i < 4352; i += 512) sw[i] = i < 3072 ? inp(a, 10)[(size_t)l * 3072 + i] : (i < 3840 ? inp(a, 14)[(size_t)l * 768 + i - 3072] : (i < 4096 ? inp(a, 16)[l * 256 + i - 3840] : inp(a, 17)[l * 256 + i - 4096]));
    __syncthreads();
    const float* cwp = sw + c4;
    const float* bwp = sw + 3072 + c4; const float* lngp = sw + 3840 + c4; const float* lnbp = sw + 4096 + c4;
    float inv[4];
#pragma unroll
    for (int e = 0; e < 4; ++e) inv[e] = powf(500000.f, -(float)(4 * (lane & 1) + e) * 0.125f);
    const int j16 = lane & 15, gD = lane >> 4;
    const float dtb = inp(a, 12)[l * 4 + (lane & 3)], nega = -__expf(inp(a, 11)[l * 4 + (lane & 3)]);
    const float* Wd = inp(a, 18) + ((size_t)(l * 4 + gD) * 128) * 128; const float* biasd = inp(a, 19) + (size_t)(l * 4 + gD) * 128;
    {
        const float* ck = inp(a, 5) + (size_t)l * 128 * 16384; const float* cv = inp(a, 6) + (size_t)l * 128 * 16384;
        float* ok = out + O_CKS + (size_t)l * 128 * 16384; float* ov = out + O_CVS + (size_t)l * 128 * 16384;
        for (int i = bidx() * 512 + tidx(); i < 128 * 3968; i += gdim() * 512) { const int bb = i / 3968, j = i - bb * 3968; const size_t o = (size_t)bb * 16384 + (size_t)j * 4;
            *(f32x4*)(ok + o) = *(const f32x4*)(ck + o + 512); *(f32x4*)(ov + o) = *(const f32x4*)(cv + o + 512); }
    }
    for (int pass = 0; pass < 2; ++pass) {
        const int B = bidx();
        bool smp; int b, t0, ntok; size_t r0;
        if (pass == 0) { smp = false; b = B >> 5; int off = 16 * wid, len = 16;
            if (B < 128) { off = wid < 4 ? 17 * wid : 68 + 16 * (wid - 4); len = wid < 4 ? 17 : (wid < 7 ? 16 : 12); }
            t0 = (B & 31) * 128 + off; ntok = len; r0 = (size_t)b * 4096 + t0; }
        else { if (!(wid == 7 && B < 128)) break; smp = true; b = B; t0 = 0; ntok = 4; r0 = (size_t)MP + 4 * b; }
        f32x4 ha[3][3], hb[2];
        const f32x4 z4 = {0.f, 0.f, 0.f, 0.f};
        if (smp) {
            const float* st = inp(a, 3) + ((size_t)(l * 128 + b) * 3) * 768;
#pragma unroll
            for (int p = 0; p < 3; ++p)
#pragma unroll
                for (int j = 0; j < 3; ++j) ha[p][j] = *(const f32x4*)(st + j * 768 + p * 256 + c4);
            const float* sb = inp(a, 4) + ((size_t)(l * 128 + b) * 2) * 256; hb[0] = *(const f32x4*)(sb + c4); hb[1] = *(const f32x4*)(sb + 256 + c4);
        } else if (t0 == 0) {
#pragma unroll
            for (int p = 0; p < 3; ++p)
#pragma unroll
                for (int j = 0; j < 3; ++j) ha[p][j] = z4;
            hb[0] = z4; hb[1] = z4;
        } else {
#pragma unroll
            for (int p = 0; p < 3; ++p)
#pragma unroll
                for (int j = 0; j < 3; ++j) ha[p][j] = ld4bf(proj + (r0 - 3 + j) * PS + C_AQ + p * 256 + c4);
#pragma unroll
            for (int j = 0; j < 2; ++j) hb[j] = ld4bf(proj + (r0 - 2 + j) * PS + C_BC + c4) * ld4bf(proj + (r0 - 2 + j) * PS + C_BH + c4);
        }
        f32x4 h0 = z4, h1 = z4, h2 = z4, h3 = z4;
        {
            const int hh = lane & 3;
            for (int ti = lane >> 2; ti < ntok; ti += 16) { const bf16_t* pr = proj + (r0 + ti) * PS;
                const float ab = bf2f(pr[C_AB + hh]), aa = bf2f(pr[C_AA + hh]);
                const float beta = __builtin_amdgcn_rcpf(1.f + __expf(-ab)); const float x = aa + dtb; const float sp = x > 20.f ? x : log1pf(__expf(x));
                bg[(r0 + ti) * 8 + hh] = beta; bg[(r0 + ti) * 8 + 4 + hh] = nega * sp; }
        }
        const float* ropet = (const float*)(wsp(a) + WS_ROPE) + (size_t)(smp ? 4096 : t0) * 16;
        TokRaw nx = ldtok(proj + r0 * PS, ropet, c4, lane);
#pragma unroll 1
        for (int i = 0; i < ntok; ++i) {
            const size_t r = r0 + i; const int t = t0 + i;
            const TokRaw tk = nx;
            const float* cwq = cwp; const float* bwq = bwp;
            nx = ldtok(proj + (r0 + (i + 1 < ntok ? i + 1 : i)) * PS, ropet + (i + 1 < ntok ? i + 1 : i) * 16, c4, lane);
#pragma unroll
            for (int p = 0; p < 3; ++p) {
                const f32x4 cur = cv4bf(p == 0 ? tk.a0 : (p == 1 ? tk.a1 : tk.a2));
                f32x4 s = silu4(*(const f32x4*)(cwq + p * 256) * ha[p][0] + *(const f32x4*)(cwq + 768 + p * 256) * ha[p][1] + *(const f32x4*)(cwq + 1536 + p * 256) * ha[p][2] + *(const f32x4*)(cwq + 2304 + p * 256) * cur);
                ha[p][0] = ha[p][1]; ha[p][1] = ha[p][2]; ha[p][2] = cur;
                if (p < 2) { float ss = red16(s[0] * s[0] + s[1] * s[1] + s[2] * s[2] + s[3] * s[3]); const float sc = rsqrtf(ss + EPS) * (p == 0 ? 0.125f : 1.f); s = s * sc; }
                st4bf(qkvn + r * 768 + p * 256 + c4, s);
                if (!smp) { if (t >= 4093) *(f32x4*)(out + O_SCP + ((size_t)(l * 8 + b) * 3 + (t - 4093)) * 768 + p * 256 + c4) = cur; }
                else if (i >= 1) *(f32x4*)(out + O_SCS + ((size_t)(l * 128 + b) * 3 + (i - 1)) * 768 + p * 256 + c4) = cur;
            }
            {
                const f32x4 s = cv4bf(tk.bc) * cv4bf(tk.bh), bb = cv4bf(tk.bb);
                const f32x4 bx = *(const f32x4*)bwq * hb[0] + *(const f32x4*)(bwq + 256) * hb[1] + *(const f32x4*)(bwq + 512) * s;
                st4bf(mix + r * DM + 256 + c4, bb * bx); hb[0] = hb[1]; hb[1] = s;
                if (!smp) { if (t >= 4094) *(f32x4*)(out + O_SSP + ((size_t)(l * 8 + b) * 2 + (t - 4094)) * 256 + c4) = s; }
                else if (i >= 2) *(f32x4*)(out + O_SSS + ((size_t)(l * 128 + b) * 2 + (i - 2)) * 256 + c4) = s;
            }
            {
                f32x4 q = cv4bf(tk.q), kv = cv4bf(tk.kv), qo, ko;
#pragma unroll
                for (int e = 0; e < 4; ++e) { qo[e] = dppf<0x4E>(q[e]); ko[e] = dppf<0x4E>(kv[e]); }
                if (j16 < 4) {
                    const float sgn = j16 < 2 ? -1.f : 1.f;
#pragma unroll
                    for (int e = 0; e < 4; ++e) {
                        const float cs = tk.cs[e], sn = tk.sn[e];
                        q[e] = q[e] * cs + sgn * qo[e] * sn;
                        if (lane < 32) kv[e] = kv[e] * cs + sgn * ko[e] * sn;
                    }
                }
                st4bf(qr + r * 256 + c4, q); st4bf(kvr + r * 256 + c4, kv);
                if (!smp) { if (t >= 3968) { float* o = (lane < 32 ? out + O_CKP : out + O_CVP) + ((size_t)(l * 8 + b) * 128 + (t - 3968)) * 128 + (c4 & 127); *(f32x4*)o = kv; } }
                else { float* o = (lane < 32 ? out + O_CKS : out + O_CVS) + ((size_t)(l * 128 + b) * 128 + 124 + i) * 128 + (c4 & 127); *(f32x4*)o = kv; }
            }
            {
                const f32x4 x = gelu4(cv4bf(tk.dv));
                const float mean = wave_sum(x[0] + x[1] + x[2] + x[3]) * (1.f / 256.f);
                const f32x4 xc = x - mean;
                const float var = wave_sum(xc[0] * xc[0] + xc[1] * xc[1] + xc[2] * xc[2] + xc[3] * xc[3]) * (1.f / 256.f);
                const f32x4 y = xc * rsqrtf(var + EPS) * *(const f32x4*)lngp + *(const f32x4*)lnbp;
                st4bf(dvn + r * 256 + c4, y);
                if (smp) {
                    *(f32x4*)(out + O_CHV + ((size_t)(l * 128 + b) * 4 + i) * 256 + c4) = y;
                    if (i == 0) h0 = y; else if (i == 1) h1 = y; else if (i == 2) h2 = y; else h3 = y;
                    f32x4 mx = Wd[i * 128 + 0] * h0 + biasd[i];
                    if (i >= 1) mx = mx + Wd[i * 128 + 1] * h1;
                    if (i >= 2) mx = mx + Wd[i * 128 + 2] * h2;
                    if (i >= 3) mx = mx + Wd[i * 128 + 3] * h3;
                    st4bf(mix + r * DM + 768 + c4, gelu4(cv4bf(tk.du)) * mx);
                }
            }
        }
    }
}

constexpr int A2_LDS = 64 * 68 * 4 + 512;
DEVI int fragidx(int row, int col) { return (((row >> 4) * 2 + (col >> 5)) * 64 + ((col >> 2) & 3) * 16 + (row & 15)) * 8 + 4 * ((col >> 4) & 1) + (col & 3); }
__device__ void a2_item(const Args& a, const int it, unsigned char* wl) {
    const int lane = tidx() & 63, fr = lane & 15, fq = lane >> 4;
    float* Aw = (float*)wl; float* gcs = Aw + 64 * 68; float* bts = gcs + 64;
    const int h = it & 3, n = (it >> 2) & 63, b = it >> 8;
    const size_t t0 = (size_t)b * 4096 + n * 64;
    const float* bg = (const float*)(wsp(a) + WS_BG); const bf16_t* qkvn = (const bf16_t*)outp(a);
    float gcv = bg[(t0 + lane) * 8 + 4 + h]; const float bt = bg[(t0 + lane) * 8 + h];
    for (int d = 1; d < 64; d <<= 1) { const float o = __shfl_up(gcv, d); if (lane >= d) gcv += o; }
    const float gl = __shfl(gcv, 63);
    gcs[lane] = gcv; bts[lane] = bt;
    const bf16_t* qb = qkvn + t0 * 768 + h * 64; const bf16_t* kb = qb + 256; const bf16_t* vb = qb + 512;
    bf16x8 kf[4][2], qf[4][2];
#pragma unroll
    for (int m = 0; m < 4; ++m)
#pragma unroll
        for (int kk = 0; kk < 2; ++kk) { kf[m][kk] = *(const bf16x8*)(kb + (size_t)(16 * m + fr) * 768 + 32 * kk + 8 * fq); qf[m][kk] = *(const bf16x8*)(qb + (size_t)(16 * m + fr) * 768 + 32 * kk + 8 * fq); }
    wave_lds_fence();
    unsigned char* cbase = wsp(a) + WS_A2 + (size_t)it * 49152;
    if (lane == 0) ((float*)(wsp(a) + WS_GLS))[it] = gl;
#pragma unroll
    for (int m = 0; m < 4; ++m) {
        const int i = 16 * m + fr; const float gi = gcs[i], bi = bts[i];
#pragma unroll
        for (int k2 = 0; k2 < 2; ++k2) {
            f32x4 ak[2], aq[2];
#pragma unroll
            for (int hh = 0; hh < 2; ++hh) {
                const int nn = 2 * k2 + hh;
                ak[hh] = (f32x4){0.f, 0.f, 0.f, 0.f}; aq[hh] = (f32x4){0.f, 0.f, 0.f, 0.f};
                if (nn <= m) {
#pragma unroll
                    for (int kk = 0; kk < 2; ++kk) { ak[hh] = MFMA16(kf[nn][kk], kf[m][kk], ak[hh]); aq[hh] = MFMA16(kf[nn][kk], qf[m][kk], aq[hh]); }
                    const f32x4 gj = *(const f32x4*)(gcs + 16 * nn + 4 * fq);
#pragma unroll
                    for (int jj = 0; jj < 4; ++jj) { const int j = 16 * nn + 4 * fq + jj; const float e = __expf(fminf(gi - gj[jj], 0.f));
                        ak[hh][jj] = (j < i) ? bi * ak[hh][jj] * e : 0.f; aq[hh][jj] = (j <= i) ? aq[hh][jj] * e : 0.f; }
                }
                *(f32x4*)(Aw + i * 68 + 16 * nn + 4 * fq) = ak[hh];
            }
            *(uint4*)(cbase + ((m * 2 + k2) * 64 + lane) * 16) = pack8u(aq[0], aq[1]);
        }
    }
#pragma unroll
    for (int m = 0; m < 4; ++m)
#pragma unroll
        for (int kk = 0; kk < 2; ++kk) { const int i = 16 * m + fr; const float e = __expf(gcs[i]);
            const f32x4 lo = ld4bf(qb + (size_t)i * 768 + 32 * kk + 4 * fq) * e, hi = ld4bf(qb + (size_t)i * 768 + 32 * kk + 16 + 4 * fq) * e;
            *(uint4*)(cbase + 16384 + ((m * 2 + kk) * 64 + lane) * 16) = pack8u(lo, hi); }
    wave_lds_fence();
    const int c = lane;
    bf16_t* wF = (bf16_t*)(cbase + 8192); bf16_t* kdF = (bf16_t*)(cbase + 24576); float* uS = (float*)(cbase + 32768);
    {
        float U[64];
#pragma unroll
        for (int i = 0; i < 64; ++i) U[i] = bf2f(vb[(size_t)i * 768 + c]);
#pragma unroll
        for (int i = 0; i < 64; ++i) {
            const float vi = U[i];
            float su = bts[i] * vi;
            f32x4 ar[16];
#pragma unroll
            for (int q = 0; q < (i + 3) / 4; ++q) ar[q] = *(const f32x4*)(Aw + i * 68 + 4 * q);
            asm volatile("" : "+v"(su) :: "memory");
#pragma unroll
            for (int q = 0; q < (i + 3) / 4; ++q)
#pragma unroll
                for (int jj = 0; jj < 4; ++jj) if (4 * q + jj < i) su -= ar[q][jj] * U[4 * q + jj];
            U[i] = su;
            uS[(((c >> 4) * 4 + (i >> 4)) * 64 + ((i >> 2) & 3) * 16 + (c & 15)) * 4 + (i & 3)] = su;
            asm volatile("" ::: "memory");
        }
    }
    {
        float W[64];
#pragma unroll
        for (int i = 0; i < 64; ++i) W[i] = bf2f(kb[(size_t)i * 768 + c]);
#pragma unroll
        for (int i = 0; i < 64; ++i) {
            const float ki = W[i];
            const float bi = bts[i], gi = gcs[i];
            float sw = bi * __expf(gi) * ki;
            f32x4 ar[16];
#pragma unroll
            for (int q = 0; q < (i + 3) / 4; ++q) ar[q] = *(const f32x4*)(Aw + i * 68 + 4 * q);
            asm volatile("" : "+v"(sw) :: "memory");
#pragma unroll
            for (int q = 0; q < (i + 3) / 4; ++q)
#pragma unroll
                for (int jj = 0; jj < 4; ++jj) if (4 * q + jj < i) sw -= ar[q][jj] * W[4 * q + jj];
            W[i] = sw;
            kdF[fragidx(c, i)] = f2bf(ki * __expf(gl - gi));
            wF[fragidx(i, c)] = f2bf(sw);
            asm volatile("" ::: "memory");
        }
    }
}

__device__ void sdelta_item(const Args& a, const int l, const int it) {
    const int lane = tidx() & 63, h = it & 3, b = it >> 2;
    const float* S0 = inp(a, 2) + ((size_t)(l * 128 + b) * 4 + h) * 4096;
    const float* bg = (const float*)(wsp(a) + WS_BG); const bf16_t* qkvn = (const bf16_t*)outp(a);
    float S[64];
#pragma unroll
    for (int i = 0; i < 64; ++i) S[i] = S0[i * 64 + lane];
    for (int t = 0; t < 4; ++t) {
        const size_t r = (size_t)MP + 4 * b + t; const bf16_t* p = qkvn + r * 768 + h * 64 + lane;
        const float qv = bf2f(p[0]), kv = bf2f(p[256]), vv = bf2f(p[512]); const float beta = bg[r * 8 + h], eg = __expf(bg[r * 8 + 4 + h]);
        float rr = 0.f;
#pragma unroll
        for (int i = 0; i < 64; ++i) { S[i] *= eg; rr += rdlane(kv, i) * S[i]; }
        const float cc = beta * (vv - rr); float oo = 0.f;
#pragma unroll
        for (int i = 0; i < 64; ++i) { S[i] += rdlane(kv, i) * cc; oo += rdlane(qv, i) * S[i]; }
        {
            const float ss = wave_sum(oo * oo);
            const float y = oo * rsqrtf(ss * (1.f / 64.f) + EPS) * inp(a, 13)[l * 64 + lane];
            const float z = bf2f(((const bf16_t*)(wsp(a) + WS_PROJ))[r * PS + C_AZ + h * 64 + lane]);
            ((bf16_t*)(wsp(a) + WS_MIX))[r * DM + h * 64 + lane] = f2bf(y * silu_f(z));
        }
    }
    float* So = outp(a) + O_SDS + ((size_t)(l * 128 + b) * 4 + h) * 4096;
#pragma unroll
    for (int i = 0; i < 64; ++i) So[i * 64 + lane] = S[i];
}

__device__ void sattn_item(const Args& a, const int l, const int it) {
    const int lane = tidx() & 63, hq = it & 3, b = it >> 2, kvh = hq >> 1;
    const float* ck = inp(a, 5) + (size_t)(l * 128 + b) * 16384 + kvh * 64; const float* cv = inp(a, 6) + (size_t)(l * 128 + b) * 16384 + kvh * 64;
    const bf16_t* qr = (const bf16_t*)(wsp(a) + WS_QR); const bf16_t* kvr = (const bf16_t*)(wsp(a) + WS_KVR); bf16_t* mix = (bf16_t*)(wsp(a) + WS_MIX);
    const size_t r0 = (size_t)MP + 4 * b;
    float qv[4];
#pragma unroll
    for (int i = 0; i < 4; ++i) qv[i] = bf2f(qr[(r0 + i) * 256 + hq * 64 + lane]);
    float s[3][4];
#pragma unroll
    for (int sl = 0; sl < 3; ++sl) {
        float acc0 = 0.f, acc1 = 0.f, acc2 = 0.f, acc3 = 0.f;
        if (sl < 2) { const float* kp = ck + (size_t)(sl * 64 + lane) * 128;
#pragma unroll
            for (int d4 = 0; d4 < 16; ++d4) { const f32x4 kx = *(const f32x4*)(kp + d4 * 4);
#pragma unroll
                for (int e = 0; e < 4; ++e) { const int d = d4 * 4 + e; acc0 += rdlane(qv[0], d) * kx[e]; acc1 += rdlane(qv[1], d) * kx[e]; acc2 += rdlane(qv[2], d) * kx[e]; acc3 += rdlane(qv[3], d) * kx[e]; } }
        } else { const bf16_t* kp = kvr + (r0 + (lane & 3)) * 256 + kvh * 64;
#pragma unroll
            for (int d4 = 0; d4 < 16; ++d4) { const f32x4 kx = ld4bf(kp + d4 * 4);
#pragma unroll
                for (int e = 0; e < 4; ++e) { const int d = d4 * 4 + e; acc0 += rdlane(qv[0], d) * kx[e]; acc1 += rdlane(qv[1], d) * kx[e]; acc2 += rdlane(qv[2], d) * kx[e]; acc3 += rdlane(qv[3], d) * kx[e]; } }
        }
        s[sl][0] = acc0; s[sl][1] = acc1; s[sl][2] = acc2; s[sl][3] = acc3;
    }
    const float sink = inp(a, 15)[l * 4 + hq];
    float inv[4];
#pragma unroll
    for (int i = 0; i < 4; ++i) {
        const bool v0 = lane > i, v1 = true, v2 = lane <= i && lane < 4;
        const float x0 = v0 ? s[0][i] * 0.125f : -1e30f, x1 = v1 ? s[1][i] * 0.125f : -1e30f, x2 = v2 ? s[2][i] * 0.125f : -1e30f;
        float mx = fmaxf(fmaxf(x0, x1), x2);
        for (int d = 1; d < 64; d <<= 1) mx = fmaxf(mx, __shfl_xor(mx, d));
        mx = fmaxf(mx, sink);
        const float p0 = v0 ? __expf(x0 - mx) : 0.f, p1 = __expf(x1 - mx), p2 = v2 ? __expf(x2 - mx) : 0.f;
        const float sum = wave_sum(p0 + p1 + p2) + __expf(sink - mx);
        s[0][i] = p0; s[1][i] = p1; s[2][i] = p2; inv[i] = __builtin_amdgcn_rcpf(sum);
    }
    float o[4] = {0.f, 0.f, 0.f, 0.f};
#pragma unroll
    for (int sl = 0; sl < 2; ++sl)
#pragma unroll 1
        for (int j0 = 0; j0 < 64; j0 += 16) { float vv[16];
#pragma unroll
            for (int e = 0; e < 16; ++e) vv[e] = cv[(size_t)(sl * 64 + j0 + e) * 128 + lane];
#pragma unroll
            for (int e = 0; e < 16; ++e)
#pragma unroll
                for (int i = 0; i < 4; ++i) o[i] += rdlane(s[sl][i], j0 + e) * vv[e]; }
#pragma unroll
    for (int jj = 0; jj < 4; ++jj) { const float vv = bf2f(kvr[(r0 + jj) * 256 + 128 + kvh * 64 + lane]);
#pragma unroll
        for (int i = 0; i < 4; ++i) o[i] += rdlane(s[2][i], jj) * vv; }
#pragma unroll
    for (int i = 0; i < 4; ++i) mix[(r0 + i) * DM + 512 + hq * 64 + lane] = f2bf(o[i] * inv[i]);
}

__device__ void c_item(const Args& a, const int l, const int it, unsigned char* smem) {
    const int tid = tidx(), lane = tid & 63, w = tid >> 6, fr = lane & 15, fq = lane >> 4;
    const int qb = it & 63, kvh = (it >> 6) & 1, b = it >> 7;
    bf16_t* Ks = (bf16_t*)smem; bf16_t* Vt = Ks + 192 * 72;
    const bf16_t* kvr = (const bf16_t*)(wsp(a) + WS_KVR); const bf16_t* qr = (const bf16_t*)(wsp(a) + WS_QR); bf16_t* mix = (bf16_t*)(wsp(a) + WS_MIX);
    const int kp0 = 64 * qb - 128;
    const int hq = 2 * kvh + (w >> 2), wq = w & 3, qrow0 = 64 * qb + 16 * wq, kb = 16 * wq;
    const bf16_t* qp = qr + ((size_t)b * 4096 + qrow0 + fr) * 256 + hq * 64 + 8 * fq;
    const bf16x8 qf0 = *(const bf16x8*)qp, qf1 = *(const bf16x8*)(qp + 32);
    for (int id = tid; id < 1536; id += 512) { const int row = id >> 3, c8 = id & 7, kp = kp0 + row; uint4 kq = {0u, 0u, 0u, 0u}, vq = {0u, 0u, 0u, 0u};
        if (kp >= 0) { const bf16_t* src = kvr + ((size_t)b * 4096 + kp) * 256 + kvh * 64 + c8 * 8; kq = *(const uint4*)src; vq = *(const uint4*)(src + 128); }
        *(uint4*)(Ks + row * 72 + c8 * 8) = kq; bf16_t* vd = Vt + (c8 * 8) * 200 + row;
        vd[0] = (bf16_t)(vq.x & 0xffffu); vd[200] = (bf16_t)(vq.x >> 16); vd[400] = (bf16_t)(vq.y & 0xffffu); vd[600] = (bf16_t)(vq.y >> 16);
        vd[800] = (bf16_t)(vq.z & 0xffffu); vd[1000] = (bf16_t)(vq.z >> 16); vd[1200] = (bf16_t)(vq.w & 0xffffu); vd[1400] = (bf16_t)(vq.w >> 16); }
    __syncthreads();
    f32x4 s[9];
#pragma unroll
    for (int nn = 0; nn < 9; ++nn) { const bf16_t* kr = Ks + (kb + 16 * nn + fr) * 72 + 8 * fq; s[nn] = (f32x4){0.f, 0.f, 0.f, 0.f};
        s[nn] = MFMA16(*(const bf16x8*)kr, qf0, s[nn]); s[nn] = MFMA16(*(const bf16x8*)(kr + 32), qf1, s[nn]); }
    const int tq = qrow0 + fr; const float sink = inp(a, 15)[l * 4 + hq];
    float mx = sink;
#pragma unroll
    for (int nn = 0; nn < 9; ++nn)
#pragma unroll
        for (int jj = 0; jj < 4; ++jj) { const int tk = kp0 + kb + 16 * nn + 4 * fq + jj; const bool ok = tk >= 0 && tk <= tq && tk > tq - 128;
            const float v = ok ? s[nn][jj] * 0.125f : -1e30f; s[nn][jj] = v; mx = fmaxf(mx, v); }
    mx = fmaxf(mx, __shfl_xor(mx, 16)); mx = fmaxf(mx, __shfl_xor(mx, 32));
    float sum = 0.f;
#pragma unroll
    for (int nn = 0; nn < 9; ++nn)
#pragma unroll
        for (int jj = 0; jj < 4; ++jj) { const float p = s[nn][jj] > -1e29f ? __expf(s[nn][jj] - mx) : 0.f; s[nn][jj] = p; sum += p; }
    sum += __shfl_xor(sum, 16); sum += __shfl_xor(sum, 32); sum += __expf(sink - mx);
    bf16x8 pb[5];
#pragma unroll
    for (int kk = 0; kk < 4; ++kk) pb[kk] = pack8(s[2 * kk], s[2 * kk + 1]);
    pb[4] = pack8(s[8], (f32x4){0.f, 0.f, 0.f, 0.f});
    const float inv = __builtin_amdgcn_rcpf(sum);
#pragma unroll
    for (int m = 0; m < 4; ++m) { f32x4 o = {0.f, 0.f, 0.f, 0.f};
#pragma unroll
        for (int kk = 0; kk < 5; ++kk) { const bf16_t* vp = Vt + (16 * m + fr) * 200 + kb + 32 * kk + 4 * fq;
            const bf16x4 lo = *(const bf16x4*)vp; bf16x4 hi = {0, 0, 0, 0}; if (kk < 4) hi = *(const bf16x4*)(vp + 16);
            const bf16x8 af = {lo[0], lo[1], lo[2], lo[3], hi[0], hi[1], hi[2], hi[3]};
            o = MFMA16(af, pb[kk], o); }
        st4bf(mix + ((size_t)b * 4096 + tq) * DM + 512 + hq * 64 + 16 * m + 4 * fq, o * inv); }
    __syncthreads();
}

__device__ void d_item(const Args& a, const int l, const int it, unsigned char* smem) {
    const int tid = tidx(), lane = tid & 63, w = tid >> 6, fr = lane & 15, fq = lane >> 4;
    const int g = it & 3, ch = (it >> 2) & 31, b = it >> 7;
    bf16_t* vT = (bf16_t*)smem;
    const bf16_t* dvn = (const bf16_t*)(wsp(a) + WS_DVN); const bf16_t* proj = (const bf16_t*)(wsp(a) + WS_PROJ); bf16_t* mix = (bf16_t*)(wsp(a) + WS_MIX);
    const size_t r0 = (size_t)b * 4096 + 128 * ch;
    const float* Wg = inp(a, 18) + ((size_t)(l * 4 + g) * 128) * 128;
    const int t = 16 * w + fr;
    const size_t r = r0 + t;
    f32x4 wa[4], wb[4]; uint2 duq[4];
#pragma unroll
    for (int kk = 0; kk < 4; ++kk) if (kk <= (w >> 1)) { const float* wp = Wg + (size_t)t * 128 + 32 * kk + 8 * fq; wa[kk] = *(const f32x4*)wp; wb[kk] = *(const f32x4*)(wp + 4); }
#pragma unroll
    for (int n = 0; n < 4; ++n) duq[n] = *(const uint2*)(proj + r * PS + C_DU + g * 64 + 16 * n + 4 * fq);
    const float bias = inp(a, 19)[(size_t)(l * 4 + g) * 128 + t];
    for (int id = tid; id < 1024; id += 512) { const int row = id >> 3, c8 = id & 7; const uint4 vq = *(const uint4*)(dvn + (r0 + row) * 256 + g * 64 + c8 * 8); bf16_t* vd = vT + (c8 * 8) * 136 + row;
        vd[0] = (bf16_t)(vq.x & 0xffffu); vd[136] = (bf16_t)(vq.x >> 16); vd[272] = (bf16_t)(vq.y & 0xffffu); vd[408] = (bf16_t)(vq.y >> 16);
        vd[544] = (bf16_t)(vq.z & 0xffffu); vd[680] = (bf16_t)(vq.z >> 16); vd[816] = (bf16_t)(vq.w & 0xffffu); vd[952] = (bf16_t)(vq.w >> 16); }
    __syncthreads();
    f32x4 acc[4];
#pragma unroll
    for (int n = 0; n < 4; ++n) acc[n] = (f32x4){0.f, 0.f, 0.f, 0.f};
#pragma unroll
    for (int kk = 0; kk < 4; ++kk) if (kk <= (w >> 1)) {
        f32x4 w0 = wa[kk], w1 = wb[kk];
#pragma unroll
        for (int e = 0; e < 4; ++e) { if (32 * kk + 8 * fq + e > t) w0[e] = 0.f; if (32 * kk + 8 * fq + 4 + e > t) w1[e] = 0.f; }
        const bf16x8 bfr = pack8(w0, w1);
#pragma unroll
        for (int n = 0; n < 4; ++n) acc[n] = MFMA16(*(const bf16x8*)(vT + (16 * n + fr) * 136 + 32 * kk + 8 * fq), bfr, acc[n]);
    }
#pragma unroll
    for (int n = 0; n < 4; ++n) { const f32x4 du = gelu4(cv4bf(duq[n])); st4bf(mix + r * DM + 768 + g * 64 + 16 * n + 4 * fq, du * (acc[n] + bias)); }
    __syncthreads();
}

__device__ void phase_chunk(const Args& a, const int l, unsigned char* smem) {
    const int wid = tidx() >> 6, gw = bidx() * 8 + wid, nw = gdim() * 8;
#ifndef CHMASK
#define CHMASK 15
#endif
#ifndef CHDUP
#define CHDUP 0
#endif
    if (CHDUP & 1) { if (l == 0) for (int it = gw; it < 2048; it += nw) a2_item(a, it, smem + wid * A2_LDS); }
    if (CHDUP & 2) { if (l == 0) for (int it = gw; it < 512; it += nw) sattn_item(a, l, it); }
    if (CHDUP & 4) { if (l == 0) { __syncthreads(); for (int it = bidx(); it < 1024; it += gdim()) c_item(a, l, it, smem); } }
    if (CHDUP & 8) { if (l == 0) { __syncthreads(); for (int it = bidx(); it < 1024; it += gdim()) d_item(a, l, it, smem); } }
    if (CHDUP) __syncthreads();
    if (CHMASK & 1) for (int it = gw; it < 2048; it += nw) a2_item(a, it, smem + wid * A2_LDS);
    __syncthreads();

}

__device__ void phase_scan(const Args& a, const int l, unsigned char* smem) {
    const int lane = tidx() & 63, wid = tidx() >> 6, fr = lane & 15, fq = lane >> 4;

    float* oraw = (float*)((unsigned char*)outp(a) + OUT_ORAW);
    if (bidx() >= 32 || gdim() < 64) {
        const int nb = gdim() < 64 ? gdim() : gdim() - 32, bi = gdim() < 64 ? bidx() : bidx() - 32;
        for (int it = bi; it < 1024; it += nb) c_item(a, l, it, smem);
        for (int it = bi; it < 1024; it += nb) d_item(a, l, it, smem);
        { const int w = bi * 8 + wid; const int w3 = w / 3, wr3 = w - 3 * w3;
          if (w3 < 512 && wr3 == 0) sdelta_item(a, l, w3);
          if (w3 < 512 && wr3 == 1) sattn_item(a, l, w3); }
        if (gdim() >= 64) return;
    }
    LAS unsigned char* ring = (LAS unsigned char*)smem;
    for (int bh = bidx(); bh < 32; bh += gdim()) {
        const int b = bh >> 2, h = bh & 3, sl = wid;
        const unsigned char* a2b = wsp(a) + WS_A2;
#define SC_BASE(n_) (a2b + (size_t)((b * 64 + (n_)) * 4 + h) * 49152)
        if (wid >= 4) {
            const int lw = wid - 4;
#define SC_ISSUE(n_) do { const int nn_ = (n_) < 63 ? (n_) : 63; const unsigned char* g_ = SC_BASE(nn_) + lw * 8192 + lane * 16; LAS unsigned char* d_ = ring + ((n_) & 3) * 32768 + lw * 8192; \
            _Pragma("unroll") for (int j_ = 0; j_ < 8; ++j_) __builtin_amdgcn_global_load_lds((const unsigned*)(g_ + j_ * 1024), (LAS unsigned*)(d_ + j_ * 1024), 16, 0, 0); } while (0)
            SC_ISSUE(0); SC_ISSUE(1); SC_ISSUE(2);
#pragma unroll 1
            for (int n = 0; n < 64; ++n) {
                asm volatile("s_waitcnt vmcnt(16)" ::: "memory");
                __builtin_amdgcn_s_barrier();
                asm volatile("" ::: "memory");
                SC_ISSUE(n + 3);
            }
            asm volatile("s_waitcnt vmcnt(0)" ::: "memory");
            __builtin_amdgcn_s_barrier();
#undef SC_ISSUE
        } else {
            f32x4 S[4];
#pragma unroll
            for (int m = 0; m < 4; ++m) S[m] = (f32x4){0.f, 0.f, 0.f, 0.f};
            f32x4 u[4]; float glv;
            const float* glsp = (const float*)(wsp(a) + WS_GLS);
#define SC_LD_U(n_) do { const unsigned char* cb_ = SC_BASE(n_); _Pragma("unroll") for (int m = 0; m < 4; ++m) u[m] = *(const f32x4*)(cb_ + 32768 + (size_t)((sl * 4 + m) * 64 + lane) * 16); glv = glsp[(b * 64 + (n_)) * 4 + h]; } while (0)
#define SC_FR(off_, m_, kk_) (*(const LAS bf16x8*)(slot + (off_) + (((m_) * 2 + (kk_)) * 64 + lane) * 16))
            SC_LD_U(0);
#pragma unroll 1
            for (int n = 0; n < 64; ++n) {
                asm volatile("s_waitcnt lgkmcnt(0)" ::: "memory");
                __builtin_amdgcn_s_barrier();
                asm volatile("" ::: "memory");
                const LAS unsigned char* slot = ring + (n & 3) * 32768;
                const int nn = n < 63 ? n + 1 : 63;
                const float egl = __expf(glv);
                bf16x8 Sb[2], Vb[2];
                Sb[0] = pack8(S[0], S[1]); Sb[1] = pack8(S[2], S[3]);
                f32x4 vn[4];
                const size_t t0 = (size_t)b * 4096 + n * 64;
#pragma unroll
                for (int m = 0; m < 4; ++m) { f32x4 T = {0.f, 0.f, 0.f, 0.f}; T = MFMA16(SC_FR(8192, m, 0), Sb[0], T); T = MFMA16(SC_FR(8192, m, 1), Sb[1], T); vn[m] = u[m] - T; }
                SC_LD_U(nn);
                Vb[0] = pack8(vn[0], vn[1]); Vb[1] = pack8(vn[2], vn[3]);
#pragma unroll
                for (int m = 0; m < 4; ++m) { f32x4 o = {0.f, 0.f, 0.f, 0.f}; o = MFMA16(SC_FR(16384, m, 0), Sb[0], o); o = MFMA16(SC_FR(16384, m, 1), Sb[1], o); o = MFMA16(SC_FR(0, m, 0), Vb[0], o); o = MFMA16(SC_FR(0, m, 1), Vb[1], o);
#pragma unroll
                    for (int jj = 0; jj < 4; ++jj) oraw[(t0 + 16 * m + 4 * fq + jj) * 256 + h * 64 + 16 * sl + fr] = o[jj]; }
#pragma unroll
                for (int m = 0; m < 4; ++m) { f32x4 s2 = S[m] * egl; s2 = MFMA16(SC_FR(24576, m, 0), Vb[0], s2); s2 = MFMA16(SC_FR(24576, m, 1), Vb[1], s2); S[m] = s2; }
            }
            asm volatile("s_waitcnt lgkmcnt(0)" ::: "memory");
            __builtin_amdgcn_s_barrier();
#undef SC_LD_U
#undef SC_FR
            float* So = outp(a) + O_SDP + ((size_t)(l * 8 + b) * 4 + h) * 4096;
#pragma unroll
            for (int m = 0; m < 4; ++m)
#pragma unroll
                for (int jj = 0; jj < 4; ++jj) So[(16 * m + 4 * fq + jj) * 64 + 16 * sl + fr] = S[m][jj];
        }
#undef SC_BASE
        __syncthreads();
    }
}

__device__ void phase_aout(const Args& a, const int l) {
    const int lane = tidx() & 63, wid = tidx() >> 6, c4 = lane * 4;
    const float* oraw = (const float*)((unsigned char*)outp(a) + OUT_ORAW); const bf16_t* proj = (const bf16_t*)(wsp(a) + WS_PROJ); bf16_t* mix = (bf16_t*)(wsp(a) + WS_MIX);
    const f32x4 g = *(const f32x4*)(inp(a, 13) + l * 64 + (c4 & 63));
    for (int r = bidx() * 8 + wid; r < MP; r += gdim() * 8) {
        const f32x4 o = *(const f32x4*)(oraw + (size_t)r * 256 + c4);
        const float ss = red16(o[0] * o[0] + o[1] * o[1] + o[2] * o[2] + o[3] * o[3]);
        const f32x4 y = o * rsqrtf(ss * (1.f / 64.f) + EPS) * g;
        st4bf(mix + (size_t)r * DM + c4, y * silu4(ld4bf(proj + (size_t)r * PS + C_AZ + c4)));
    }
}

__device__ void phase_fix(const Args& a, const int l) {
    const float* sg = (const float*)(wsp(a) + WS_SG); const float* su = (const float*)(wsp(a) + WS_SU); bf16_t* act = (bf16_t*)(wsp(a) + WS_PROJ);
    const float* cw = inp(a, 24) + (size_t)l * 3 * FF;
    const int idx0 = bidx() * 512 + tidx(), idxs = gdim() * 512;
#pragma unroll 3
    for (int idx = idx0; idx < 512 * 2 * 704; idx += idxs) {
        const int f = (idx % 704) * 4, q = (idx / 704) & 1, blk = idx / 1408; const bool prev = (blk & 63) != 0;
        const f32x4 z4 = {0.f, 0.f, 0.f, 0.f};
        const f32x4 g0 = *(const f32x4*)(sg + ((size_t)blk * 4 + q) * FF + f), up = *(const f32x4*)(su + ((size_t)blk * 2 + q) * FF + f);
        f32x4 gm2, gm1;
        if (q == 0) { gm2 = prev ? *(const f32x4*)(sg + ((size_t)(blk - 1) * 4 + 2) * FF + f) : z4; gm1 = prev ? *(const f32x4*)(sg + ((size_t)(blk - 1) * 4 + 3) * FF + f) : z4; }
        else { gm2 = prev ? *(const f32x4*)(sg + ((size_t)(blk - 1) * 4 + 3) * FF + f) : z4; gm1 = *(const f32x4*)(sg + ((size_t)blk * 4 + 0) * FF + f); }
        const f32x4 gc = *(const f32x4*)(cw + f) * gm2 + *(const f32x4*)(cw + FF + f) * gm1 + *(const f32x4*)(cw + 2 * FF + f) * g0;
        st4bf(act + ((size_t)blk * 64 + q) * FF + f, silu4(gc) * up);
    }
    const float* P = (const float*)(wsp(a) + WS_SACC); const float* st = inp(a, 7) + (size_t)l * 128 * 2 * FF; float* osfs = outp(a) + O_SFS + (size_t)l * 128 * 2 * FF;
    const float* ssq = (const float*)(wsp(a) + WS_SSQB);
    for (int idx = idx0; idx < 128 * FF; idx += idxs) {
        const int b = idx / FF, ff = idx - b * FF, gcol = 256 * (ff >> 7) + (ff & 127);
        float x2 = st[((size_t)b * 2) * FF + ff], x1 = st[((size_t)b * 2 + 1) * FF + ff];
        const float w0 = cw[ff], w1 = cw[FF + ff], w2 = cw[2 * FF + ff];
#pragma unroll
        for (int t = 0; t < 4; ++t) {
            const int rs = 4 * b + t; const float sc = rowscale(ssq, MP + rs);
            float g = 0.f, u = 0.f;
#pragma unroll
            for (int sl = 0; sl < 4; ++sl) { const float* pp = P + ((size_t)sl * MS + rs) * 5632 + gcol; g += pp[0]; u += pp[128]; }
            g *= sc; u *= sc;
            const float y = w0 * x2 + w1 * x1 + w2 * g;
            act[((size_t)MP + rs) * FF + ff] = f2bf(silu_f(y) * u);
            if (t >= 2) osfs[((size_t)b * 2 + (t - 2)) * FF + ff] = g;
            x2 = x1; x1 = g;
        }
    }
}

__device__ void phase_sfin(const Args& a) {
    const int lane = tidx() & 63, wid = tidx() >> 6;
    const float* sacc = (const float*)(wsp(a) + WS_SACC); bf16_t* xb = (bf16_t*)(wsp(a) + WS_XB); float* ssq = (float*)(wsp(a) + WS_SSQA);
    for (int rs = bidx() * 8 + wid; rs < MS; rs += gdim() * 8) {
        const size_t r = (size_t)MP + rs; float ss = 0.f;
#pragma unroll
        for (int q = 0; q < 4; ++q) { const int c = q * 256 + lane * 4; f32x4 v = ld4bf(xb + r * DM + c);
#pragma unroll
            for (int ks = 0; ks < 11; ++ks) v = v + *(const f32x4*)(sacc + (size_t)ks * ((size_t)MS * DM) + (size_t)rs * DM + c);
            ss += v[0] * v[0] + v[1] * v[1] + v[2] * v[2] + v[3] * v[3]; st4bf(xb + r * DM + c, v); }
        ss = wave_sum(ss);
        if (lane < 16) ssq[r * 16 + lane] = lane == 0 ? ss : 0.f;
    }
}

__device__ void phase_final(const Args& a) {
    const int lane = tidx() & 63, wid = tidx() >> 6;
    const float* ssq = (const float*)(wsp(a) + WS_SSQA); const float* g = inp(a, 26); const bf16_t* xb = (const bf16_t*)(wsp(a) + WS_XB);
    for (int r = bidx() * 8 + wid; r < M; r += gdim() * 8) {
        const float sc = rowscale(ssq, r); float* yr = outp(a) + (size_t)r * DM; const bf16_t* xr = xb + (size_t)r * DM;
#pragma unroll
        for (int q = 0; q < 4; ++q) { const int c = q * 256 + lane * 4; __builtin_nontemporal_store(ld4bf(xr + c) * sc * *(const f32x4*)(g + c), (f32x4*)(yr + c)); }
    }
}

#define XB_TMO      128
#define XB_XCNT(j)  (256  + 64 * (j))
#define XB_XSUB(j)  (1280 + 64 * (j))
#define XB_XGEN(j)  (2304 + 64 * (j))
#define XB_TOP      3328
#define XB_TOPGEN   3392
#define XCD_BAR_WORDS 3456
#define XB_SPIN_CAP (1u << 20)
DEVI unsigned xb_ld(unsigned* p)              { return __hip_atomic_load(p, __ATOMIC_RELAXED, __HIP_MEMORY_SCOPE_AGENT); }
DEVI unsigned xb_add(unsigned* p, unsigned v) { return __hip_atomic_fetch_add(p, v, __ATOMIC_RELAXED, __HIP_MEMORY_SCOPE_AGENT); }
DEVI unsigned xb_xcc_id() { return (unsigned)__builtin_amdgcn_s_getreg((3 << 11) | 20) & 0xFu; }
#define XB_SPIN(cond, bar) do { unsigned _sp = 0; while (cond) { __builtin_amdgcn_s_sleep(1); \
    if ((++_sp & 255u) == 0u) { if (xb_ld(&(bar)[XB_TMO])) break; if (_sp > XB_SPIN_CAP) { atomicAdd(&(bar)[XB_TMO], 1u); break; } } } } while (0)
DEVI void xcd_barrier_complete(unsigned* bar, unsigned x, unsigned& nloc, unsigned& nx) {
    const unsigned G = gridDim.x * gridDim.y * gridDim.z;
    unsigned sum, cnt, mine, sp = 0u;
    for (;;) {
        sum = 0u; cnt = 0u; mine = 0u;
#pragma unroll
        for (unsigned j = 0; j < 16; ++j) { const unsigned c = xb_ld(&bar[XB_XCNT(j)]); sum += c; cnt += (c > 0u) ? 1u : 0u; mine = (j == x) ? c : mine; }
        if (sum == G) break;
        __builtin_amdgcn_s_sleep(1);
        if ((++sp & 255u) == 0u) { if (xb_ld(&bar[XB_TMO])) break; if (sp > XB_SPIN_CAP) { atomicAdd(&bar[XB_TMO], 1u); break; } }
    }
    nloc = mine > 0u ? mine : 1u; nx = cnt > 0u ? cnt : 1u;
}
DEVI void xcd_barrier(unsigned* const b_bar, volatile LAS unsigned* const b_st) {
    const unsigned b_x = xb_xcc_id();
    asm volatile("s_waitcnt vmcnt(0)" ::: "memory");
    __syncthreads();
    if (threadIdx.x == 0) {
        unsigned* bar = b_bar;
        __builtin_amdgcn_s_waitcnt(0);
        unsigned nloc = b_st[0], nx = b_st[1];
        if (nloc == 0u) { (void)xb_add(&bar[XB_XCNT(b_x)], 1u); xcd_barrier_complete(bar, b_x, nloc, nx); b_st[0] = nloc; b_st[1] = nx; }
        const unsigned old = xb_add(&bar[XB_XSUB(b_x)], 1u);
        const unsigned gen = old / nloc;
        if (old + 1u == (gen + 1u) * nloc) {
            __builtin_amdgcn_fence(__ATOMIC_RELEASE, "agent");
            asm volatile("s_waitcnt vmcnt(0)" ::: "memory");
            const unsigned og = xb_add(&bar[XB_TOP], 1u);
            const unsigned tg = og / nx;
            if (og + 1u == (tg + 1u) * nx) xb_add(&bar[XB_TOPGEN], 1u);
            else XB_SPIN(xb_ld(&bar[XB_TOPGEN]) == tg, bar);
            __builtin_amdgcn_fence(__ATOMIC_ACQUIRE, "agent");
            xb_add(&bar[XB_XGEN(b_x)], 1u);
            asm volatile("s_waitcnt vmcnt(0)" ::: "memory");
        } else {
            XB_SPIN(xb_ld(&bar[XB_XGEN(b_x)]) == gen, bar);
            __builtin_amdgcn_fence(__ATOMIC_ACQUIRE, "agent");
            asm volatile("s_waitcnt vmcnt(0)" ::: "memory");
        }
    }
    __syncthreads();
}

constexpr int NPH = 22, LDS_BYTES = 147456;
__global__ void __launch_bounds__(512) fwd_kernel(Args a0) {
    extern __shared__ __attribute__((aligned(16))) unsigned char smem[];
    LAS unsigned char* lds = (LAS unsigned char*)smem;
#ifndef DUPMASK
#define DUPMASK 0
#endif
    int dup = 0;
#pragma unroll 1
    for (int ph = a0.ph_lo; ph < a0.ph_hi; ++ph) {
        if (ph == a0.ph_lo && threadIdx.x == 0) { volatile LAS unsigned* st0 = (volatile LAS unsigned*)(lds + (LDS_BYTES - 16)); st0[0] = 0u; st0[1] = 0u; }
        if (ph > a0.ph_lo && a0.coop && !(ph >= 1 && ph < NPH - 1 && (ph - 1) % 10 == 2)) { if (a0.coop == 2) cg::this_grid().sync();                         xcd_barrier((unsigned*)wsp(a0) + WS_BAR / 4, (volatile LAS unsigned*)(lds + (LDS_BYTES - 16))); }
        const Args& a = a0;
#ifndef PHMASK
#define PHMASK 0xFFFFF
#endif
        if (ph == 0) { if (PHMASK & 1) phase_prep(a, smem);
#ifdef DUP_PREP
            __syncthreads(); phase_prep(a, smem);
#endif
            continue; }
        if (ph == NPH - 1) {
#ifdef EXTRA_SYNCS
#pragma unroll 1
            for (int i = 0; i < EXTRA_SYNCS; ++i) cg::this_grid().sync();
#endif
            if (PHMASK & 2) phase_final(a); continue; }
        const int l = (ph - 1) / 10, sp = (ph - 1) % 10;
        pg8::StaticOrder S;
        if (!((PHMASK >> (2 + sp)) & 1)) continue;
        switch (sp) {
        case 0: { pg8::Gemm g{(const bf16_t*)(wsp(a) + WS_XB), (const bf16_t*)(wsp(a) + WS_WIN) + (size_t)l * NPAD * 1024, M, NPAD, 1024}; S.init(M, NPAD, 1024, gdim(), bidx());
            EpiProj E{(bf16_t*)(wsp(a) + WS_PROJ), (const float*)(wsp(a) + WS_SSQA)}; pg8::gemm_phase(lds, g, S, E); } break;
        case 1: phase_tok(a, l, smem);
            __syncthreads();
            phase_chunk(a, l, smem); break;
        case 2: break;
        case 3: phase_scan(a, l, smem); break;
        case 4: phase_aout(a, l); break;
        case 5: { pg8::Gemm g{(const bf16_t*)(wsp(a) + WS_MIX), (const bf16_t*)(wsp(a) + WS_WOUT) + (size_t)l * 1024 * 1024, M, 1024, 1024}; S.init(M, 1024, 1024, gdim(), bidx());
            EpiRes E{(bf16_t*)(wsp(a) + WS_XB), (float*)(wsp(a) + WS_SSQB), nullptr}; pg8::gemm_phase(lds, g, S, E); } break;
        case 6: { pg8::Gemm g{(const bf16_t*)(wsp(a) + WS_XB), (const bf16_t*)(wsp(a) + WS_WGU) + (size_t)l * 5632 * 1024, M, 5632, 1024};
            pg8::SplitOrder S2; S2.init(MP, 5632, 1024, gdim(), bidx()); S2.nks = 4;
            EpiGU E{(bf16_t*)(wsp(a) + WS_PROJ), (const float*)(wsp(a) + WS_SSQB), inp(a, 24) + (size_t)l * 3 * FF, (float*)(wsp(a) + WS_SG), (float*)(wsp(a) + WS_SU),
                    outp(a) + O_SFP + (size_t)l * 8 * 2 * FF, (float*)(wsp(a) + WS_SACC)}; pg8::gemm_phase(lds, g, S2, E); } break;
        case 7: phase_fix(a, l); break;
        case 8: { pg8::Gemm g{(const bf16_t*)(wsp(a) + WS_PROJ), (const bf16_t*)(wsp(a) + WS_WDN) + (size_t)l * 1024 * FF, M, 1024, FF};
            pg8::SplitOrder S2; S2.init(MP, 1024, FF, gdim(), bidx()); S2.nks = 11;
            EpiRes E{(bf16_t*)(wsp(a) + WS_XB), (float*)(wsp(a) + WS_SSQA), (float*)(wsp(a) + WS_SACC)}; pg8::gemm_phase(lds, g, S2, E); } break;
        default: phase_sfin(a); break;
        }
        if (DUPMASK && !dup && ph >= 1 && ph <= 9 && ((DUPMASK >> (ph - 1)) & 1)) { dup = 1; --ph; } else dup = 0;
    }
}

extern "C" void kernel_launch(void* const* d_in, const int* in_sizes, int n_in, void* d_out, int out_size, void* d_ws, size_t ws_size, hipStream_t stream) {
    static int grid = 0;
    if (grid == 0) {
        if (n_in != 27 || (size_t)out_size != O_END || ws_size < WS_END) { fprintf(stderr, "kernel_launch: unexpected sizes n_in %d out %d ws %zu (need %zu)\n", n_in, out_size, ws_size, (size_t)WS_END); grid = -1; return; }
        int dev = 0, cus = 0, per_cu = 0;
        hipGetDevice(&dev); hipDeviceGetAttribute(&cus, hipDeviceAttributeMultiprocessorCount, dev);
        if (hipFuncSetAttribute((const void*)fwd_kernel, hipFuncAttributeMaxDynamicSharedMemorySize, LDS_BYTES) != hipSuccess) { fprintf(stderr, "kernel_launch: hipFuncSetAttribute failed\n"); grid = -1; return; }
        hipOccupancyMaxActiveBlocksPerMultiprocessor(&per_cu, (const void*)fwd_kernel, 512, LDS_BYTES);
        (void)hipGetLastError();
        if (per_cu < 1) per_cu = 1;
        if (cus != 256) { fprintf(stderr, "kernel_launch: built for a 256-CU device (one workgroup per CU), found %d CUs\n", cus); grid = -1; return; }
        grid = 256;
    }
    if (grid < 0) return;
    Args a{};
    for (int i = 0; i < 27; ++i) a.in[i] = (const float*)d_in[i];
    a.out = (float*)d_out; a.ws = (unsigned char*)d_ws;
#if ONE_LAUNCH
    a.coop = 1; a.ph_lo = 0; a.ph_hi = NPH;
    if (hipMemsetAsync((unsigned char*)d_ws + WS_BAR, 0, 16384, stream) != hipSuccess) { fprintf(stderr, "kernel_launch: memset of the barrier words failed\n"); return; }
    void* args[] = {&a};
    hipError_t e = hipLaunchCooperativeKernel((const void*)fwd_kernel, dim3(grid), dim3(512), args, LDS_BYTES, stream);
    if (e != hipSuccess) fprintf(stderr, "cooperative launch failed: %s (grid %d)\n", hipGetErrorString(e), grid);
#else
    a.coop = 0;
    for (int ph = 0; ph < NPH; ++ph) { a.ph_lo = ph; a.ph_hi = ph + 1; hipLaunchKernelGGL(fwd_kernel, dim3(grid), dim3(512), LDS_BYTES, stream, a); }
#endif
}
```
